# Optimizing an MI355X kernel written in HIP

```python
import numpy as np
import jax
import jax.numpy as jnp
from jax import lax

D_MODEL = 1024
BATCH = 8
SEQ = 2048
DEPTH = 2

GRID_W = 64
CTX_LEN = 256
Q_BLOCK = 128
ROPE_THETA = 10000.0
NORM_EPS = 1e-6
N_MOD = 6

GQA_HEADS = 8
GQA_KV_HEADS = 2
GQA_GROUP = GQA_HEADS // GQA_KV_HEADS
GQA_HEAD_DIM = 64
GQA_WIDTH = GQA_HEADS * GQA_HEAD_DIM

LRU_WIDTH = 512
LRU_BLOCKS = 8
LRU_BLOCK_W = LRU_WIDTH // LRU_BLOCKS
CONV_WIDTH = 4
CONV_PAD = (1, 2)
LRU_C = 8.0

MLA_HEADS = 8
MLA_NOPE = 64
MLA_ROPE = 32
MLA_V = 64
MLA_Q_LORA = 384
MLA_KV_LORA = 256
MLA_WIDTH = MLA_HEADS * MLA_V

N_BRANCHES = 3
IN_WIDTHS = (GQA_WIDTH, GQA_KV_HEADS * GQA_HEAD_DIM, GQA_KV_HEADS * GQA_HEAD_DIM, LRU_WIDTH, LRU_WIDTH,
             MLA_Q_LORA, MLA_KV_LORA, MLA_ROPE, N_BRANCHES * D_MODEL)
IN_WIDTH = sum(IN_WIDTHS)

N_EXPERTS = 16
N_GROUPS = 4
EXPERTS_PER_GROUP = N_EXPERTS // N_GROUPS
TOPK_GROUPS = 1
GROUP_SCORE_TOPK = 2
TOP_K = 2
EXPERT_FF = 512
ROUTED_SCALE = 1.0

kernel_name = 'hybrid_gqa_rglru_mla_moe_prefix'


def rms_norm(x, g):
    xf = x.astype(jnp.float32)
    y = xf * lax.rsqrt(jnp.mean(xf * xf, axis=-1, keepdims=True) + NORM_EPS)
    return (y * g.astype(jnp.float32)).astype(x.dtype)


def modulate(h, shift, scale):
    return h * (1 + scale) + shift


def axial_rope_tables(rows, dim):
    r, col = jnp.meshgrid(jnp.arange(rows, dtype=jnp.float32), jnp.arange(GRID_W, dtype=jnp.float32), indexing='ij')
    quarter = dim // 4
    inv_freq = ROPE_THETA ** (-jnp.arange(quarter, dtype=jnp.float32) / quarter)
    ang_r = r.reshape(-1, 1) * inv_freq
    ang_c = col.reshape(-1, 1) * inv_freq
    return (jnp.cos(ang_r), jnp.sin(ang_r), jnp.cos(ang_c), jnp.sin(ang_c))


def _rotate(x, cos, sin):
    x1, x2 = jnp.split(x, 2, axis=-1)
    cos = cos[None, :, None, :].astype(x.dtype)
    sin = sin[None, :, None, :].astype(x.dtype)
    return jnp.concatenate([x1 * cos - x2 * sin, x2 * cos + x1 * sin], axis=-1)


def apply_axial_rope(x, tables):
    cr, sr, cc, sc = tables
    x_row, x_col = jnp.split(x, 2, axis=-1)
    return jnp.concatenate([_rotate(x_row, cr, sr), _rotate(x_col, cc, sc)], axis=-1)


def block_attention(q, k, v, scale):
    b, sq, hkv, g, dk = q.shape
    nb = sq // Q_BLOCK
    qb = jnp.moveaxis(q.reshape(b, nb, Q_BLOCK, hkv, g, dk), 1, 0)

    def one_block(qblk):
        s = jnp.einsum('bqhgd,bkhd->bhgqk', qblk, k, preferred_element_type=jnp.float32) * scale
        p = jax.nn.softmax(s, axis=-1).astype(v.dtype)
        return jnp.einsum('bhgqk,bkhe->bqhge', p, v)

    o = lax.map(one_block, qb)
    return jnp.moveaxis(o, 0, 1).reshape(b, sq, -1)


def centred_dwconv(x, w, b):
    y = lax.conv_general_dilated(x, w[:, None, :].astype(x.dtype), window_strides=(1,), padding=[CONV_PAD],
                                 dimension_numbers=('NWC', 'WIO', 'NWC'), feature_group_count=x.shape[-1])
    return y + b


def rglru_coeffs(u, w_a, b_a, w_i, b_i, lam):
    bsz, t, width = u.shape
    uf = u.astype(jnp.float32)
    ub = uf.reshape(bsz, t, LRU_BLOCKS, LRU_BLOCK_W)
    r = jax.nn.sigmoid(jnp.einsum('btnk,nkj->btnj', ub, w_a.astype(jnp.float32)).reshape(bsz, t, width)
                       + b_a.astype(jnp.float32))
    i = jax.nn.sigmoid(jnp.einsum('btnk,nkj->btnj', ub, w_i.astype(jnp.float32)).reshape(bsz, t, width)
                       + b_i.astype(jnp.float32))
    log_a = -LRU_C * r * jax.nn.softplus(-lam.astype(jnp.float32))
    a = jnp.exp(log_a)
    gated_x = jnp.sqrt(-jnp.expm1(2.0 * log_a)) * (i * uf)
    return a, gated_x


def _scan_combine(left, right):
    a_l, b_l = left
    a_r, b_r = right
    return a_l * a_r, a_r * b_l + b_r


def linear_recurrence(a, b, h0, reverse):
    edge = -1 if reverse else 0
    b = b.at[:, edge].add(a[:, edge] * h0)
    _, h = lax.associative_scan(_scan_combine, (a, b), reverse=reverse, axis=1)
    return h


def token_mixer(hc, hl, need_ctx, rope_gqa, rope_mla, w_in, gqa_q_norm, gqa_k_norm, conv_w, conv_b,
                lru_w_a, lru_b_a, lru_w_i, lru_b_i, lru_lam, mla_q_a_norm, mla_w_qb, mla_kv_a_norm, mla_w_kvb,
                w_branch_attn, w_branch_lru, w_branch_mla, w_out):
    bsz, n_ctx, _ = hc.shape
    n_lat = hl.shape[1]
    h = jnp.concatenate([hc, hl], axis=1)
    z = h @ w_in
    zq, zk, zv, zx, zy, zcq, zckv, zkr, zg = jnp.split(z, np.cumsum(IN_WIDTHS)[:-1].tolist(), axis=-1)
    q0 = 0 if need_ctx else n_ctx
    lq = n_ctx - q0
    nq = n_ctx + n_lat - q0

    q = rms_norm(zq[:, q0:].reshape(bsz, nq, GQA_HEADS, GQA_HEAD_DIM), gqa_q_norm)
    k = rms_norm(zk.reshape(bsz, -1, GQA_KV_HEADS, GQA_HEAD_DIM), gqa_k_norm)
    v = zv.reshape(bsz, -1, GQA_KV_HEADS, GQA_HEAD_DIM)
    k = jnp.concatenate([k[:, :n_ctx], apply_axial_rope(k[:, n_ctx:], rope_gqa)], axis=1)
    q_lat = apply_axial_rope(q[:, lq:], rope_gqa).reshape(bsz, n_lat, GQA_KV_HEADS, GQA_GROUP, GQA_HEAD_DIM)
    gqa_scale = GQA_HEAD_DIM ** -0.5
    o_attn = block_attention(q_lat, k, v, gqa_scale)
    if need_ctx:
        q_ctx = q[:, :lq].reshape(bsz, n_ctx, GQA_KV_HEADS, GQA_GROUP, GQA_HEAD_DIM)
        o_attn = jnp.concatenate([block_attention(q_ctx, k[:, :n_ctx], v[:, :n_ctx], gqa_scale), o_attn], axis=1)

    u_ctx = centred_dwconv(zx[:, :n_ctx], conv_w, conv_b)
    u_lat = centred_dwconv(zx[:, n_ctx:], conv_w, conv_b)
    lat_states = []
    ctx_states = []
    for d, reverse in enumerate((False, True)):
        params = (lru_w_a[d], lru_b_a[d], lru_w_i[d], lru_b_i[d], lru_lam[d])
        a_c, x_c = rglru_coeffs(u_ctx, *params)
        hs_c = linear_recurrence(a_c, x_c, jnp.zeros_like(x_c[:, 0]), reverse)
        h_end = hs_c[:, 0] if reverse else hs_c[:, -1]
        a_l, x_l = rglru_coeffs(u_lat, *params)
        lat_states.append(linear_recurrence(a_l, x_l, h_end, reverse))
        if need_ctx:
            ctx_states.append(hs_c)
    rec = lat_states[0] + lat_states[1]
    if need_ctx:
        rec = jnp.concatenate([ctx_states[0] + ctx_states[1], rec], axis=1)
    o_lru = rec.astype(h.dtype) * jax.nn.gelu(zy[:, q0:], approximate=True)

    cq = rms_norm(zcq[:, q0:], mla_q_a_norm)
    qm = (cq @ mla_w_qb).reshape(bsz, nq, MLA_HEADS, MLA_NOPE + MLA_ROPE)
    ckv = rms_norm(zckv, mla_kv_a_norm)
    kv = (ckv @ mla_w_kvb).reshape(bsz, -1, MLA_HEADS, MLA_NOPE + MLA_V)
    k_nope, vm = jnp.split(kv, [MLA_NOPE], axis=-1)
    k_rope = zkr[:, :, None, :]
    k_rope = jnp.concatenate([k_rope[:, :n_ctx], apply_axial_rope(k_rope[:, n_ctx:], rope_mla)], axis=1)
    km = jnp.concatenate([k_nope, jnp.broadcast_to(k_rope, k_nope.shape[:-1] + (MLA_ROPE,))], axis=-1)
    q_nope, q_rope = jnp.split(qm, [MLA_NOPE], axis=-1)
    q_lat_m = jnp.concatenate([q_nope[:, lq:], apply_axial_rope(q_rope[:, lq:], rope_mla)], axis=-1)
    mla_scale = (MLA_NOPE + MLA_ROPE) ** -0.5
    o_mla = block_attention(q_lat_m[:, :, :, None, :], km, vm, mla_scale)
    if need_ctx:
        o_mla_ctx = block_attention(qm[:, :lq][:, :, :, None, :], km[:, :n_ctx], vm[:, :n_ctx], mla_scale)
        o_mla = jnp.concatenate([o_mla_ctx, o_mla], axis=1)

    g_attn, g_lru, g_mla = jnp.split(jax.nn.sigmoid(zg[:, q0:]), N_BRANCHES, axis=-1)
    merged = (g_attn * (o_attn @ w_branch_attn) + g_lru * (o_lru @ w_branch_lru)
              + g_mla * (o_mla @ w_branch_mla))
    y = merged @ w_out
    return y[:, :lq], y[:, lq:]


def moe_ffn(h, router_w, router_bias, w_gate, w_up, w_down):
    shape = h.shape
    t = h.reshape(-1, shape[-1])
    scores = jax.nn.sigmoid(jnp.matmul(t, router_w, preferred_element_type=jnp.float32))
    sel = scores + router_bias.astype(jnp.float32)
    grp = sel.reshape(-1, N_GROUPS, EXPERTS_PER_GROUP)
    group_score = jnp.sum(lax.top_k(grp, GROUP_SCORE_TOPK)[0], axis=-1)
    _, g_idx = lax.top_k(group_score, TOPK_GROUPS)
    group_mask = jnp.sum(jax.nn.one_hot(g_idx, N_GROUPS, dtype=jnp.float32), axis=1)
    expert_mask = jnp.repeat(group_mask, EXPERTS_PER_GROUP, axis=-1)
    masked = jnp.where(expert_mask > 0, sel, -jnp.inf)
    _, e_idx = lax.top_k(masked, TOP_K)
    w = jnp.take_along_axis(scores, e_idx, axis=-1)
    w = ROUTED_SCALE * w / jnp.sum(w, axis=-1, keepdims=True)
    combine = jnp.sum(jax.nn.one_hot(e_idx, N_EXPERTS, dtype=jnp.float32) * w[..., None], axis=1).astype(h.dtype)
    gate = jnp.einsum('nd,edf->nef', t, w_gate)
    up = jnp.einsum('nd,edf->nef', t, w_up)
    act = jax.nn.silu(gate) * up * combine[..., None]
    y = jnp.einsum('nef,efd->nd', act, w_down)
    return y.reshape(shape)


def setup_inputs(seed: int = 0) -> dict:
    key = jax.random.key(seed)
    ks = iter(jax.random.split(key, 40))
    d = D_MODEL

    def nrm(shape, scale):
        return jax.random.normal(next(ks), shape, jnp.float32) * scale

    x = nrm((BATCH, SEQ, d), 1.0)
    c = nrm((BATCH, d), 1.0)
    ctx = nrm((BATCH, CTX_LEN, d), 1.0)
    c_ctx = nrm((d,), 1.0)
    w_mod = nrm((DEPTH, d, N_MOD * d), 0.5 * d ** -0.5)
    b_mod = nrm((DEPTH, N_MOD * d), 0.02)
    norm_mix = 1.0 + nrm((DEPTH, d), 0.05)
    norm_ffn = 1.0 + nrm((DEPTH, d), 0.05)
    w_in = nrm((DEPTH, d, IN_WIDTH), d ** -0.5)
    gqa_q_norm = 1.0 + nrm((DEPTH, GQA_HEAD_DIM), 0.05)
    gqa_k_norm = 1.0 + nrm((DEPTH, GQA_HEAD_DIM), 0.05)
    conv_w = nrm((DEPTH, CONV_WIDTH, LRU_WIDTH), CONV_WIDTH ** -0.5)
    conv_b = nrm((DEPTH, LRU_WIDTH), 0.02)
    lru_w_a = nrm((DEPTH, 2, LRU_BLOCKS, LRU_BLOCK_W, LRU_BLOCK_W), LRU_BLOCK_W ** -0.5)
    lru_b_a = nrm((DEPTH, 2, LRU_WIDTH), 0.02)
    lru_w_i = nrm((DEPTH, 2, LRU_BLOCKS, LRU_BLOCK_W, LRU_BLOCK_W), LRU_BLOCK_W ** -0.5)
    lru_b_i = nrm((DEPTH, 2, LRU_WIDTH), 0.02)
    a8 = jax.random.uniform(next(ks), (DEPTH, 2, LRU_WIDTH), jnp.float32, minval=0.9, maxval=0.999)
    s = a8 ** 0.125
    lru_lam = jnp.log(s) - jnp.log1p(-s)
    mla_q_a_norm = 1.0 + nrm((DEPTH, MLA_Q_LORA), 0.05)
    mla_w_qb = nrm((DEPTH, MLA_Q_LORA, MLA_HEADS * (MLA_NOPE + MLA_ROPE)), MLA_Q_LORA ** -0.5)
    mla_kv_a_norm = 1.0 + nrm((DEPTH, MLA_KV_LORA), 0.05)
    mla_w_kvb = nrm((DEPTH, MLA_KV_LORA, MLA_HEADS * (MLA_NOPE + MLA_V)), MLA_KV_LORA ** -0.5)
    w_branch_attn = nrm((DEPTH, GQA_WIDTH, d), GQA_WIDTH ** -0.5)
    w_branch_lru = nrm((DEPTH, LRU_WIDTH, d), LRU_WIDTH ** -0.5)
    w_branch_mla = nrm((DEPTH, MLA_WIDTH, d), MLA_WIDTH ** -0.5)
    w_out = nrm((DEPTH, d, d), d ** -0.5)
    router_w = nrm((d, N_EXPERTS), d ** -0.5)
    router_bias = nrm((N_EXPERTS,), 0.01)
    moe_w_gate = nrm((DEPTH, N_EXPERTS, d, EXPERT_FF), d ** -0.5)
    moe_w_up = nrm((DEPTH, N_EXPERTS, d, EXPERT_FF), d ** -0.5)
    moe_w_down = nrm((DEPTH, N_EXPERTS, EXPERT_FF, d), EXPERT_FF ** -0.5)
    final_norm = 1.0 + nrm((d,), 0.05)
    return {'x': x, 'c': c, 'ctx': ctx, 'c_ctx': c_ctx, 'w_mod': w_mod, 'b_mod': b_mod,
            'norm_mix': norm_mix, 'norm_ffn': norm_ffn, 'w_in': w_in,
            'gqa_q_norm': gqa_q_norm, 'gqa_k_norm': gqa_k_norm, 'conv_w': conv_w, 'conv_b': conv_b,
            'lru_w_a': lru_w_a, 'lru_b_a': lru_b_a, 'lru_w_i': lru_w_i, 'lru_b_i': lru_b_i, 'lru_lam': lru_lam,
            'mla_q_a_norm': mla_q_a_norm, 'mla_w_qb': mla_w_qb, 'mla_kv_a_norm': mla_kv_a_norm,
            'mla_w_kvb': mla_w_kvb, 'w_branch_attn': w_branch_attn, 'w_branch_lru': w_branch_lru,
            'w_branch_mla': w_branch_mla, 'w_out': w_out, 'router_w': router_w, 'router_bias': router_bias,
            'moe_w_gate': moe_w_gate, 'moe_w_up': moe_w_up, 'moe_w_down': moe_w_down, 'final_norm': final_norm}


def reference(x, c, ctx, c_ctx, w_mod, b_mod, norm_mix, norm_ffn, w_in, gqa_q_norm, gqa_k_norm, conv_w, conv_b,
              lru_w_a, lru_b_a, lru_w_i, lru_b_i, lru_lam, mla_q_a_norm, mla_w_qb, mla_kv_a_norm, mla_w_kvb,
              w_branch_attn, w_branch_lru, w_branch_mla, w_out, router_w, router_bias,
              moe_w_gate, moe_w_up, moe_w_down, final_norm):
    rows = x.shape[1] // GRID_W
    rope_gqa = axial_rope_tables(rows, GQA_HEAD_DIM)
    rope_mla = axial_rope_tables(rows, MLA_ROPE)
    act_c = jax.nn.silu(c)[:, None, :]
    act_cc = jax.nn.silu(c_ctx)[None, None, :]
    n_ctx = ctx.shape[1]
    xc, xl = ctx, x
    for layer in range(DEPTH):
        need_ctx = layer < DEPTH - 1
        mod_l = jnp.split(act_c @ w_mod[layer] + b_mod[layer], N_MOD, axis=-1)
        mod_c = jnp.split(act_cc @ w_mod[layer] + b_mod[layer], N_MOD, axis=-1)
        hc = modulate(rms_norm(xc, norm_mix[layer]), mod_c[0], mod_c[1])
        hl = modulate(rms_norm(xl, norm_mix[layer]), mod_l[0], mod_l[1])
        yc, yl = token_mixer(hc, hl, need_ctx, rope_gqa, rope_mla, w_in[layer], gqa_q_norm[layer],
                             gqa_k_norm[layer], conv_w[layer], conv_b[layer], lru_w_a[layer], lru_b_a[layer],
                             lru_w_i[layer], lru_b_i[layer], lru_lam[layer], mla_q_a_norm[layer],
                             mla_w_qb[layer], mla_kv_a_norm[layer], mla_w_kvb[layer], w_branch_attn[layer],
                             w_branch_lru[layer], w_branch_mla[layer], w_out[layer])
        xl = xl + mod_l[2] * yl
        hl = modulate(rms_norm(xl, norm_ffn[layer]), mod_l[3], mod_l[4])
        if need_ctx:
            xc = xc + mod_c[2] * yc
            hc = modulate(rms_norm(xc, norm_ffn[layer]), mod_c[3], mod_c[4])
            f = moe_ffn(jnp.concatenate([hc, hl], axis=1), router_w, router_bias,
                        moe_w_gate[layer], moe_w_up[layer], moe_w_down[layer])
            xc = xc + mod_c[5] * f[:, :n_ctx]
            xl = xl + mod_l[5] * f[:, n_ctx:]
        else:
            xl = xl + mod_l[5] * moe_ffn(hl, router_w, router_bias, moe_w_gate[layer], moe_w_up[layer],
                                         moe_w_down[layer])
    return rms_norm(xl, final_norm)
```

```cpp
#include <hip/hip_runtime.h>
#include <cstdio>
#include <cstdint>

#ifndef MK_PER_PHASE
#define MK_PER_PHASE 0
#endif

namespace mk {
#define LAS __attribute__((address_space(3)))
#define GAS __attribute__((address_space(1)))
typedef unsigned short bf16_t;
typedef short bf16x8 __attribute__((ext_vector_type(8)));
typedef short s16x4 __attribute__((ext_vector_type(4)));
typedef float f32x4 __attribute__((ext_vector_type(4)));
typedef float f32x2 __attribute__((ext_vector_type(2)));
typedef float f32x16 __attribute__((ext_vector_type(16)));
typedef unsigned u32x4 __attribute__((ext_vector_type(4)));
typedef unsigned u32x2 __attribute__((ext_vector_type(2)));

constexpr int D = 1024, NB = 8, SEQ = 2048, CTXL = 256, TT = CTXL + SEQ, MALL = NB * TT, NRT = MALL / 256;
constexpr int DEPTH = 2, INW = 5536;
constexpr int OFF_Q = 0, OFF_K = 512, OFF_V = 640, OFF_X = 768, OFF_Y = 1280, OFF_CQ = 1792, OFF_CKV = 2176, OFF_KR = 2432, OFF_G = 2464;
constexpr float EPS = 1e-6f, LOG2E = 1.4426950408889634f;
constexpr float C2Q = 0.125f * LOG2E;
constexpr float C2M = 0.10206207261596575f * LOG2E;
constexpr int NWAVES = 8, NTHR = 512;
constexpr int MAXSLOT = 40960, MAXTILE = 160;
constexpr int NCH = TT / 64;

constexpr size_t MiB = 1u << 20;
constexpr size_t WS_CTL = 0, CTL_BYTES = 1 * MiB;
constexpr int CW_BAR = 1024;
constexpr int CW_CNT = 8192;
constexpr size_t WS_MOD = 1 * MiB;
constexpr size_t WS_TAB64 = WS_MOD + 2 * 9 * 6 * D * 4;
constexpr size_t WS_TAB32 = WS_TAB64 + 64 * 16 * 8;
constexpr size_t WS_ROUTE = WS_TAB32 + 64 * 8 * 8;
constexpr size_t RT_TE = 0, RT_TW = RT_TE + MALL * 2 * 4, RT_RANK = RT_TW + MALL * 2 * 4, RT_SLOT = RT_RANK + MALL * 2 * 4, RT_SLOTW = RT_SLOT + MALL * 2 * 4,
                 RT_TILEE = RT_SLOTW + MAXSLOT * 4, RT_END = RT_TILEE + 256 * 4;
static_assert(WS_ROUTE + RT_END <= 3 * MiB, "route");
constexpr size_t WS_WLRU = 3 * MiB;
constexpr size_t WS_TOT = WS_WLRU + MiB / 2;
constexpr size_t WS_XC = 6 * MiB;
constexpr size_t WS_SSP = 14 * MiB;
constexpr size_t WS_W = 16 * MiB;
constexpr size_t W_IN = 0, W_GATE = W_IN + 2560 * 1024 * 2, W_QB = W_GATE + 3072 * 1024 * 2, W_KVB = W_QB + 768 * 640 * 2, W_BR = W_KVB + 1024 * 640 * 2,
                 W_OUT = W_BR + 3 * 1024 * 1024 * 2, W_GU = W_OUT + 1024 * 1024 * 2, W_DN = W_GU + (size_t)16 * 1024 * 1024 * 2, W_LAYER = W_DN + (size_t)16 * 1024 * 512 * 2;
static_assert(W_LAYER % 256 == 0, "w");
constexpr size_t WS_ACT0 = WS_W + 2 * W_LAYER;
constexpr size_t SZ_R1K = (size_t)MALL * 1024 * 2;
constexpr size_t WS_H = WS_ACT0;
constexpr size_t WS_QG = WS_H + SZ_R1K;
constexpr size_t WS_XM = WS_QG + SZ_R1K;
constexpr size_t WS_KB = WS_XM + SZ_R1K;
constexpr size_t WS_VB = WS_KB + (size_t)MALL * 128 * 2;
constexpr size_t WS_CQKV = WS_VB + (size_t)MALL * 128 * 2;
constexpr size_t WS_KR = WS_CQKV + (size_t)MALL * 640 * 2;
constexpr size_t WS_QM = WS_KR + (size_t)MALL * 32 * 2;
constexpr size_t WS_KVM = WS_QM + (size_t)MALL * 768 * 2;
constexpr size_t WS_END = WS_KVM + SZ_R1K;
constexpr size_t WS_MERGED = WS_KVM;
constexpr size_t WS_STASH = WS_CQKV;
static_assert(WS_STASH + (size_t)256 * 131072 <= WS_KVM, "stash");
constexpr size_t WS_H2S = WS_QG;
constexpr size_t WS_Y = WS_H2S;
static_assert(WS_H2S + (size_t)MAXSLOT * 1024 * 2 <= WS_CQKV, "h2s");
constexpr size_t WS_ACT = WS_CQKV;
static_assert(WS_ACT + (size_t)MAXSLOT * 512 * 2 <= WS_KVM, "act");
static_assert(WS_END <= (size_t)380 * MiB, "workspace must fit in sum(inputs) = 380.7 MiB");

constexpr int LDS_STAGE = 131072;
constexpr int LDS_MISC = 133120;
constexpr int LDS_BYTES = LDS_MISC + 256;

typedef __bf16 bf16x2v __attribute__((ext_vector_type(2)));
__device__ __forceinline__ unsigned cvt_pk_bf16(float lo, float hi) { const f32x2 v = {lo, hi}; const bf16x2v b = __builtin_convertvector(v, bf16x2v); return __builtin_bit_cast(unsigned, b); }
__device__ __forceinline__ float bf2f(unsigned short b) { return __uint_as_float(((unsigned)b) << 16); }
__device__ __forceinline__ float bflo(unsigned w) { return __uint_as_float(w << 16); }
__device__ __forceinline__ float bfhi(unsigned w) { return __uint_as_float(w & 0xffff0000u); }
__device__ __forceinline__ float fast_exp2(float x) { return __builtin_amdgcn_exp2f(x); }
__device__ __forceinline__ float fast_rcp(float x) { return __builtin_amdgcn_rcpf(x); }
__device__ __forceinline__ float sigmoid_f(float x) { return fast_rcp(1.f + fast_exp2(-LOG2E * x)); }
__device__ __forceinline__ float silu_f(float x) { return x * sigmoid_f(x); }
__device__ __forceinline__ float gelu_tanh_f(float x) {
    const float u = 0.7978845608028654f * (x + 0.044715f * x * x * x);
    return x * sigmoid_f(2.f * u);
}
__device__ __forceinline__ float wave_sum(float v) {
#pragma unroll
    for (int o = 1; o < 64; o <<= 1) v += __shfl_xor(v, o);
    return v;
}
__device__ __forceinline__ u32x4 pack8(f32x4 a, f32x4 b) { u32x4 w; w.x = cvt_pk_bf16(a[0], a[1]); w.y = cvt_pk_bf16(a[2], a[3]); w.z = cvt_pk_bf16(b[0], b[1]); w.w = cvt_pk_bf16(b[2], b[3]); return w; }

#define SBAR() __builtin_amdgcn_sched_barrier(0)
__device__ __forceinline__ int opaque(int x) { asm volatile("" : "+v"(x)); return x; }
__device__ __forceinline__ u32x4 ld16_sc1(const void* p) {
    const unsigned long long* q = (const unsigned long long*)p;
    const unsigned long long a = __hip_atomic_load(q, __ATOMIC_RELAXED, __HIP_MEMORY_SCOPE_AGENT), b = __hip_atomic_load(q + 1, __ATOMIC_RELAXED, __HIP_MEMORY_SCOPE_AGENT);
    return (u32x4){(unsigned)a, (unsigned)(a >> 32), (unsigned)b, (unsigned)(b >> 32)};
}
#define XB_TMO      128
#define XB_XCNT(j)  (256  + 64 * (j))
#define XB_XSUB(j)  (1280 + 64 * (j))
#define XB_XGEN(j)  (2304 + 64 * (j))
#define XB_TOP      3328
#define XB_TOPGEN   3392
#define XCD_BAR_WORDS 3456
#define XB_SPIN_CAP (1u << 18)
__device__ __forceinline__ unsigned xb_ld(unsigned* p)              { return __hip_atomic_load(p, __ATOMIC_RELAXED, __HIP_MEMORY_SCOPE_AGENT); }
__device__ __forceinline__ unsigned xb_add(unsigned* p, unsigned v) { return __hip_atomic_fetch_add(p, v, __ATOMIC_RELAXED, __HIP_MEMORY_SCOPE_AGENT); }
__device__ __forceinline__ unsigned xb_xcc_id() { return (unsigned)__builtin_amdgcn_s_getreg((3 << 11) | 20) & 0xFu; }
#define XB_SPIN(cond, bar) do { unsigned _sp = 0; while (cond) { __builtin_amdgcn_s_sleep(1); \
    if ((++_sp & 255u) == 0u) { if (xb_ld(&(bar)[XB_TMO])) break; if (_sp > XB_SPIN_CAP) { atomicAdd(&(bar)[XB_TMO], 1u); break; } } } } while (0)
struct XcdBarrier { unsigned* bar; unsigned x; volatile LAS unsigned* st; };
__device__ __forceinline__ XcdBarrier xcd_barrier_post(unsigned* bar, volatile LAS unsigned* st) {
    XcdBarrier b; b.bar = bar; b.x = xb_xcc_id(); b.st = st;
    if (threadIdx.x == 0) (void)xb_add(&bar[XB_XCNT(b.x)], 1u);
    return b;
}
__device__ __forceinline__ void xcd_barrier_complete(unsigned* bar, unsigned x, unsigned& nloc, unsigned& nx) {
    const unsigned G = gridDim.x * gridDim.y * gridDim.z;
    unsigned sum, cnt, mine, sp = 0u;
    for (;;) {
        sum = 0u; cnt = 0u; mine = 0u;
#pragma unroll
        for (unsigned j = 0; j < 16; ++j) { const unsigned c = xb_ld(&bar[XB_XCNT(j)]); sum += c; cnt += (c > 0u) ? 1u : 0u; mine = (j == x) ? c : mine; }
        if (sum == G) break;
        __builtin_amdgcn_s_sleep(1);
        if ((++sp & 255u) == 0u) { if (xb_ld(&bar[XB_TMO])) break; if (sp > XB_SPIN_CAP) { atomicAdd(&bar[XB_TMO], 1u); break; } }
    }
    nloc = mine > 0u ? mine : 1u; nx = cnt > 0u ? cnt : 1u;
}
__device__ __forceinline__ void xcd_barrier(const XcdBarrier& b) {
    asm volatile("s_waitcnt vmcnt(0)" ::: "memory");
    __syncthreads();
    if (threadIdx.x == 0) {
        unsigned* bar = b.bar;
        __builtin_amdgcn_s_waitcnt(0);
        unsigned nloc = b.st[0], nx = b.st[1];
        if (nloc == 0u) { xcd_barrier_complete(bar, b.x, nloc, nx); b.st[0] = nloc; b.st[1] = nx; }
        const unsigned old = xb_add(&bar[XB_XSUB(b.x)], 1u);
        const unsigned gen = old / nloc;
        if (old + 1u == (gen + 1u) * nloc) {
            __builtin_amdgcn_fence(__ATOMIC_RELEASE, "agent");
            asm volatile("s_waitcnt vmcnt(0)" ::: "memory");
            const unsigned og = xb_add(&bar[XB_TOP], 1u);
            const unsigned tg = og / nx;
            if (og + 1u == (tg + 1u) * nx) xb_add(&bar[XB_TOPGEN], 1u);
            else XB_SPIN(xb_ld(&bar[XB_TOPGEN]) == tg, bar);
            __builtin_amdgcn_fence(__ATOMIC_ACQUIRE, "agent");
            xb_add(&bar[XB_XGEN(b.x)], 1u);
            asm volatile("s_waitcnt vmcnt(0)" ::: "memory");
        } else {
            XB_SPIN(xb_ld(&bar[XB_XGEN(b.x)]) == gen, bar);
            __builtin_amdgcn_fence(__ATOMIC_ACQUIRE, "agent");
            asm volatile("s_waitcnt vmcnt(0)" ::: "memory");
        }
    }
    __syncthreads();
}

constexpr int BM = 256, BK = 64, HALF = 128, HTB = HALF * BK * 2, STAGE_BYTES = 8 * HTB, NXCD = 8, WGM = 8;
__host__ __device__ __forceinline__ int lds_byte(int r, int c) { const int st = (r >> 4) * 2 + (c >> 5), rr = r & 15, cc = c & 31, ob = rr * 64 + cc * 2; return st * 1024 + (ob ^ (((ob >> 9) & 1) << 5)); }
__host__ __device__ __forceinline__ void stage_rc(int b, int& R, int& C) { const int st = b / 1024, sb = b % 1024, swz = sb ^ (((sb >> 9) & 1) << 5); R = (st >> 1) * 16 + swz / 64; C = (st & 1) * 32 + (swz % 64) / 2; }
__host__ __device__ __forceinline__ int perm32(int rho) { const int n = rho >> 4, i = rho & 15; return 8 * (i >> 2) + 4 * n + (i & 3); }

struct Unit { const char* A; const char* B; int nt; int pm, pn, kind; };

__device__ __forceinline__ void rect_order(int L, int nM, int nN, int& im, int& in_) {
    const int nwg = nM * nN;
    int wgid = L; { const int q = nwg / NXCD, r = nwg % NXCD, xcd = wgid % NXCD, off = wgid / NXCD; wgid = (xcd < r ? xcd * (q + 1) : r * (q + 1) + (xcd - r) * q) + off; }
    const int nig = WGM * nN, gid = wgid / nig, fm = gid * WGM, gsz = (nM - fm) < WGM ? (nM - fm) : WGM;
    im = fm + ((wgid % nig) % gsz); in_ = (wgid % nig) / gsz;
}

template <int PA, int PB, class Epi, class Sched>
__device__ __forceinline__ void gemm_stream(LAS unsigned char* lds, const Sched& S, const Epi& E) {
    const int tid = opaque(threadIdx.x), wid = __builtin_amdgcn_readfirstlane(tid >> 6), lane = tid & 63, wr = wid >> 2, wc = wid & 3, fr = lane & 15, fq = lane >> 4;
    unsigned voffA[2], voffB[2];
#pragma unroll
    for (int i = 0; i < 2; ++i) { int R, C; stage_rc(tid * 16 + i * 8192, R, C); const int Rb = Epi::PERM ? ((R & ~31) + perm32(R & 31)) : R;
        voffA[i] = (unsigned)(R * PA + C) * 2u; voffB[i] = (unsigned)(Rb * PB + C) * 2u; }
    constexpr size_t kstep = (size_t)(BK * 2);
    constexpr size_t hstepA = (size_t)HALF * PA * 2, hstepB = (size_t)HALF * PB * 2;
    const unsigned ldsw = (unsigned)wid * 1024u;
    const int aoff = lds_byte(wr * 64 + fr, fq * 8), boff = lds_byte(wc * 32 + fr, fq * 8);
#define G_SA(b, h) (((b) * 2 + (h)) * HTB)
#define G_SB(b, h) ((4 + (b) * 2 + (h)) * HTB)
#define G_STAGE(bufoff, gbase, voff) do { _Pragma("unroll") for (int _i = 0; _i < 2; ++_i) \
        __builtin_amdgcn_global_load_lds((const unsigned*)((const char*)(gbase) + (voff)[_i]), (LAS unsigned*)(lds + (bufoff) + ldsw + _i * 8192), 16, 0, 0); } while (0)
#define G_LDA(dst, b, h) do { _Pragma("unroll") for (int m = 0; m < 4; ++m) _Pragma("unroll") for (int k = 0; k < 2; ++k) dst[m][k] = *(const LAS bf16x8*)(lds + G_SA(b, h) + aoff + m * 2048 + k * 1024); } while (0)
#define G_LDB(dst, b, h) do { _Pragma("unroll") for (int n = 0; n < 2; ++n) _Pragma("unroll") for (int k = 0; k < 2; ++k) dst[n][k] = *(const LAS bf16x8*)(lds + G_SB(b, h) + boff + n * 2048 + k * 1024); } while (0)
#define G_MMA(ai, bj, At, Bt) do { __builtin_amdgcn_s_setprio(1); _Pragma("unroll") for (int m = 0; m < 4; ++m) _Pragma("unroll") for (int n = 0; n < 2; ++n) _Pragma("unroll") for (int k = 0; k < 2; ++k) \
        acc[ai][bj][m][n] = __builtin_amdgcn_mfma_f32_16x16x32_bf16(Bt[n][k], At[m][k], acc[ai][bj][m][n], 0, 0, 0); __builtin_amdgcn_s_setprio(0); } while (0)
#define G_WAIT_V(n) asm volatile("s_waitcnt vmcnt(" #n ")" ::: "memory")
#define G_WAIT_L(n) asm volatile("s_waitcnt lgkmcnt(" #n ")" ::: "memory")
#define G_BAR __builtin_amdgcn_s_barrier()
#define G_SCHED __builtin_amdgcn_sched_barrier(0)
    Unit cur, nxt; int ui = 0;
    if (!S.next(0, cur)) return;
    f32x4 acc[2][2][4][2];
#pragma unroll
    for (int a = 0; a < 2; ++a)
#pragma unroll
        for (int b = 0; b < 2; ++b)
#pragma unroll
            for (int m = 0; m < 4; ++m)
#pragma unroll
                for (int n = 0; n < 2; ++n) acc[a][b][m][n] = (f32x4){0.f, 0.f, 0.f, 0.f};
    bf16x8 At[4][2], B0[2][2], B1[2][2];
    const char* cA = cur.A; const char* cB = cur.B;
    G_STAGE(G_SB(0, 0), cB, voffB); G_STAGE(G_SB(0, 1), cB + hstepB, voffB); G_STAGE(G_SA(0, 0), cA, voffA); G_STAGE(G_SA(0, 1), cA + hstepA, voffA);
    if (wr == 1) G_BAR;
    G_WAIT_V(2); G_BAR;
    G_STAGE(G_SB(1, 0), cB + kstep, voffB); G_STAGE(G_SA(1, 0), cA + kstep, voffA); G_STAGE(G_SB(1, 1), cB + hstepB + kstep, voffB);
    G_WAIT_V(6); G_BAR;
    for (;;) {
        const bool has_next = S.next(ui + 1, nxt);
        const char* nA = has_next ? nxt.A : cA; const char* nB = has_next ? nxt.B : cB;
        const int nt = cur.nt;
        for (int t = 0; t < nt; t += 2) {
            const bool last = (t == nt - 2);
            const char* a1 = cA + (size_t)(t + 1) * kstep;
            const char* a2 = last ? nA : cA + (size_t)(t + 2) * kstep; const char* b2 = last ? nB : cB + (size_t)(t + 2) * kstep;
            const char* a3 = a2 + kstep; const char* b3 = b2 + kstep;
            G_LDB(B0, 0, 0); G_LDB(B1, 0, 1); G_SCHED; G_LDA(At, 0, 0); G_STAGE(G_SA(1, 1), a1 + hstepA, voffA);
            G_WAIT_V(8); G_WAIT_L(0); G_BAR; G_MMA(0, 0, At, B0); G_MMA(0, 1, At, B1); G_BAR; G_SCHED;
            G_LDA(At, 0, 1); G_STAGE(G_SB(0, 0), b2, voffB); G_STAGE(G_SB(0, 1), b2 + hstepB, voffB); G_STAGE(G_SA(0, 0), a2, voffA);
            G_WAIT_V(8); G_WAIT_L(0); G_BAR; G_MMA(1, 0, At, B0); G_MMA(1, 1, At, B1); G_BAR; G_SCHED;
            G_LDB(B0, 1, 0); G_LDB(B1, 1, 1); G_SCHED; G_LDA(At, 1, 0); G_STAGE(G_SA(0, 1), a2 + hstepA, voffA);
            G_WAIT_V(8); G_WAIT_L(0); G_BAR; G_MMA(0, 0, At, B0); G_MMA(0, 1, At, B1); G_BAR; G_SCHED;
            G_LDA(At, 1, 1); G_STAGE(G_SB(1, 0), b3, voffB); G_STAGE(G_SB(1, 1), b3 + hstepB, voffB); G_STAGE(G_SA(1, 0), a3, voffA);
            G_WAIT_V(8); G_WAIT_L(0); G_BAR; G_MMA(1, 0, At, B0); G_MMA(1, 1, At, B1); G_BAR; G_SCHED;
        }
        if (wr == 0) G_BAR;
        E(acc, cur, wr, wc, fr, fq);
        if (!has_next) break;
#pragma unroll
        for (int a = 0; a < 2; ++a)
#pragma unroll
            for (int b = 0; b < 2; ++b)
#pragma unroll
                for (int m = 0; m < 4; ++m)
#pragma unroll
                    for (int n = 0; n < 2; ++n) acc[a][b][m][n] = (f32x4){0.f, 0.f, 0.f, 0.f};
        cur = nxt; cA = nA; cB = nB; ++ui;
        if (wr == 1) G_BAR;
    }
    G_WAIT_V(0);
    G_BAR;
#undef G_SA
#undef G_SB
#undef G_STAGE
#undef G_LDA
#undef G_LDB
#undef G_MMA
#undef G_WAIT_V
#undef G_WAIT_L
#undef G_BAR
#undef G_SCHED
}

struct Args { const float* in[32]; float* out; unsigned char* ws; int ph_lo, ph_hi; };
enum { I_X = 0, I_C, I_CTX, I_CCTX, I_WMOD, I_BMOD, I_NMIX, I_NFFN, I_WIN, I_GQN, I_GKN, I_CONVW, I_CONVB, I_LWA, I_LBA, I_LWI, I_LBI, I_LLAM,
       I_MQN, I_WQB, I_MKVN, I_WKVB, I_WBA, I_WBL, I_WBM, I_WOUT, I_RW, I_RB, I_MG, I_MU, I_MD, I_FN };
struct Frame {
    LAS unsigned char* lds; unsigned char* ws; const float* const* in; float* out;
    int tid, lane, wave, G, bx;
};
#define WSP(T, off) ((T*)(F.ws + (off)))
#define CTLW(idx) (((unsigned*)(F.ws + WS_CTL)) + (idx))
__device__ __forceinline__ float* xrow_ptr(const Frame& F, int r) {
    const int b = r / TT, t = r - b * TT;
    return t < CTXL ? WSP(float, WS_XC) + ((size_t)b * CTXL + t) * D : F.out + ((size_t)b * SEQ + (t - CTXL)) * D;
}
__device__ __forceinline__ const float* mod_ptr(const Frame& F, int l, int r, int which) {
    const int b = r / TT, t = r - b * TT; const int mr = t < CTXL ? 8 : b;
    return WSP(const float, WS_MOD) + ((size_t)(l * 9 + mr) * 6 + which) * D;
}

__device__ __forceinline__ int src_col_in(int p) {
    const int tile = p >> 8, q = p & 255, bj = q >> 7, wc = (q >> 5) & 3, s = q & 31, fq = s >> 3, n = (s >> 2) & 1, j = s & 3;
    const int hd = 32 * bj + 16 * n + 4 * fq + j;
    switch (tile) {
        case 0: case 1: return OFF_Q + (4 * tile + wc) * 64 + hd;
        case 2: return wc < 2 ? OFF_K + wc * 64 + hd : OFF_V + (wc - 2) * 64 + 32 * bj + s;
        case 3: case 4: return OFF_X + (tile - 3) * 256 + q;
        case 5: case 6: return OFF_Y + (tile - 5) * 256 + q;
        case 7: return OFF_CQ + q;
        case 8: return q < 128 ? OFF_CQ + 256 + q : OFF_CKV + (q - 128);
        default: if (q < 128) return OFF_CKV + 128 + q;
                 if (q < 160) return OFF_KR + 16 * n + 8 * (j >> 1) + 2 * fq + (j & 1);
                 return -1;
    }
}
__device__ __forceinline__ int rope32_dim(int s) { const int fq = s >> 3, n = (s >> 2) & 1, j = s & 3; return 16 * n + 8 * (j >> 1) + 2 * fq + (j & 1); }

struct WMat { int rows, K, pitch, nkb, items; };
__device__ __forceinline__ void p0_weights(const Frame& F) {
    constexpr int NI_IN = 40 * 8, NI_GATE = 48 * 8, NI_QB = 12 * 3, NI_KVB = 16 * 2, NI_BR = 3 * 16 * 4, NI_OUT = 16 * 8, NI_GU = 256 * 8, NI_DN = 256 * 4;
    constexpr int NI_L = NI_IN + NI_GATE + NI_QB + NI_KVB + NI_BR + NI_OUT + NI_GU + NI_DN;
    LAS unsigned char* tile = F.lds;
    const int tid_ = opaque(F.tid); const int pl = tid_ & 63, kg = tid_ >> 6;
    for (int it = F.bx; it < 2 * NI_L; it += F.G) {
        const int l = it / NI_L; int r = it - l * NI_L;
        const float* src; int ld, K, pitch, nkb; bf16_t* dst; int kind; const float* ksc = nullptr;
        unsigned char* wl = F.ws + WS_W + (size_t)l * W_LAYER;
        if (r < NI_IN) { kind = 0; src = F.in[I_WIN] + (size_t)l * D * INW; ld = INW; K = 1024; pitch = 1024; nkb = 8; dst = (bf16_t*)(wl + W_IN); }
        else if ((r -= NI_IN) < NI_GATE) { kind = 1; src = F.in[I_WIN] + (size_t)l * D * INW; ld = INW; K = 1024; pitch = 1024; nkb = 8; dst = (bf16_t*)(wl + W_GATE); }
        else if ((r -= NI_GATE) < NI_QB) { kind = 2; src = F.in[I_WQB] + (size_t)l * 384 * 768; ld = 768; K = 384; pitch = 640; nkb = 3; dst = (bf16_t*)(wl + W_QB); ksc = F.in[I_MQN] + l * 384; }
        else if ((r -= NI_QB) < NI_KVB) { kind = 3; src = F.in[I_WKVB] + (size_t)l * 256 * 1024; ld = 1024; K = 256; pitch = 640; nkb = 2; dst = (bf16_t*)(wl + W_KVB); ksc = F.in[I_MKVN] + l * 256; }
        else if ((r -= NI_KVB) < NI_BR) { kind = 4; const int b = r / 64; r -= b * 64; src = F.in[I_WBA + b] + (size_t)l * 512 * D; ld = D; K = 512; pitch = 1024; nkb = 4; dst = (bf16_t*)(wl + W_BR) + (size_t)b * 1024 * 1024; }
        else if ((r -= NI_BR) < NI_OUT) { kind = 5; src = F.in[I_WOUT] + (size_t)l * D * D; ld = D; K = 1024; pitch = 1024; nkb = 8; dst = (bf16_t*)(wl + W_OUT); }
        else if ((r -= NI_OUT) < NI_GU) { kind = 6; src = nullptr; ld = 512; K = 1024; pitch = 1024; nkb = 8; dst = (bf16_t*)(wl + W_GU); }
        else { r -= NI_GU; kind = 7; src = nullptr; ld = D; K = 512; pitch = 512; nkb = 4; dst = (bf16_t*)(wl + W_DN); }
        const int rb = r / nkb, kb = r - rb * nkb, p0 = rb * 64, k0 = kb * 128, p = p0 + pl;
        int col;
        switch (kind) {
            case 0: col = src_col_in(p); break;
            case 1: col = OFF_G + p; break;
            case 2: col = p < 512 ? (p >> 6) * 96 + (p & 63) : (4 * (((p - 512) >> 7)) + (((p - 512) >> 5) & 3)) * 96 + 64 + rope32_dim((p - 512) & 31); break;
            case 3: col = p < 512 ? (p >> 6) * 128 + (p & 63) : ((p - 512) >> 6) * 128 + 64 + ((p - 512) & 63); break;
            case 6: { const int e = p >> 10, pp = p & 1023, t4 = pp >> 8, q = pp & 255;
                      src = F.in[q < 128 ? I_MG : I_MU] + ((size_t)l * 16 + e) * D * 512; col = t4 * 128 + (q & 127); } break;
            case 7: { const int e = p >> 10; src = F.in[I_MD] + ((size_t)l * 16 + e) * 512 * D; col = p & 1023; } break;
            default: col = p; break;
        }
        float v[16];
#pragma unroll
        for (int i = 0; i < 16; ++i) { const int k = k0 + kg * 16 + i; float x = col >= 0 ? src[(size_t)k * ld + col] : 0.f; if (ksc) x *= ksc[k]; v[i] = x; }
        u32x4 w0, w1;
        w0.x = cvt_pk_bf16(v[0], v[1]); w0.y = cvt_pk_bf16(v[2], v[3]); w0.z = cvt_pk_bf16(v[4], v[5]); w0.w = cvt_pk_bf16(v[6], v[7]);
        w1.x = cvt_pk_bf16(v[8], v[9]); w1.y = cvt_pk_bf16(v[10], v[11]); w1.z = cvt_pk_bf16(v[12], v[13]); w1.w = cvt_pk_bf16(v[14], v[15]);
        *(LAS u32x4*)(tile + pl * 272 + kg * 32) = w0; *(LAS u32x4*)(tile + pl * 272 + kg * 32 + 16) = w1;
        __syncthreads();
#pragma unroll
        for (int i = 0; i < 2; ++i) { const int id = tid_ + i * 512, row = id >> 4, ch = id & 15;
            *(u32x4*)(dst + (size_t)(p0 + row) * pitch + k0 + ch * 8) = *(LAS u32x4*)(tile + row * 272 + ch * 16); }
        __syncthreads();
    }
}
__device__ __forceinline__ void p0_misc(const Frame& F) {
    const int gt = F.bx * NTHR + opaque(F.tid), GT = F.G * NTHR;
    bf16_t* wl = WSP(bf16_t, WS_WLRU);
    for (int i = gt; i < 2 * 2 * 2 * 8 * 64 * 64; i += GT) {
        const int k = i & 63, j = (i >> 6) & 63, n = (i >> 12) & 7, g = (i >> 15) & 1, d = (i >> 16) & 1, l = i >> 17;
        const float x = F.in[g ? I_LWI : I_LWA][((((size_t)(l * 2 + d) * 8 + n) * 64 + k) * 64) + j];
        wl[i] = (bf16_t)(cvt_pk_bf16(x, 0.f) & 0xffffu);
    }
    f32x2* t64 = WSP(f32x2, WS_TAB64); f32x2* t32 = WSP(f32x2, WS_TAB32);
    for (int i = gt; i < 64 * 16 + 64 * 8; i += GT) {
        if (i < 1024) { const int p = i >> 4, q = i & 15; const float a = (float)p * exp2f(-13.287712379549449f * (float)q / 16.f); t64[i] = (f32x2){cosf(a), sinf(a)}; }
        else { const int ii = i - 1024, p = ii >> 3, q = ii & 7; const float a = (float)p * exp2f(-13.287712379549449f * (float)q / 8.f); t32[ii] = (f32x2){cosf(a), sinf(a)}; }
    }
}
__device__ __forceinline__ void p0_mod(const Frame& F) {
    LAS float* sv = (LAS float*)F.lds;
    LAS float* red = (LAS float*)(F.lds + 9 * 1024 * 4);
    if (F.bx >= 192) return;
    const int tid = opaque(F.tid);
    for (int i = tid; i < 9 * 1024; i += NTHR) { const int r = i >> 10, k = i & 1023; const float x = r < 8 ? F.in[I_C][r * D + k] : F.in[I_CCTX][k]; sv[i] = silu_f(x); }
    __syncthreads();
    for (int it = F.bx; it < 192; it += F.G) {
        const int l = it / 96, n0 = (it % 96) * 64, col = tid & 63, kg = tid >> 6;
        const float* w = F.in[I_WMOD] + (size_t)l * D * 6 * D + n0 + col;
        float acc[9];
#pragma unroll
        for (int r = 0; r < 9; ++r) acc[r] = 0.f;
#pragma unroll 4
        for (int k = kg * 128; k < kg * 128 + 128; ++k) { const float wv = w[(size_t)k * 6 * D];
#pragma unroll
            for (int r = 0; r < 9; ++r) acc[r] += sv[r * 1024 + k] * wv; }
#pragma unroll
        for (int r = 0; r < 9; ++r) red[(kg * 9 + r) * 64 + col] = acc[r];
        __syncthreads();
        for (int o = tid; o < 9 * 64; o += NTHR) { const int r = o >> 6, c = o & 63; float s = F.in[I_BMOD][l * 6 * D + n0 + c];
#pragma unroll
            for (int g = 0; g < 8; ++g) s += red[(g * 9 + r) * 64 + c];
            WSP(float, WS_MOD)[((size_t)(l * 9 + r)) * 6 * D + n0 + c] = s; }
        __syncthreads();
    }
}

struct RowV { f32x4 v[4]; };
__device__ __forceinline__ RowV row_load(const float* p, int lane) { RowV r; const f32x4* q = (const f32x4*)p + lane;
#pragma unroll
    for (int j = 0; j < 4; ++j) r.v[j] = q[64 * j]; return r; }
__device__ __forceinline__ void row_store(float* p, int lane, const RowV& r) { f32x4* q = (f32x4*)p + lane;
#pragma unroll
    for (int j = 0; j < 4; ++j) q[64 * j] = r.v[j]; }
__device__ __forceinline__ float row_rstd(const RowV& r) { float s = 0.f;
#pragma unroll
    for (int j = 0; j < 4; ++j) s += (r.v[j][0] * r.v[j][0] + r.v[j][1] * r.v[j][1]) + (r.v[j][2] * r.v[j][2] + r.v[j][3] * r.v[j][3]);
    return rsqrtf(wave_sum(s) * (1.f / D) + EPS); }
__device__ __forceinline__ RowV row_normmod(const RowV& x, float rstd, const float* g, const float* shift, const float* scale, int lane) {
    RowV y;
#pragma unroll
    for (int j = 0; j < 4; ++j) { const f32x4 gv = ((const f32x4*)g)[lane + 64 * j]; f32x4 t = x.v[j] * rstd * gv;
        if (scale) { const f32x4 sc = ((const f32x4*)scale)[lane + 64 * j], sh = ((const f32x4*)shift)[lane + 64 * j]; t = t * (sc + 1.f) + sh; }
        y.v[j] = t; }
    return y;
}
__device__ __forceinline__ void row_store_bf16(bf16_t* p, int lane, const RowV& r) { u32x2* q = (u32x2*)p + lane;
#pragma unroll
    for (int j = 0; j < 4; ++j) { u32x2 w; w.x = cvt_pk_bf16(r.v[j][0], r.v[j][1]); w.y = cvt_pk_bf16(r.v[j][2], r.v[j][3]); q[64 * j] = w; } }
__device__ __forceinline__ RowV row_load_bf16(const bf16_t* p, int lane) { RowV r; const u32x2* q = (const u32x2*)p + lane;
#pragma unroll
    for (int j = 0; j < 4; ++j) { const u32x2 w = q[64 * j]; r.v[j] = (f32x4){bflo(w.x), bfhi(w.x), bflo(w.y), bfhi(w.y)}; } return r; }

template <int MODE>
__device__ __forceinline__ void phase_rows(const Frame& F, int l) {
    const int gw = F.bx * NWAVES + F.wave, NGW = F.G * NWAVES, lane = opaque(F.lane);
    const bool last = (MODE == 1 && l == DEPTH - 1);
    const int ln = (MODE == 0) ? 0 : l + 1;
    for (int r = gw; r < MALL; r += NGW) {
        const int b = r / TT, t = r - b * TT; const bool isctx = t < CTXL;
        if (last && isctx) continue;
        float* xp = xrow_ptr(F, r);
        RowV x;
        if (MODE == 0) { x = row_load(isctx ? F.in[I_CTX] + ((size_t)b * CTXL + t) * D : F.in[I_X] + ((size_t)b * SEQ + (t - CTXL)) * D, lane); row_store(xp, lane, x); }
        else {
            x = row_load(xp, lane);
            const int* ts = WSP(const int, WS_ROUTE + RT_SLOT) + (size_t)r * 2;
            const int s0 = ts[0], s1 = ts[1];
            const RowV y0 = row_load_bf16(WSP(const bf16_t, WS_Y) + (size_t)s0 * D, lane), y1 = row_load_bf16(WSP(const bf16_t, WS_Y) + (size_t)s1 * D, lane);
            const float* gt = mod_ptr(F, l, r, 5);
#pragma unroll
            for (int j = 0; j < 4; ++j) x.v[j] = x.v[j] + ((const f32x4*)gt)[lane + 64 * j] * (y0.v[j] + y1.v[j]);
            if (!last) row_store(xp, lane, x);
        }
        const float rstd = row_rstd(x);
        if (last) { const RowV y = row_normmod(x, rstd, F.in[I_FN], nullptr, nullptr, lane); row_store(xp, lane, y); }
        else { const RowV y = row_normmod(x, rstd, F.in[I_NMIX] + ln * D, mod_ptr(F, ln, r, 0), mod_ptr(F, ln, r, 1), lane);
               row_store_bf16(WSP(bf16_t, WS_H) + (size_t)r * D, lane, y); }
    }
}

__device__ __forceinline__ void phase_router(const Frame& F, int l) {
    LAS float* rwT = (LAS float*)F.lds;
    LAS int* lcnt = (LAS int*)(F.lds + 65536);
    LAS int* rinfo = (LAS int*)(F.lds + 65536 + 256);
    const bool last = (l == DEPTH - 1); const int tid = opaque(F.tid);
    for (int i = tid; i < 16 * 1024; i += NTHR) { const int k = i >> 4, e = i & 15; rwT[e * 1024 + k] = F.in[I_RW][i]; }
    if (tid < 32) lcnt[tid] = 0;
    __syncthreads();
    const int RPW = (MALL + F.G - 1) / F.G;
    const int r0 = F.bx * RPW, r1 = (r0 + RPW < MALL) ? r0 + RPW : MALL;
    const int lane = tid & 63;
    for (int r = r0 + F.wave; r < r1; r += NWAVES) {
        const int b = r / TT, t = r - b * TT;
        int* ri = (int*)(rinfo + (r - r0) * 4);
        if (last && t < CTXL) { if (lane == 0) ri[0] = -1; continue; }
        const RowV x = row_load(xrow_ptr(F, r), lane);
        const float rstd = row_rstd(x);
        const RowV h = row_normmod(x, rstd, F.in[I_NFFN] + l * D, mod_ptr(F, l, r, 3), mod_ptr(F, l, r, 4), lane);
        row_store_bf16(WSP(bf16_t, WS_H) + (size_t)r * D, lane, h);
        float lg[16];
#pragma unroll
        for (int e = 0; e < 16; ++e) { float s = 0.f;
#pragma unroll
            for (int j = 0; j < 4; ++j) { const f32x4 w = *(const LAS f32x4*)(rwT + e * 1024 + 256 * j + 4 * lane); s += (h.v[j][0] * w[0] + h.v[j][1] * w[1]) + (h.v[j][2] * w[2] + h.v[j][3] * w[3]); }
            lg[e] = wave_sum(s); }
        float sc[16], sel[16];
#pragma unroll
        for (int e = 0; e < 16; ++e) { sc[e] = 1.f / (1.f + __expf(-lg[e])); sel[e] = sc[e] + F.in[I_RB][e]; }
        int bg = 0; float bgs = -1e30f;
#pragma unroll
        for (int g = 0; g < 4; ++g) { float m1 = -1e30f, m2 = -1e30f;
#pragma unroll
            for (int i = 0; i < 4; ++i) { const float v = sel[g * 4 + i]; if (v > m1) { m2 = m1; m1 = v; } else if (v > m2) m2 = v; }
            const float gs = m1 + m2; if (gs > bgs) { bgs = gs; bg = g; } }
        int e0 = -1, e1 = -1; float v0 = -1e30f, v1 = -1e30f, w0 = 0.f, w1 = 0.f;
#pragma unroll
        for (int e = 0; e < 16; ++e) { if ((e >> 2) == bg) { const float v = sel[e], sv = sc[e];
            if (v > v0) { v1 = v0; e1 = e0; w1 = w0; v0 = v; e0 = e; w0 = sv; } else if (v > v1) { v1 = v; e1 = e; w1 = sv; } } }
        if (lane == 0) {
            const float ws = w0 + w1;
            float* tw = WSP(float, WS_ROUTE + RT_TW) + (size_t)r * 2; tw[0] = w0 / ws; tw[1] = w1 / ws;
            int* te = WSP(int, WS_ROUTE + RT_TE) + (size_t)r * 2; te[0] = e0; te[1] = e1;
            ri[0] = e0; ri[1] = e1; ri[2] = __hip_atomic_fetch_add(&lcnt[e0], 1, __ATOMIC_RELAXED, __HIP_MEMORY_SCOPE_WORKGROUP); ri[3] = __hip_atomic_fetch_add(&lcnt[e1], 1, __ATOMIC_RELAXED, __HIP_MEMORY_SCOPE_WORKGROUP);
        }
    }
    __syncthreads();
    if (tid < 16) lcnt[16 + tid] = (int)atomicAdd(CTLW(CW_CNT + l * 64 + tid), (unsigned)lcnt[tid]);
    __syncthreads();
    for (int i = tid; i < r1 - r0; i += NTHR) { const int* ri = (const int*)(rinfo + i * 4);
        if (ri[0] >= 0) { int* rk = WSP(int, WS_ROUTE + RT_RANK) + (size_t)(r0 + i) * 2; rk[0] = lcnt[16 + ri[0]] + ri[2]; rk[1] = lcnt[16 + ri[1]] + ri[3]; } }
    __syncthreads();
}
__device__ __forceinline__ void phase_gather(const Frame& F, int l) {
    LAS int* off = (LAS int*)F.lds;
    const bool last = (l == DEPTH - 1); const int tid = opaque(F.tid);
    if (tid == 0) { int s = 0; for (int e = 0; e < 16; ++e) { off[e] = s; const int c = (int)*CTLW(CW_CNT + l * 64 + e); s += (c + 255) & ~255; } off[16] = s; }
    __syncthreads();
    if (F.bx == 0) {
        int* te = WSP(int, WS_ROUTE + RT_TILEE);
        const int nt = off[16] >> 8;
        for (int i = tid; i < nt; i += NTHR) { int e = 0;
#pragma unroll
            for (int q = 1; q < 16; ++q) e += (i * 256 >= off[q]) ? 1 : 0;
            te[i] = e; }
        if (tid == 0) te[255] = nt;
    }
    const int gw = F.bx * NWAVES + F.wave, NGW = F.G * NWAVES, lane = tid & 63;
    for (int i = gw; i < MALL * 2; i += NGW) {
        const int r = i >> 1; const int t = r % TT;
        if (last && t < CTXL) continue;
        const int e = WSP(const int, WS_ROUTE + RT_TE)[i], rk = WSP(const int, WS_ROUTE + RT_RANK)[i];
        const int slot = off[e] + rk;
        const u32x4* s = (const u32x4*)(WSP(const bf16_t, WS_H) + (size_t)r * D); u32x4* d = (u32x4*)(WSP(bf16_t, WS_H2S) + (size_t)slot * D);
        const u32x4 a = s[lane], bq = s[lane + 64]; d[lane] = a; d[lane + 64] = bq;
        if (lane == 0) { WSP(int, WS_ROUTE + RT_SLOT)[i] = slot; WSP(float, WS_ROUTE + RT_SLOTW)[slot] = WSP(const float, WS_ROUTE + RT_TW)[i]; }
    }
}

__device__ __forceinline__ int lat_tile(int j) { return (j >> 3) * 9 + 1 + (j & 7); }

struct SchedIn {
    const char* H; const char* W; int G, c; bool need_ctx;
    __device__ __forceinline__ bool next(int i, Unit& u) const {
        const int L = i * G + c; int pm, pn;
        if (need_ctx) { if (L >= NRT * 10) return false; rect_order(L, NRT, 10, pm, pn); }
        else if (L < 640) { int im; rect_order(L, 64, 10, im, pn); pm = lat_tile(im); }
        else { const int Lc = L - 640; if (Lc >= 40) return false; pm = (Lc / 5) * 9; const int q = Lc % 5; pn = q < 3 ? 2 + q : 5 + q; }
        u.pm = pm; u.pn = pn; u.kind = 0; u.nt = 16;
        u.A = H + (size_t)pm * 256 * 1024 * 2; u.B = W + (size_t)pn * 256 * 1024 * 2;
        return true;
    }
};
struct EpiIn {
    static constexpr bool PERM = true;
    bf16_t *QG, *KB, *VB, *XM, *CQKV, *KR; float *SSP; const float *qg, *kg; const f32x2 *t64, *t32;
    __device__ __forceinline__ void operator()(const f32x4 (&acc)[2][2][4][2], const Unit& u, int wr, int wc, int fr, int fq) const {
        const int pn = u.pn, pmod = u.pm % 9; const bool lat = pmod != 0;
        const int rowb = u.pm * 256 + wr * 64 + fr, tb = (pmod - 1) * 256 + wr * 64 + fr;
        if (pn <= 2) {
            if (pn == 2 && wc >= 2) {
#pragma unroll
                for (int ai = 0; ai < 2; ++ai)
#pragma unroll
                    for (int m = 0; m < 4; ++m) { const size_t row = rowb + ai * 128 + m * 16;
#pragma unroll
                        for (int bj = 0; bj < 2; ++bj) *(u32x4*)(VB + row * 128 + (wc - 2) * 64 + 32 * bj + 8 * fq) = pack8(acc[ai][bj][m][0], acc[ai][bj][m][1]); }
            } else {
                const float* g = pn < 2 ? qg : kg; const float osc = pn < 2 ? C2Q : 1.f;
                f32x4 gv[2][2];
#pragma unroll
                for (int bj = 0; bj < 2; ++bj)
#pragma unroll
                    for (int n = 0; n < 2; ++n) gv[bj][n] = *(const f32x4*)(g + 32 * bj + 16 * n + 4 * fq);
#pragma unroll
                for (int ai = 0; ai < 2; ++ai)
#pragma unroll
                    for (int m = 0; m < 4; ++m) {
                        const size_t row = rowb + ai * 128 + m * 16;
                        f32x4 v[2][2]; float ss = 0.f;
#pragma unroll
                        for (int bj = 0; bj < 2; ++bj)
#pragma unroll
                            for (int n = 0; n < 2; ++n) { v[bj][n] = acc[ai][bj][m][n]; ss += (v[bj][n][0] * v[bj][n][0] + v[bj][n][1] * v[bj][n][1]) + (v[bj][n][2] * v[bj][n][2] + v[bj][n][3] * v[bj][n][3]); }
                        ss += __shfl_xor(ss, 16); ss += __shfl_xor(ss, 32);
                        const float rs = rsqrtf(ss * (1.f / 64.f) + EPS);
#pragma unroll
                        for (int bj = 0; bj < 2; ++bj)
#pragma unroll
                            for (int n = 0; n < 2; ++n) v[bj][n] = v[bj][n] * rs * gv[bj][n];
                        if (lat) {
                            const int t = tb + ai * 128 + m * 16, pr = t >> 6, pc = t & 63;
#pragma unroll
                            for (int j = 0; j < 4; ++j) {
                                const f32x2 cr = t64[pr * 16 + 4 * fq + j], cc = t64[pc * 16 + 4 * fq + j];
                                const float a1 = v[0][0][j], a2 = v[0][1][j]; v[0][0][j] = a1 * cr.x - a2 * cr.y; v[0][1][j] = a2 * cr.x + a1 * cr.y;
                                const float b1 = v[1][0][j], b2 = v[1][1][j]; v[1][0][j] = b1 * cc.x - b2 * cc.y; v[1][1][j] = b2 * cc.x + b1 * cc.y;
                            }
                        }
                        bf16_t* dst = pn < 2 ? QG + row * 1024 + (4 * pn + wc) * 64 : KB + row * 128 + wc * 64;
#pragma unroll
                        for (int bj = 0; bj < 2; ++bj) *(u32x4*)(dst + 32 * bj + 8 * fq) = pack8(v[bj][0] * osc, v[bj][1] * osc);
                    }
            }
        } else if (pn <= 4) {
#pragma unroll
            for (int ai = 0; ai < 2; ++ai)
#pragma unroll
                for (int m = 0; m < 4; ++m) { const size_t row = rowb + ai * 128 + m * 16;
#pragma unroll
                    for (int bj = 0; bj < 2; ++bj) *(u32x4*)(XM + row * 1024 + (pn - 3) * 256 + 128 * bj + 32 * wc + 8 * fq) = pack8(acc[ai][bj][m][0], acc[ai][bj][m][1]); }
        } else if (pn <= 6) {
#pragma unroll
            for (int ai = 0; ai < 2; ++ai)
#pragma unroll
                for (int m = 0; m < 4; ++m) { const size_t row = rowb + ai * 128 + m * 16;
#pragma unroll
                    for (int bj = 0; bj < 2; ++bj) { f32x4 a = acc[ai][bj][m][0], b = acc[ai][bj][m][1];
#pragma unroll
                        for (int j = 0; j < 4; ++j) { a[j] = gelu_tanh_f(a[j]); b[j] = gelu_tanh_f(b[j]); }
                        *(u32x4*)(QG + row * 1024 + 512 + (pn - 5) * 256 + 128 * bj + 32 * wc + 8 * fq) = pack8(a, b); } }
        } else {
#pragma unroll
            for (int bj = 0; bj < 2; ++bj) {
                const int sec = pn == 7 ? 0 : (pn == 8 ? bj : 1 + bj);
                if (sec == 2) {
                    if (wc != 0) continue;
#pragma unroll
                    for (int ai = 0; ai < 2; ++ai)
#pragma unroll
                        for (int m = 0; m < 4; ++m) { const size_t row = rowb + ai * 128 + m * 16;
                            f32x4 v[2] = {acc[ai][1][m][0], acc[ai][1][m][1]};
                            if (lat) { const int t = tb + ai * 128 + m * 16, pr = t >> 6, pc = t & 63;
#pragma unroll
                                for (int j = 0; j < 2; ++j) { const f32x2 cr = t32[pr * 8 + 2 * fq + j], cc = t32[pc * 8 + 2 * fq + j];
                                    const float a1 = v[0][j], a2 = v[0][j + 2]; v[0][j] = a1 * cr.x - a2 * cr.y; v[0][j + 2] = a2 * cr.x + a1 * cr.y;
                                    const float b1 = v[1][j], b2 = v[1][j + 2]; v[1][j] = b1 * cc.x - b2 * cc.y; v[1][j + 2] = b2 * cc.x + b1 * cc.y; } }
                            *(u32x4*)(KR + row * 32 + 8 * fq) = pack8(v[0], v[1]); }
                } else {
                    const int colb = (pn == 7 ? 128 * bj : (pn == 8 ? (bj == 0 ? 256 : 384) : 384 + 128)) + 32 * wc + 8 * fq;
                    const int grp = (pn == 7 ? 4 * bj : (pn == 8 ? (bj == 0 ? 8 : 12) : 16)) + wc;
#pragma unroll
                    for (int ai = 0; ai < 2; ++ai)
#pragma unroll
                        for (int m = 0; m < 4; ++m) { const size_t row = rowb + ai * 128 + m * 16;
                            const f32x4 a = acc[ai][bj][m][0], b = acc[ai][bj][m][1];
                            *(u32x4*)(CQKV + row * 640 + colb) = pack8(a, b);
                            float ss = (a[0] * a[0] + a[1] * a[1]) + (a[2] * a[2] + a[3] * a[3]) + (b[0] * b[0] + b[1] * b[1]) + (b[2] * b[2] + b[3] * b[3]);
                            ss += __shfl_xor(ss, 16); ss += __shfl_xor(ss, 32);
                            if (fq == 0) SSP[row * 20 + grp] = ss; }
                }
            }
        }
    }
};

struct SchedQKV {
    const char* CQKV; const char* WQ; const char* WKV; int G, c; bool need_ctx;
    __device__ __forceinline__ bool next(int i, Unit& u) const {
        const int L = i * G + c; const int nq = need_ctx ? NRT : 64;
        if (L < nq * 3) { int im, pn; rect_order(L, nq, 3, im, pn); const int pm = need_ctx ? im : lat_tile(im);
            u.pm = pm; u.pn = pn; u.kind = 0; u.nt = 6; u.A = CQKV + (size_t)pm * 256 * 640 * 2; u.B = WQ + (size_t)pn * 256 * 640 * 2; return true; }
        const int L2 = L - nq * 3; if (L2 >= NRT * 4) return false;
        int pm, pn; rect_order(L2, NRT, 4, pm, pn);
        u.pm = pm; u.pn = pn; u.kind = 1; u.nt = 4; u.A = CQKV + (size_t)pm * 256 * 640 * 2 + 384 * 2; u.B = WKV + (size_t)pn * 256 * 640 * 2; return true;
    }
};
struct EpiQKV {
    static constexpr bool PERM = true;
    bf16_t *QM, *KVM; const float *SSP; const f32x2* t32;
    __device__ __forceinline__ void operator()(const f32x4 (&acc)[2][2][4][2], const Unit& u, int wr, int wc, int fr, int fq) const {
        const int pn = u.pn, pmod = u.pm % 9; const bool lat = pmod != 0;
        const int rowb = u.pm * 256 + wr * 64 + fr, tb = (pmod - 1) * 256 + wr * 64 + fr;
#pragma unroll
        for (int ai = 0; ai < 2; ++ai)
#pragma unroll
            for (int m = 0; m < 4; ++m) {
                const size_t row = rowb + ai * 128 + m * 16;
                if (u.kind == 1) {
                    const f32x4 s0 = *(const f32x4*)(SSP + row * 20 + 12), s1 = *(const f32x4*)(SSP + row * 20 + 16);
                    const float rs = rsqrtf((((s0[0] + s0[1]) + (s0[2] + s0[3])) + ((s1[0] + s1[1]) + (s1[2] + s1[3]))) * (1.f / 256.f) + EPS);
#pragma unroll
                    for (int bj = 0; bj < 2; ++bj) *(u32x4*)(KVM + row * 1024 + pn * 256 + 128 * bj + 32 * wc + 8 * fq) = pack8(acc[ai][bj][m][0] * rs, acc[ai][bj][m][1] * rs);
                } else {
                    const f32x4 s0 = *(const f32x4*)(SSP + row * 20), s1 = *(const f32x4*)(SSP + row * 20 + 4), s2 = *(const f32x4*)(SSP + row * 20 + 8);
                    const float rs = rsqrtf((((s0[0] + s0[1]) + (s0[2] + s0[3])) + ((s1[0] + s1[1]) + (s1[2] + s1[3])) + ((s2[0] + s2[1]) + (s2[2] + s2[3]))) * (1.f / 384.f) + EPS);
                    if (pn < 2) {
#pragma unroll
                        for (int bj = 0; bj < 2; ++bj) *(u32x4*)(QM + row * 768 + pn * 256 + 128 * bj + 32 * wc + 8 * fq) = pack8(acc[ai][bj][m][0] * (rs * C2M), acc[ai][bj][m][1] * (rs * C2M));
                    } else {
                        const int t = tb + ai * 128 + m * 16, pr = t >> 6, pc = t & 63;
#pragma unroll
                        for (int bj = 0; bj < 2; ++bj) {
                            f32x4 v[2] = {acc[ai][bj][m][0] * rs, acc[ai][bj][m][1] * rs};
                            if (lat) {
#pragma unroll
                                for (int j = 0; j < 2; ++j) { const f32x2 cr = t32[pr * 8 + 2 * fq + j], cc = t32[pc * 8 + 2 * fq + j];
                                    const float a1 = v[0][j], a2 = v[0][j + 2]; v[0][j] = a1 * cr.x - a2 * cr.y; v[0][j + 2] = a2 * cr.x + a1 * cr.y;
                                    const float b1 = v[1][j], b2 = v[1][j + 2]; v[1][j] = b1 * cc.x - b2 * cc.y; v[1][j + 2] = b2 * cc.x + b1 * cc.y; } }
                            *(u32x4*)(QM + row * 768 + 512 + (4 * bj + wc) * 32 + 8 * fq) = pack8(v[0] * C2M, v[1] * C2M);
                        }
                    }
                }
            }
    }
};

struct SchedMerge {
    const char *H, *QG, *XM, *WG, *WB; int G, c; bool need_ctx;
    __device__ __forceinline__ bool next(int i, Unit& u) const {
#ifdef MK_DBG_GATEONLY
        const int ti = i / 3, sub = 2 * (i - ti * 3), L = ti * G + c; const int nq = need_ctx ? NRT : 64;
#else
        const int ti = i / 6, sub = i - ti * 6, L = ti * G + c; const int nq = need_ctx ? NRT : 64;
#endif
        if (L >= nq * 4) return false;
        int im, pn; rect_order(L, nq, 4, im, pn); const int pm = need_ctx ? im : lat_tile(im); const int b = sub >> 1;
        u.pm = pm; u.pn = pn; u.kind = sub;
        if ((sub & 1) == 0) { u.nt = 16; u.A = H + (size_t)pm * 256 * 1024 * 2; u.B = WG + (size_t)(b * 1024 + pn * 256) * 1024 * 2; }
        else { u.nt = 8; u.A = (b == 0 ? QG : (b == 1 ? QG + 512 * 2 : XM + 512 * 2)) + (size_t)pm * 256 * 1024 * 2; u.B = WB + (size_t)(b * 1024 + pn * 256) * 1024 * 2; }
        return true;
    }
};
struct EpiMerge {
    static constexpr bool PERM = true;
    bf16_t* MERGED; u32x4* stash;
    __device__ __forceinline__ void operator()(const f32x4 (&acc)[2][2][4][2], const Unit& u, int wr, int wc, int fr, int fq) const {
        const int rowb = u.pm * 256 + wr * 64 + fr, tid = opaque(threadIdx.x), b = u.kind >> 1;
#pragma unroll
        for (int ai = 0; ai < 2; ++ai)
#pragma unroll
            for (int m = 0; m < 4; ++m)
#pragma unroll
                for (int bj = 0; bj < 2; ++bj) {
                    u32x4* sp = stash + (size_t)(((ai * 4 + m) * 2 + bj) * 512 + tid);
                    f32x4 a = acc[ai][bj][m][0], c = acc[ai][bj][m][1];
                    if ((u.kind & 1) == 0) {
#ifdef MK_DBG_RAWGATE
                        *(u32x4*)(MERGED + (size_t)(rowb + ai * 128 + m * 16) * 1024 + u.pn * 256 + 128 * bj + 32 * wc + 8 * fq) = pack8(a, c);
#else
#pragma unroll
                        for (int j = 0; j < 4; ++j) { a[j] = sigmoid_f(a[j]); c[j] = sigmoid_f(c[j]); }
                        *sp = pack8(a, c);
#endif
                    } else {
                        const u32x4 g = ld16_sc1(sp);
                        a[0] *= bflo(g.x); a[1] *= bfhi(g.x); a[2] *= bflo(g.y); a[3] *= bfhi(g.y); c[0] *= bflo(g.z); c[1] *= bfhi(g.z); c[2] *= bflo(g.w); c[3] *= bfhi(g.w);
                        u32x4* mp = (u32x4*)(MERGED + (size_t)(rowb + ai * 128 + m * 16) * 1024 + u.pn * 256 + 128 * bj + 32 * wc + 8 * fq);
                        if (b > 0) { const u32x4 p = ld16_sc1(mp);
                            a[0] += bflo(p.x); a[1] += bfhi(p.x); a[2] += bflo(p.y); a[3] += bfhi(p.y); c[0] += bflo(p.z); c[1] += bfhi(p.z); c[2] += bflo(p.w); c[3] += bfhi(p.w); }
                        *mp = pack8(a, c);
                    }
                    SBAR();
                }
    }
};

struct SchedOut {
    const char *A, *W; int G, c; bool need_ctx;
    __device__ __forceinline__ bool next(int i, Unit& u) const {
        const int L = i * G + c; const int nq = need_ctx ? NRT : 64;
        if (L >= nq * 4) return false;
        int im, pn; rect_order(L, nq, 4, im, pn); const int pm = need_ctx ? im : lat_tile(im);
        u.pm = pm; u.pn = pn; u.kind = 0; u.nt = 16; u.A = A + (size_t)pm * 256 * 1024 * 2; u.B = W + (size_t)pn * 256 * 1024 * 2; return true;
    }
};
struct EpiOut {
    static constexpr bool PERM = false;
    float* xc; float* xl; const float* mod;
    __device__ __forceinline__ void operator()(const f32x4 (&acc)[2][2][4][2], const Unit& u, int wr, int wc, int fr, int fq) const {
        const int b = u.pm / 9, pmod = u.pm - b * 9;
        const float* gate = mod + ((size_t)(pmod == 0 ? 8 : b) * 6 + 2) * D;
        float* xb = pmod == 0 ? xc + (size_t)b * CTXL * D : xl + ((size_t)b * SEQ + (pmod - 1) * 256) * D;
        const int r0 = wr * 64 + fr, c0 = u.pn * 256 + 32 * wc + 4 * fq;
#pragma unroll
        for (int ai = 0; ai < 2; ++ai)
#pragma unroll
            for (int m = 0; m < 4; ++m)
#pragma unroll
                for (int bj = 0; bj < 2; ++bj)
#pragma unroll
                    for (int n = 0; n < 2; ++n) { const int c = c0 + 128 * bj + 16 * n;
                        f32x4* p = (f32x4*)(xb + (size_t)(r0 + ai * 128 + m * 16) * D + c);
                        *p = *p + *(const f32x4*)(gate + c) * acc[ai][bj][m][n]; }
    }
};

struct SchedMoe {
    const char *A, *W; const int* tile_e; int G, c, second;
    __device__ __forceinline__ bool next(int i, Unit& u) const {
        const int L = i * G + c; const int ntile = __builtin_amdgcn_readfirstlane(tile_e[255]);
        if (L >= ntile * 4) return false;
        int im, pn; rect_order(L, ntile, 4, im, pn); const int e = __builtin_amdgcn_readfirstlane(tile_e[im]);
        u.pm = im; u.pn = pn; u.kind = e;
        if (!second) { u.nt = 16; u.A = A + (size_t)im * 256 * 1024 * 2; u.B = W + (size_t)(e * 1024 + pn * 256) * 1024 * 2; }
        else { u.nt = 8; u.A = A + (size_t)im * 256 * 512 * 2; u.B = W + (size_t)(e * 1024 + pn * 256) * 512 * 2; }
        return true;
    }
};
struct EpiMoe1 {
    static constexpr bool PERM = true;
    bf16_t* ACT; const float* slotw;
    __device__ __forceinline__ void operator()(const f32x4 (&acc)[2][2][4][2], const Unit& u, int wr, int wc, int fr, int fq) const {
        const int rowb = u.pm * 256 + wr * 64 + fr;
#pragma unroll
        for (int ai = 0; ai < 2; ++ai)
#pragma unroll
            for (int m = 0; m < 4; ++m) { const size_t row = rowb + ai * 128 + m * 16; const float w = slotw[row];
                f32x4 o[2];
#pragma unroll
                for (int n = 0; n < 2; ++n)
#pragma unroll
                    for (int j = 0; j < 4; ++j) o[n][j] = silu_f(acc[ai][0][m][n][j]) * acc[ai][1][m][n][j] * w;
                *(u32x4*)(ACT + row * 512 + u.pn * 128 + 32 * wc + 8 * fq) = pack8(o[0], o[1]); }
    }
};
struct EpiMoe2 {
    static constexpr bool PERM = true;
    bf16_t* Y;
    __device__ __forceinline__ void operator()(const f32x4 (&acc)[2][2][4][2], const Unit& u, int wr, int wc, int fr, int fq) const {
        const int rowb = u.pm * 256 + wr * 64 + fr;
#pragma unroll
        for (int ai = 0; ai < 2; ++ai)
#pragma unroll
            for (int m = 0; m < 4; ++m)
#pragma unroll
                for (int bj = 0; bj < 2; ++bj) *(u32x4*)(Y + (size_t)(rowb + ai * 128 + m * 16) * 1024 + u.pn * 256 + 128 * bj + 32 * wc + 8 * fq) = pack8(acc[ai][bj][m][0], acc[ai][bj][m][1]);
    }
};

constexpr int AT_VB = 8192, AT_KB = 16384;
constexpr int AT_V = 0, AT_K = 2 * AT_VB, AT_WS = AT_K + 2 * AT_KB, AT_BYTES = AT_WS + NWAVES * 256;
constexpr float AT_THR = 8.f;
__device__ __forceinline__ int crow(int r, int hi) { return (r & 3) + 8 * (r >> 2) + 4 * hi; }
template <int DK> __device__ __forceinline__ int kswz(int row, int colB) { return DK == 64 ? row * 128 + (colB ^ (((row >> 1) & 7) << 4)) : row * 256 + (colB ^ ((row & 15) << 4)); }
__device__ __forceinline__ int v_st(int k, int c) { const int kk = (k & ~0xC) | ((k & 4) << 1) | ((k & 8) >> 1); return ((kk >> 3) * 2 + (c >> 5)) * 512 + ((kk & 7) * 32 + (c & 31)) * 2; }
__device__ __forceinline__ int v_rd_base(int lane) { return ((lane & 3) << 3) | (((lane >> 2) & 3) << 6) | (((lane >> 4) & 1) << 5) | (((lane >> 5) & 1) << 8); }
constexpr int v_rd_off(int d0, int ks, int half) { return d0 * 512 + ks * 2048 + half * 1024; }
template <int OFF> __device__ __forceinline__ s16x4 tr_read(int vb) { s16x4 r; asm volatile("ds_read_b64_tr_b16 %0, %1 offset:%2" : "=&v"(r) : "v"(vb), "i"(OFF) : "memory"); return r; }

__device__ __forceinline__ void partialSM(f32x16& p0, f32x16& p1, float& m_reg, float& mn, float& alpha) {
    float pmax = p0[0];
#pragma unroll
    for (int r = 1; r < 16; ++r) pmax = fmaxf(pmax, p0[r]);
#pragma unroll
    for (int r = 0; r < 16; ++r) pmax = fmaxf(pmax, p1[r]);
    { auto rr = __builtin_amdgcn_permlane32_swap(__float_as_uint(pmax), __float_as_uint(pmax), false, false); pmax = fmaxf(__uint_as_float(rr[0]), __uint_as_float(rr[1])); }
    if (__builtin_expect(__all(pmax - m_reg <= AT_THR), 1)) { mn = m_reg; alpha = 1.f; }
    else { mn = fmaxf(m_reg, pmax); alpha = fast_exp2(m_reg - mn); m_reg = mn; }
#pragma unroll
    for (int r = 0; r < 16; ++r) { p0[r] = p0[r] - mn; p1[r] = p1[r] - mn; }
#pragma unroll
    for (int r = 0; r < 16; ++r) p0[r] = fast_exp2(p0[r]);
}
__device__ __forceinline__ void finishSM(f32x16& p0, f32x16& p1, float alpha, float& l_reg, bf16x8& pa0, bf16x8& pa1, bf16x8& pa2, bf16x8& pa3) {
#pragma unroll
    for (int r = 0; r < 16; ++r) p1[r] = fast_exp2(p1[r]);
    float ps = 0;
#pragma unroll
    for (int r = 0; r < 16; ++r) ps += p0[r];
#pragma unroll
    for (int r = 0; r < 16; ++r) ps += p1[r];
    { auto rr = __builtin_amdgcn_permlane32_swap(__float_as_uint(ps), __float_as_uint(ps), false, false); ps = __uint_as_float(rr[0]) + __uint_as_float(rr[1]); }
    l_reg = l_reg * alpha + ps;
#define PK4(P, BASE, OUT) do { unsigned a0 = cvt_pk_bf16(P[BASE + 0], P[BASE + 1]), a1 = cvt_pk_bf16(P[BASE + 2], P[BASE + 3]);   \
    unsigned b0 = cvt_pk_bf16(P[BASE + 4], P[BASE + 5]), b1 = cvt_pk_bf16(P[BASE + 6], P[BASE + 7]);                              \
    auto r0 = __builtin_amdgcn_permlane32_swap(a0, b0, false, false); auto r1 = __builtin_amdgcn_permlane32_swap(a1, b1, false, false); \
    u32x4 w = {r0[0], r1[0], r0[1], r1[1]}; OUT = *reinterpret_cast<bf16x8*>(&w); } while (0)
    PK4(p0, 0, pa0); PK4(p0, 8, pa1); PK4(p1, 0, pa2); PK4(p1, 8, pa3);
#undef PK4
}
template <int DK>
__device__ __forceinline__ void qkt(f32x16& p0, f32x16& p1, int Ks, const bf16x8* qr, int r32, int hi) {
    p0 = f32x16{}; p1 = f32x16{};
#pragma unroll
    for (int d0 = 0; d0 < DK / 16; ++d0) { const int cb = (d0 * 16 + hi * 8) * 2;
        const bf16x8 b0 = *(const LAS bf16x8*)(uintptr_t)(Ks + kswz<DK>(r32, cb));
        const bf16x8 b1 = *(const LAS bf16x8*)(uintptr_t)(Ks + kswz<DK>(32 + r32, cb));
        p0 = __builtin_amdgcn_mfma_f32_32x32x16_bf16(b0, qr[d0], p0, 0, 0, 0);
        p1 = __builtin_amdgcn_mfma_f32_32x32x16_bf16(b1, qr[d0], p1, 0, 0, 0); }
}
template <int D0> __device__ __forceinline__ void pv_one(f32x16& od, int vb, bf16x8 pa0, bf16x8 pa1, bf16x8 pa2, bf16x8 pa3) {
    const s16x4 l0 = tr_read<v_rd_off(D0, 0, 0)>(vb), h0 = tr_read<v_rd_off(D0, 0, 1)>(vb), l1 = tr_read<v_rd_off(D0, 1, 0)>(vb), h1 = tr_read<v_rd_off(D0, 1, 1)>(vb);
    const s16x4 l2 = tr_read<v_rd_off(D0, 2, 0)>(vb), h2 = tr_read<v_rd_off(D0, 2, 1)>(vb), l3 = tr_read<v_rd_off(D0, 3, 0)>(vb), h3 = tr_read<v_rd_off(D0, 3, 1)>(vb);
    asm volatile("s_waitcnt lgkmcnt(0)" ::: "memory"); SBAR();
#define PK(L, H) (bf16x8){L[0], L[1], L[2], L[3], H[0], H[1], H[2], H[3]}
    od = __builtin_amdgcn_mfma_f32_32x32x16_bf16(pa0, PK(l0, h0), od, 0, 0, 0);
    od = __builtin_amdgcn_mfma_f32_32x32x16_bf16(pa1, PK(l1, h1), od, 0, 0, 0);
    od = __builtin_amdgcn_mfma_f32_32x32x16_bf16(pa2, PK(l2, h2), od, 0, 0, 0);
    od = __builtin_amdgcn_mfma_f32_32x32x16_bf16(pa3, PK(l3, h3), od, 0, 0, 0);
#undef PK
}
__device__ __forceinline__ void pv_d0(f32x16* o, int vb, bf16x8 pa0, bf16x8 pa1, bf16x8 pa2, bf16x8 pa3) {
    pv_one<0>(o[0], vb, pa0, pa1, pa2, pa3); pv_one<1>(o[1], vb, pa0, pa1, pa2, pa3);
}
template <int DK>
__device__ __forceinline__ void attn_unit(const bf16_t* Qb, int ldq, const bf16_t* Qr, const bf16_t* __restrict__ Kh, int ldk, const bf16_t* __restrict__ K2,
                                          const bf16_t* __restrict__ Vh, int ldv, bf16_t* Ob, int ldo, int nkeys, int ldsb) {
    const int tid = opaque(threadIdx.x), wid = tid >> 6, lane = tid & 63, r32 = lane & 31, hi = lane >> 5;
    const int V_lds = ldsb + AT_V, K_lds = ldsb + AT_K;
    LAS float* ws = (LAS float*)(uintptr_t)(ldsb + AT_WS + wid * 256); LAS float* li_l = ws; LAS float* al_l = ws + 32;
    float m_reg = -1e30f, l_reg = 0; f32x16 o[2] = {}; bf16x8 qr[DK / 16];
    { const bf16_t* Qw = Qb + (size_t)(wid * 32 + r32) * ldq + hi * 8;
#pragma unroll
      for (int d0 = 0; d0 < 4; ++d0) qr[d0] = *(const bf16x8*)(Qw + d0 * 16);
      if constexpr (DK == 96) { const bf16_t* Qw2 = Qr + (size_t)(wid * 32 + r32) * ldq + hi * 8;
#pragma unroll
        for (int d0 = 0; d0 < 2; ++d0) qr[4 + d0] = *(const bf16x8*)(Qw2 + d0 * 16); } }
    const int sr = tid >> 3, sc = (tid & 7) * 8;
    const int sr2 = (tid >> 2) & 63, sc2 = (tid & 3) * 8;
    const int kst = kswz<DK>(sr, sc * 2), kst2 = kswz<DK>(sr2, (64 + sc2) * 2), vst = v_st(sr, sc);
    const int vb0 = V_lds + v_rd_base(lane);
    constexpr int SD = (DK == 96) ? 1 : 2, S1 = SD - 1;
    struct { bf16x8 k, k2, v; } sr_[SD];
#define SLOAD(i, k0) do { sr_[i].v = *(const bf16x8*)(Vh + (size_t)((k0) + sr) * ldv + sc); sr_[i].k = *(const bf16x8*)(Kh + (size_t)((k0) + sr) * ldk + sc); \
    if constexpr (DK == 96) sr_[i].k2 = *(const bf16x8*)(K2 + (size_t)((k0) + sr2) * 32 + sc2); } while (0)
#define SWRITE(b, i) do { *(LAS bf16x8*)(uintptr_t)(V_lds + (b) * AT_VB + vst) = sr_[i].v; *(LAS bf16x8*)(uintptr_t)(K_lds + (b) * AT_KB + kst) = sr_[i].k; \
    if constexpr (DK == 96) *(LAS bf16x8*)(uintptr_t)(K_lds + (b) * AT_KB + kst2) = sr_[i].k2; } while (0)
#define RESC(a) do { if (__any((a) < 1.f)) { if (hi == 0) al_l[r32] = (a); asm volatile("s_waitcnt lgkmcnt(0)" ::: "memory"); \
    _Pragma("unroll") for (int d = 0; d < 2; ++d) _Pragma("unroll") for (int r = 0; r < 16; ++r) o[d][r] *= al_l[crow(r, hi)]; } } while (0)
    f32x16 pA0, pA1, pB0, pB1; float mnA, mnB, alA, alB; bf16x8 pa0, pa1, pa2, pa3; const int NT = nkeys / 64;
    SLOAD(0, 0); SWRITE(0, 0); __syncthreads();
    qkt<DK>(pA0, pA1, K_lds, qr, r32, hi); partialSM(pA0, pA1, m_reg, mnA, alA);
    SLOAD(S1, 64); if constexpr (SD == 2) { if (2 < NT) SLOAD(0, 128); }
    SWRITE(1, S1); __syncthreads();
    for (int j = 1; j + 1 < NT; j += 2) {
        SBAR(); qkt<DK>(pB0, pB1, K_lds + AT_KB, qr, r32, hi);
        finishSM(pA0, pA1, alA, l_reg, pa0, pa1, pa2, pa3); SBAR();
        SLOAD(S1, (j + SD) * 64); SBAR();
        pv_d0(o, vb0, pa0, pa1, pa2, pa3); partialSM(pB0, pB1, m_reg, mnB, alB);
        __syncthreads(); SWRITE(0, 0);
        RESC(alB); __syncthreads();
        SBAR(); qkt<DK>(pA0, pA1, K_lds, qr, r32, hi);
        finishSM(pB0, pB1, alB, l_reg, pa0, pa1, pa2, pa3); SBAR();
        if (SD == 1 || j + 3 < NT) SLOAD(0, (j + 1 + SD) * 64); SBAR();
        pv_d0(o, vb0 + AT_VB, pa0, pa1, pa2, pa3); partialSM(pA0, pA1, m_reg, mnA, alA);
        __syncthreads(); SWRITE(1, S1);
        RESC(alA); __syncthreads();
    }
    SBAR(); qkt<DK>(pB0, pB1, K_lds + AT_KB, qr, r32, hi);
    finishSM(pA0, pA1, alA, l_reg, pa0, pa1, pa2, pa3); SBAR();
    pv_d0(o, vb0, pa0, pa1, pa2, pa3); partialSM(pB0, pB1, m_reg, mnB, alB);
    __syncthreads(); RESC(alB);
    finishSM(pB0, pB1, alB, l_reg, pa0, pa1, pa2, pa3); SBAR();
    pv_d0(o, vb0 + AT_VB, pa0, pa1, pa2, pa3);
    if (hi == 0) li_l[r32] = l_reg; asm volatile("s_waitcnt lgkmcnt(0)" ::: "memory");
    bf16_t* Ow = Ob + (size_t)(wid * 32) * ldo;
#pragma unroll
    for (int r = 0; r < 16; ++r) { const int orow = crow(r, hi); const float rl = fast_rcp(li_l[orow]);
#pragma unroll
        for (int d0 = 0; d0 < 2; ++d0) Ow[(size_t)orow * ldo + d0 * 32 + r32] = (bf16_t)(cvt_pk_bf16(o[d0][r] * rl, 0.f) & 0xffffu); }
    __syncthreads();
#undef SLOAD
#undef SWRITE
#undef RESC
}

constexpr int LRU_UROW = 1040;
constexpr int LRU_HF = 64 * LRU_UROW;
static_assert(LRU_HF + 8 * 32 * 64 * 4 <= LDS_MISC, "lru lds");
template <bool FINAL, int DIR>
__device__ __forceinline__ void lru_dir(const Frame& F, int l, int b, int ch, int nt2) {
    const int lane = opaque(F.lane), w = F.wave, r32 = lane & 31, hi = lane >> 5, d = DIR;
    LAS unsigned char* U = F.lds;
    LAS float* HF = (LAS float*)(F.lds + LRU_HF) + w * 2048 + lane;
    const int c = w * 64 + nt2 * 32 + r32;
    const bf16_t* WL = WSP(const bf16_t, WS_WLRU) + (size_t)l * (2 * 2 * 8 * 64 * 64);
    float* TOT = WSP(float, WS_TOT);
    const float ba = F.in[I_LBA][(l * 2 + d) * 512 + c], bi = F.in[I_LBI][(l * 2 + d) * 512 + c];
    const float c8 = -8.f * LOG2E * log1pf(__expf(-F.in[I_LLAM][(l * 2 + d) * 512 + c]));
    f32x16 av[2], bq[2];
#pragma unroll
    for (int mt = 0; mt < 2; ++mt) {
        f32x16 xa = {}, xi = {};
#pragma unroll
        for (int ks = 0; ks < 4; ++ks) {
            const bf16x8 wa = *(const bf16x8*)(WL + ((size_t)((d * 2 + 0) * 8 + w) * 64 + nt2 * 32 + r32) * 64 + ks * 16 + hi * 8);
            const bf16x8 wi = *(const bf16x8*)(WL + ((size_t)((d * 2 + 1) * 8 + w) * 64 + nt2 * 32 + r32) * 64 + ks * 16 + hi * 8);
            const bf16x8 af = *(const LAS bf16x8*)(U + (mt * 32 + r32) * LRU_UROW + (w * 64 + ks * 16 + hi * 8) * 2);
            xa = __builtin_amdgcn_mfma_f32_32x32x16_bf16(af, wa, xa, 0, 0, 0); xi = __builtin_amdgcn_mfma_f32_32x32x16_bf16(af, wi, xi, 0, 0, 0); }
#pragma unroll
        for (int r = 0; r < 16; ++r) {
            const float uv = bf2f(*(const LAS unsigned short*)(U + (mt * 32 + crow(r, hi)) * LRU_UROW + c * 2));
            const float rg = sigmoid_f(xa[r] + ba), ig = sigmoid_f(xi[r] + bi);
            const float la2 = c8 * rg;
            const float a = fast_exp2(la2);
            const float x = la2 * (2.f * 0.6931471805599453f);
            const float em = x > -0.3f ? -x * (1.f + x * (0.5f + x * (0.16666667f + x * (0.041666668f + x * (0.0083333338f + x * 0.0013888889f))))) : 1.f - a * a;
            av[mt][r] = a; bq[mt][r] = sqrtf(em) * ig * uv;
        }
        SBAR();
    }
    float cin = 0.f, Atot = 1.f;
    if (FINAL) {
        const float* tp = TOT + ((size_t)(b * 2 + d) * NCH) * 1024 + c;
        if (d == 0) { for (int j = 0; j < ch; ++j) cin = tp[j * 1024] * cin + tp[j * 1024 + 512]; }
        else { if (ch >= 4) { for (int j = 3; j >= 0; --j) cin = tp[j * 1024] * cin + tp[j * 1024 + 512]; for (int j = NCH - 1; j > ch; --j) cin = tp[j * 1024] * cin + tp[j * 1024 + 512]; }
               else { for (int j = 3; j > ch; --j) cin = tp[j * 1024] * cin + tp[j * 1024 + 512]; } }
    }
    float mycin[2][4];
#pragma unroll
    for (int q = 0; q < 2; ++q) {
        const int mt = d == 0 ? q : 1 - q;
#pragma unroll
        for (int qs = 0; qs < 4; ++qs) {
            const int sl = d == 0 ? qs : 3 - qs;
            float As = 1.f, Bs = 0.f;
#pragma unroll
            for (int k = 0; k < 4; ++k) { const int r = 4 * sl + (d == 0 ? k : 3 - k); As *= av[mt][r]; Bs = av[mt][r] * Bs + bq[mt][r]; }
            const float Ap = __shfl_xor(As, 32), Bp = __shfl_xor(Bs, 32);
            const float A0 = hi ? Ap : As, B0 = hi ? Bp : Bs, A1 = hi ? As : Ap, B1 = hi ? Bs : Bp;
            float c0v, c1v;
            if (d == 0) { c0v = cin; cin = A0 * cin + B0; c1v = cin; cin = A1 * cin + B1; }
            else { c1v = cin; cin = A1 * cin + B1; c0v = cin; cin = A0 * cin + B0; }
            mycin[mt][sl] = hi ? c1v : c0v; Atot *= A0 * A1;
        }
    }
    if (!FINAL) { if (hi == 0) { float* tp = TOT + ((size_t)(b * 2 + d) * NCH + ch) * 1024 + c; tp[0] = Atot; tp[512] = cin; } }
    else {
        bf16_t* QG = WSP(bf16_t, WS_QG);
#pragma unroll
        for (int mt = 0; mt < 2; ++mt)
#pragma unroll
            for (int sl = 0; sl < 4; ++sl) { float h = mycin[mt][sl];
#pragma unroll
                for (int k = 0; k < 4; ++k) { const int r = 4 * sl + (d == 0 ? k : 3 - k); h = av[mt][r] * h + bq[mt][r];
                    if (d == 0) HF[(mt * 16 + r) * 64] = h;
                    else { bf16_t* op = QG + (size_t)(b * TT + ch * 64 + mt * 32 + crow(r, hi)) * 1024 + 512 + c; *op = (bf16_t)(cvt_pk_bf16((HF[(mt * 16 + r) * 64] + h) * bf2f(*op), 0.f) & 0xffffu); } } }
    }
}
template <bool FINAL>
__device__ __forceinline__ void lru_unit(const Frame& F, int l, int b, int ch) {
    const int tid = opaque(F.tid);
    LAS unsigned char* U = F.lds;
    const bf16_t* XM = WSP(const bf16_t, WS_XM);
    const int t0 = ch * 64, seglo = ch < 4 ? 0 : CTXL, seghi = ch < 4 ? CTXL : TT;
    {
        const int c0 = (tid & 63) * 8, tg = tid >> 6;
        u32x4 xr[11];
#pragma unroll
        for (int i = 0; i < 11; ++i) { const int t = t0 + tg * 8 - 1 + i;
            xr[i] = (t >= seglo && t < seghi) ? *(const u32x4*)(XM + (size_t)(b * TT + t) * 1024 + c0) : (u32x4){0u, 0u, 0u, 0u}; }
        const float* cw = F.in[I_CONVW] + (size_t)l * 4 * 512 + c0; const float* cb = F.in[I_CONVB] + l * 512 + c0;
        f32x4 wv[4][2], bv[2];
#pragma unroll
        for (int j = 0; j < 4; ++j) { wv[j][0] = *(const f32x4*)(cw + j * 512); wv[j][1] = *(const f32x4*)(cw + j * 512 + 4); }
        bv[0] = *(const f32x4*)cb; bv[1] = *(const f32x4*)(cb + 4);
#pragma unroll
        for (int tt = 0; tt < 8; ++tt) { f32x4 a0 = bv[0], a1 = bv[1];
#pragma unroll
            for (int j = 0; j < 4; ++j) { const u32x4 x = xr[tt + j];
                a0 += wv[j][0] * (f32x4){bflo(x.x), bfhi(x.x), bflo(x.y), bfhi(x.y)}; a1 += wv[j][1] * (f32x4){bflo(x.z), bfhi(x.z), bflo(x.w), bfhi(x.w)}; }
            *(LAS u32x4*)(U + (tg * 8 + tt) * LRU_UROW + c0 * 2) = pack8(a0, a1); }
    }
    __syncthreads();
#pragma unroll 1
    for (int nt2 = 0; nt2 < 2; ++nt2) {
        lru_dir<FINAL, 0>(F, l, b, ch, nt2);
        SBAR();
        lru_dir<FINAL, 1>(F, l, b, ch, nt2);
        SBAR();
    }
    __syncthreads();
}
#ifdef MK_DBG_DET
namespace mkdbg {
__global__ void k_chk(const unsigned* base, long rows, long pitch_w, long off_w, long width_w, const int* rowidx, unsigned long long* acc) {
    unsigned long long s = 0;
    const long total = rows * width_w;
    for (long i = blockIdx.x * (long)blockDim.x + threadIdx.x; i < total; i += (long)gridDim.x * blockDim.x) {
        const long r = i / width_w, c = i - r * width_w; const long rr = rowidx ? rowidx[r] : r;
        const unsigned v = base[rr * pitch_w + off_w + c];
        s += (unsigned long long)v * (unsigned long long)(2 * (i % 1021) + 1);
    }
    for (int o = 32; o > 0; o >>= 1) s += __shfl_xor(s, o);
    if ((threadIdx.x & 63) == 0) atomicAdd(acc, s);
}
__global__ void k_verdict(const unsigned long long* a, const unsigned long long* b, int n, float* out, long nout) {
    int code = n;
    for (int p = n - 1; p >= 0; --p) if (a[p] != b[p]) code = p;
    const float v = exp2f((float)(code + 1));
    for (long i = blockIdx.x * (long)blockDim.x + threadIdx.x; i < nout; i += (long)gridDim.x * blockDim.x) out[i] = v;
}
}
#endif

#ifndef MK_P4
#define MK_P4 15
#endif
__device__ __forceinline__ void phase_attn(const Frame& F, int l) {
    const bool need_ctx = (l < DEPTH - 1);
    const int ldsb = (int)(uintptr_t)F.lds;
    bf16_t* QG = WSP(bf16_t, WS_QG); bf16_t* XM = WSP(bf16_t, WS_XM);
    const bf16_t* KB = WSP(const bf16_t, WS_KB); const bf16_t* VB = WSP(const bf16_t, WS_VB);
    const bf16_t* QM = WSP(const bf16_t, WS_QM); const bf16_t* KVM = WSP(const bf16_t, WS_KVM); const bf16_t* KR = WSP(const bf16_t, WS_KR);
    const int n_ctx = need_ctx ? 128 : 0, n_lru = need_ctx ? NB * NCH : NB * (NCH - 4);
    const int total = 1024 + n_ctx + n_lru;
    for (int id = F.bx; id < total; id += F.G) {
        if (id < 512) { if (MK_P4 & 1) {
            const int r = id >> 8, wq = id & 255, x = wq & 7, j = wq >> 3, pp = x + 8 * r, b = pp >> 1, kvh = pp & 1, h = kvh * 4 + (j >> 3), qb = j & 7;
            const size_t row0 = (size_t)b * TT + CTXL + qb * 256, key0 = (size_t)b * TT;
            attn_unit<64>(QG + row0 * 1024 + h * 64, 1024, nullptr, KB + key0 * 128 + kvh * 64, 128, nullptr, VB + key0 * 128 + kvh * 64, 128, QG + row0 * 1024 + h * 64, 1024, TT, ldsb); }
        } else if (id < 1024) { if (MK_P4 & 2) {
            const int i2 = id - 512, r = i2 >> 8, wq = i2 & 255, x = wq & 7, j = wq >> 3, idx = (x + 8 * r) * 4 + (j >> 3), b = idx >> 3, h = idx & 7, qb = j & 7;
            const size_t row0 = (size_t)b * TT + CTXL + qb * 256, key0 = (size_t)b * TT;
            attn_unit<96>(QM + row0 * 768 + h * 64, 768, QM + row0 * 768 + 512 + h * 32, KVM + key0 * 1024 + h * 64, 1024, KR + key0 * 32, KVM + key0 * 1024 + 512 + h * 64, 1024,
                          XM + row0 * 1024 + 512 + h * 64, 1024, TT, ldsb); }
        } else if (id < 1024 + n_ctx) { if (MK_P4 & 4) {
            const int i2 = id - 1024, b = (i2 & 63) >> 3, h = i2 & 7; const size_t row0 = (size_t)b * TT;
            if (i2 < 64) { const int kvh = h >> 2;
                attn_unit<64>(QG + row0 * 1024 + h * 64, 1024, nullptr, KB + row0 * 128 + kvh * 64, 128, nullptr, VB + row0 * 128 + kvh * 64, 128, QG + row0 * 1024 + h * 64, 1024, CTXL, ldsb);
            } else {
                attn_unit<96>(QM + row0 * 768 + h * 64, 768, QM + row0 * 768 + 512 + h * 32, KVM + row0 * 1024 + h * 64, 1024, KR + row0 * 32, KVM + row0 * 1024 + 512 + h * 64, 1024,
                              XM + row0 * 1024 + 512 + h * 64, 1024, CTXL, ldsb);
            } }
        } else if (MK_P4 & 8) {
            const int i2 = id - 1024 - n_ctx; int b, ch;
            if (need_ctx) { b = i2 / NCH; ch = i2 - b * NCH; } else { b = i2 / (NCH - 4); ch = 4 + i2 - b * (NCH - 4); }
            lru_unit<true>(F, l, b, ch);
        }
    }
}

constexpr int NPHASE = 2 + DEPTH * 10;
#ifndef MK_MASK
#define MK_MASK 0xFFF
#endif
#define PM(k) ((MK_MASK >> (k)) & 1)
__global__ void __launch_bounds__(NTHR, 2) mk_fwd(Args args) {
    extern __shared__ __attribute__((aligned(16))) unsigned char lds_raw[];
    Frame F;
    F.lds = (LAS unsigned char*)lds_raw; F.ws = args.ws; F.in = args.in; F.out = args.out;
    F.tid = threadIdx.x; F.lane = F.tid & 63; F.wave = __builtin_amdgcn_readfirstlane(F.tid >> 6); F.G = gridDim.x; F.bx = blockIdx.x;
    volatile LAS unsigned* misc = (volatile LAS unsigned*)(F.lds + LDS_MISC);
    if (F.tid < 64) misc[F.tid] = 0u;
    __syncthreads();
    XcdBarrier bar; bar.bar = CTLW(CW_BAR); bar.x = 0; bar.st = nullptr;
#if !MK_PER_PHASE
    bar = xcd_barrier_post(CTLW(CW_BAR), misc + 8);
#endif
    const int lo = args.ph_lo, hi = args.ph_hi;
#define IN(k) (lo <= (k) && (k) < hi)
#if MK_PER_PHASE
#define SEAM(k) do { } while (0)
#else
#define SEAM(k) do { if (IN(k) && IN((k) + 1)) xcd_barrier(bar); } while (0)
#endif
    if (PM(0) && IN(0)) { p0_mod(F); __syncthreads(); p0_weights(F); p0_misc(F); }
    SEAM(0);
    if (PM(1) && IN(1)) phase_rows<0>(F, 0);
    SEAM(1);
#pragma unroll 1
    for (int l = 0; l < DEPTH; ++l) {
        const int pb = 2 + l * 10; const bool need_ctx = (l < DEPTH - 1);
        unsigned char* wl = F.ws + WS_W + (size_t)l * W_LAYER;
        if (PM(2) && IN(pb + 0)) {
            SchedIn S{(const char*)(F.ws + WS_H), (const char*)(wl + W_IN), F.G, F.bx, need_ctx};
            EpiIn E{WSP(bf16_t, WS_QG), WSP(bf16_t, WS_KB), WSP(bf16_t, WS_VB), WSP(bf16_t, WS_XM), WSP(bf16_t, WS_CQKV), WSP(bf16_t, WS_KR),
                    WSP(float, WS_SSP), F.in[I_GQN] + l * 64, F.in[I_GKN] + l * 64, WSP(const f32x2, WS_TAB64), WSP(const f32x2, WS_TAB32)};
            gemm_stream<1024, 1024, EpiIn, SchedIn>(F.lds, S, E);
        }
        SEAM(pb + 0);
        if (PM(3) && IN(pb + 1)) {
            SchedQKV S{(const char*)(F.ws + WS_CQKV), (const char*)(wl + W_QB), (const char*)(wl + W_KVB), F.G, F.bx, need_ctx};
            EpiQKV E{WSP(bf16_t, WS_QM), WSP(bf16_t, WS_KVM), WSP(const float, WS_SSP), WSP(const f32x2, WS_TAB32)};
            gemm_stream<640, 640, EpiQKV, SchedQKV>(F.lds, S, E);
            __syncthreads();
            for (int id = F.G - 1 - F.bx; id < NB * NCH; id += F.G) lru_unit<false>(F, l, id / NCH, id % NCH);
        }
        SEAM(pb + 1);
        if (PM(4) && IN(pb + 2)) phase_attn(F, l);
        SEAM(pb + 2);
        if (PM(5) && IN(pb + 3)) {
            SchedMerge S{(const char*)(F.ws + WS_H), (const char*)(F.ws + WS_QG), (const char*)(F.ws + WS_XM), (const char*)(wl + W_GATE), (const char*)(wl + W_BR), F.G, F.bx, need_ctx};
            EpiMerge E{WSP(bf16_t, WS_MERGED), (u32x4*)(F.ws + WS_STASH + (size_t)(F.bx & 255) * 131072)};
            gemm_stream<1024, 1024, EpiMerge, SchedMerge>(F.lds, S, E);
        }
        SEAM(pb + 3);
        if (PM(6) && IN(pb + 4)) {
            SchedOut S{(const char*)(F.ws + WS_MERGED), (const char*)(wl + W_OUT), F.G, F.bx, need_ctx};
            EpiOut E{WSP(float, WS_XC), F.out, WSP(const float, WS_MOD) + (size_t)l * 9 * 6 * D};
            gemm_stream<1024, 1024, EpiOut, SchedOut>(F.lds, S, E);
        }
        SEAM(pb + 4);
        if (PM(7) && IN(pb + 5)) phase_router(F, l);
        SEAM(pb + 5);
        if (PM(8) && IN(pb + 6)) phase_gather(F, l);
        SEAM(pb + 6);
        if (PM(9) && IN(pb + 7)) {
            SchedMoe S{(const char*)(F.ws + WS_H2S), (const char*)(wl + W_GU), WSP(const int, WS_ROUTE + RT_TILEE), F.G, F.bx, 0};
            EpiMoe1 E{WSP(bf16_t, WS_ACT), WSP(const float, WS_ROUTE + RT_SLOTW)};
            gemm_stream<1024, 1024, EpiMoe1, SchedMoe>(F.lds, S, E);
        }
        SEAM(pb + 7);
        if (PM(10) && IN(pb + 8)) {
            SchedMoe S{(const char*)(F.ws + WS_ACT), (const char*)(wl + W_DN), WSP(const int, WS_ROUTE + RT_TILEE), F.G, F.bx, 1};
            EpiMoe2 E{WSP(bf16_t, WS_Y)};
            gemm_stream<512, 512, EpiMoe2, SchedMoe>(F.lds, S, E);
        }
        SEAM(pb + 8);
        if (PM(11) && IN(pb + 9)) phase_rows<1>(F, l);
        SEAM(pb + 9);
    }
#undef IN
#undef SEAM
}
}

extern "C" void kernel_launch(void* const* d_in, const int* in_sizes, int n_in, void* d_out, int out_size, void* d_ws, size_t ws_size, hipStream_t stream) {
    using namespace mk;
    static int grid = 0;
    if (grid == 0) {
        if (n_in != 32 || out_size != NB * SEQ * D || ws_size < WS_END) { fprintf(stderr, "kernel_launch: unexpected shapes (n_in %d out %d ws %zu, need %zu)\n", n_in, out_size, ws_size, (size_t)WS_END); grid = -1; return; }
        int dev = 0, cus = 0, per_cu = 0;
        if (hipGetDevice(&dev) != hipSuccess || hipDeviceGetAttribute(&cus, hipDeviceAttributeMultiprocessorCount, dev) != hipSuccess) { grid = -1; return; }
        if (hipFuncSetAttribute((const void*)mk_fwd, hipFuncAttributeMaxDynamicSharedMemorySize, LDS_BYTES) != hipSuccess) { fprintf(stderr, "kernel_launch: hipFuncSetAttribute failed\n"); grid = -1; return; }
        if (hipOccupancyMaxActiveBlocksPerMultiprocessor(&per_cu, (const void*)mk_fwd, NTHR, LDS_BYTES) != hipSuccess || per_cu < 1) { fprintf(stderr, "kernel_launch: occupancy query says %d\n", per_cu); per_cu = 1; }
        (void)hipGetLastError();
        grid = cus;
    }
    if (grid < 0) return;
    if (hipMemsetAsync((char*)d_ws + WS_CTL, 0, CTL_BYTES, stream) != hipSuccess) return;
#ifdef MK_DBG_ZERO
    (void)hipMemsetAsync((char*)d_ws + CTL_BYTES, 0, WS_END - CTL_BYTES, stream);
    (void)hipMemsetAsync(d_out, 0, (size_t)NB * SEQ * D * 4, stream);
#endif
    Args a{};
    for (int i = 0; i < 32; ++i) a.in[i] = (const float*)d_in[i];
    a.out = (float*)d_out; a.ws = (unsigned char*)d_ws;
#if defined(MK_DBG_DET)
    {
        unsigned char* ws = (unsigned char*)d_ws;
        unsigned long long* chk = (unsigned long long*)(ws + WS_CTL + 512 * 1024);
        unsigned long long* chkA = (unsigned long long*)(ws + WS_ROUTE + RT_END + 1024);
        auto CHK = [&](int p, const void* base, long rows, long pitch_b, long off_b, long width_b, const int* rowidx) {
            hipLaunchKernelGGL(mk::mkdbg::k_chk, dim3(1024), dim3(256), 0, stream, (const unsigned*)base, rows, pitch_b / 4, off_b / 4, width_b / 4, rowidx, chk + p); };
        const int* tslot = (const int*)(ws + WS_ROUTE + RT_SLOT);
        for (int run = 0; run < 2; ++run) {
            if (run == 1) { hipMemcpyAsync(chkA, chk, 32 * 8, hipMemcpyDeviceToDevice, stream); hipMemsetAsync((char*)d_ws + WS_CTL, 0, CTL_BYTES, stream); }
            for (int p = 0; p < 12; ++p) {
                a.ph_lo = p; a.ph_hi = p + 1; hipLaunchKernelGGL(mk_fwd, dim3(grid), dim3(NTHR), LDS_BYTES, stream, a);
                switch (p) {
                    case 0: CHK(p, ws + WS_MOD, 1, 0, 0, 2 * 9 * 6 * D * 4 + 64 * 16 * 8 + 64 * 8 * 8, nullptr); CHK(p, ws + WS_WLRU, 1, 0, 0, 512 * 1024, nullptr); CHK(p, ws + WS_W, 1, 0, 0, 2 * W_LAYER, nullptr); break;
                    case 1: case 6: case 11: CHK(p, ws + WS_XC, 1, 0, 0, (long)NB * CTXL * D * 4, nullptr); CHK(p, d_out, 1, 0, 0, (long)NB * SEQ * D * 4, nullptr); if (p != 6) CHK(p, ws + WS_H, 1, 0, 0, SZ_R1K, nullptr); break;
                    case 2: CHK(p, ws + WS_QG, 1, 0, 0, SZ_R1K, nullptr); CHK(p, ws + WS_XM, MALL, 2048, 0, 1024, nullptr); CHK(p, ws + WS_KB, 1, 0, 0, (long)MALL * 128 * 2 * 2, nullptr);
                            CHK(p, ws + WS_CQKV, 1, 0, 0, (long)MALL * 640 * 2, nullptr); CHK(p, ws + WS_KR, 1, 0, 0, (long)MALL * 32 * 2, nullptr); CHK(p, ws + WS_SSP, 1, 0, 0, (long)MALL * 20 * 4, nullptr); break;
                    case 3: CHK(p, ws + WS_QM, 1, 0, 0, (long)MALL * 768 * 2, nullptr); CHK(p, ws + WS_KVM, 1, 0, 0, SZ_R1K, nullptr); CHK(p, ws + WS_TOT, 1, 0, 0, (long)NB * 2 * NCH * 1024 * 4, nullptr); break;
                    case 4: CHK(p, ws + WS_QG, 1, 0, 0, SZ_R1K, nullptr); CHK(p, ws + WS_XM, MALL, 2048, 1024, 1024, nullptr); break;
                    case 5: CHK(p, ws + WS_MERGED, 1, 0, 0, SZ_R1K, nullptr); break;
                    case 7: CHK(p, ws + WS_H, 1, 0, 0, SZ_R1K, nullptr); CHK(p, ws + WS_ROUTE + RT_TE, 1, 0, 0, (long)MALL * 2 * 4 * 2, nullptr); break;
                    case 8: CHK(p, ws + WS_H2S, (long)MALL * 2, 2048, 0, 2048, tslot); CHK(p, ws + WS_ROUTE + RT_SLOTW, (long)MALL * 2, 4, 0, 4, tslot); break;
                    case 9: CHK(p, ws + WS_ACT, (long)MALL * 2, 1024, 0, 1024, tslot); break;
                    case 10: CHK(p, ws + WS_Y, (long)MALL * 2, 2048, 0, 2048, tslot); break;
                }
            }
        }
        hipLaunchKernelGGL(mk::mkdbg::k_verdict, dim3(1024), dim3(256), 0, stream, (const unsigned long long*)chkA, (const unsigned long long*)chk, 12, (float*)d_out, (long)NB * SEQ * D);
    }
#elif MK_PER_PHASE
    for (int p = 0; p < NPHASE; ++p) { a.ph_lo = p; a.ph_hi = p + 1; hipLaunchKernelGGL(mk_fwd, dim3(grid), dim3(NTHR), LDS_BYTES, stream, a); }
#else
    a.ph_lo = 0; a.ph_hi = NPHASE;
    hipLaunchKernelGGL(mk_fwd, dim3(grid), dim3(NTHR), LDS_BYTES, stream, a);
#endif
    const hipError_t le = hipPeekAtLastError();
    if (le != hipSuccess) fprintf(stderr, "kernel_launch: launch failed: %s\n", hipGetErrorName(le));
}
```

```cpp
#include <hip/hip_runtime.h>
#include <cstdio>
#include <cstdint>

#ifndef MK_PER_PHASE
#define MK_PER_PHASE 0
#endif

#ifndef MK_REP
#define MK_REP 0
#endif
#define CREG(l) ((l) * 2 + ((MK_REP >> 7) & 1))
namespace mk {
#define LAS __attribute__((address_space(3)))
#define GAS __attribute__((address_space(1)))
typedef unsigned short bf16_t;
typedef short bf16x8 __attribute__((ext_vector_type(8)));
typedef short s16x4 __attribute__((ext_vector_type(4)));
typedef float f32x4 __attribute__((ext_vector_type(4)));
typedef float f32x2 __attribute__((ext_vector_type(2)));
typedef float f32x16 __attribute__((ext_vector_type(16)));
typedef unsigned u32x4 __attribute__((ext_vector_type(4)));
typedef unsigned u32x2 __attribute__((ext_vector_type(2)));

constexpr int D = 1024, NB = 8, SEQ = 2048, CTXL = 256, TT = CTXL + SEQ, MALL = NB * TT, NRT = MALL / 256;
constexpr int DEPTH = 2, INW = 5536;
constexpr int OFF_Q = 0, OFF_K = 512, OFF_V = 640, OFF_X = 768, OFF_Y = 1280, OFF_CQ = 1792, OFF_CKV = 2176, OFF_KR = 2432, OFF_G = 2464;
constexpr float EPS = 1e-6f, LOG2E = 1.4426950408889634f;
constexpr float C2Q = 0.125f * LOG2E;
constexpr float C2M = 0.10206207261596575f * LOG2E;
constexpr int NWAVES = 8, NTHR = 512;
constexpr int MAXSLOT = 40960, MAXTILE = 160;
constexpr int NCH = TT / 64;

constexpr size_t MiB = 1u << 20;
constexpr size_t WS_CTL = 0, CTL_BYTES = 1 * MiB;
constexpr int CW_BAR = 1024;
constexpr int CW_KMAX = 12288;
constexpr int CW_CNT = 8192;
constexpr size_t WS_MOD = 1 * MiB;
constexpr size_t WS_TAB64 = WS_MOD + 2 * 9 * 6 * D * 4;
constexpr size_t WS_TAB32 = WS_TAB64 + 64 * 16 * 8;
constexpr size_t WS_RWT = WS_TAB32 + 64 * 8 * 8;
constexpr size_t WS_ROUTE = WS_RWT + 16 * 1024 * 4;
constexpr size_t RT_TE = 0, RT_TW = RT_TE + MALL * 2 * 4, RT_RANK = RT_TW + MALL * 2 * 4, RT_SLOT = RT_RANK + MALL * 2 * 4, RT_SLOTW = RT_SLOT + MALL * 2 * 4,
                 RT_TILEE = RT_SLOTW + MAXSLOT * 4, RT_END = RT_TILEE + 256 * 4;
static_assert(WS_ROUTE + RT_END <= 3 * MiB, "route");
constexpr size_t WS_WLRU = 3 * MiB;
constexpr size_t WS_TOT = WS_WLRU + MiB / 2;
constexpr size_t WS_XC = 6 * MiB;
constexpr size_t WS_SSP = 14 * MiB;
constexpr size_t WS_W = 16 * MiB;
constexpr size_t W_IN = 0, W_GATE = W_IN + 2560 * 1024 * 2, W_QB = W_GATE + 3072 * 1024 * 2, W_KVB = W_QB + 768 * 640 * 2, W_BR = W_KVB + 1024 * 640 * 2,
                 W_OUT = W_BR + 3 * 1024 * 1024 * 2, W_GU = W_OUT + 1024 * 1024 * 2, W_DN = W_GU + (size_t)16 * 1024 * 1024 * 2, W_LAYER = W_DN + (size_t)16 * 1024 * 512 * 2;
static_assert(W_LAYER % 256 == 0, "w");
constexpr size_t WS_ACT0 = WS_W + 2 * W_LAYER;
constexpr size_t SZ_R1K = (size_t)MALL * 1024 * 2;
constexpr size_t WS_H = WS_ACT0;
constexpr size_t WS_QG = WS_H + SZ_R1K;
constexpr size_t WS_XM = WS_QG + SZ_R1K;
constexpr size_t WS_KB = WS_XM + SZ_R1K;
constexpr size_t WS_VB = WS_KB + (size_t)MALL * 128 * 2;
constexpr size_t WS_CQKV = WS_VB + (size_t)MALL * 128 * 2;
constexpr size_t WS_KR = WS_CQKV + (size_t)MALL * 640 * 2;
constexpr size_t WS_QM = WS_KR + (size_t)MALL * 32 * 2;
constexpr size_t WS_KVM = WS_QM + (size_t)MALL * 768 * 2;
constexpr size_t WS_END = WS_KVM + SZ_R1K;
constexpr size_t WS_MERGED = WS_KVM;
constexpr size_t WS_STASH = WS_CQKV;
static_assert(WS_STASH + (size_t)256 * 131072 <= WS_KVM, "stash");
constexpr size_t WS_PB = WS_QM + 16 * MiB;
static_assert(WS_PB >= WS_STASH + (size_t)256 * 131072 && WS_PB + (size_t)2 * 2048 * 1024 * 2 <= WS_KVM, "pb");
constexpr size_t WS_ROWL = WS_XM;
constexpr size_t WS_Y = WS_QG;
static_assert(WS_Y + (size_t)MAXSLOT * 1024 * 2 <= WS_CQKV, "y");
static_assert((size_t)16 * MALL * 4 <= SZ_R1K, "rowlist");
constexpr size_t WS_ACT = WS_CQKV;
static_assert(WS_ACT + (size_t)MAXSLOT * 512 * 2 <= WS_KVM, "act");
static_assert(WS_END <= (size_t)380 * MiB, "workspace must fit in sum(inputs) = 380.7 MiB");

constexpr int LDS_STAGE = 131072;
constexpr int LDS_MISC = 133120;
constexpr int LDS_BYTES = LDS_MISC + 512;

typedef __bf16 bf16x2v __attribute__((ext_vector_type(2)));
__device__ __forceinline__ unsigned cvt_pk_bf16(float lo, float hi) { const f32x2 v = {lo, hi}; const bf16x2v b = __builtin_convertvector(v, bf16x2v); return __builtin_bit_cast(unsigned, b); }
__device__ __forceinline__ float bf2f(unsigned short b) { return __uint_as_float(((unsigned)b) << 16); }
__device__ __forceinline__ float bflo(unsigned w) { return __uint_as_float(w << 16); }
__device__ __forceinline__ float bfhi(unsigned w) { return __uint_as_float(w & 0xffff0000u); }
__device__ __forceinline__ float fast_exp2(float x) { return __builtin_amdgcn_exp2f(x); }
__device__ __forceinline__ float fast_rcp(float x) { return __builtin_amdgcn_rcpf(x); }
__device__ __forceinline__ float sigmoid_f(float x) { return fast_rcp(1.f + fast_exp2(-LOG2E * x)); }
__device__ __forceinline__ float silu_f(float x) { return x * sigmoid_f(x); }
__device__ __forceinline__ float gelu_tanh_f(float x) {
    const float u = 0.7978845608028654f * (x + 0.044715f * x * x * x);
    return x * sigmoid_f(2.f * u);
}
template <int CTRL> __device__ __forceinline__ float dpp_mov(float v) { return __uint_as_float((unsigned)__builtin_amdgcn_update_dpp(0, (int)__float_as_uint(v), CTRL, 0xF, 0xF, true)); }
__device__ __forceinline__ float wave_sum(float v) {
    v += dpp_mov<0xB1>(v); v += dpp_mov<0x4E>(v); v += dpp_mov<0x141>(v); v += dpp_mov<0x140>(v);
    const unsigned u = __float_as_uint(v);
    return (__uint_as_float(__builtin_amdgcn_readlane(u, 0)) + __uint_as_float(__builtin_amdgcn_readlane(u, 16))) + (__uint_as_float(__builtin_amdgcn_readlane(u, 32)) + __uint_as_float(__builtin_amdgcn_readlane(u, 48)));
}
__device__ __forceinline__ u32x4 pack8(f32x4 a, f32x4 b) { u32x4 w; w.x = cvt_pk_bf16(a[0], a[1]); w.y = cvt_pk_bf16(a[2], a[3]); w.z = cvt_pk_bf16(b[0], b[1]); w.w = cvt_pk_bf16(b[2], b[3]); return w; }

#define SBAR() __builtin_amdgcn_sched_barrier(0)
template <class T> __device__ __forceinline__ T* opaque_p(T* p) { asm volatile("" : "+s"(p)); return p; }
__device__ __forceinline__ unsigned opaque_s(unsigned x) { asm volatile("" : "+s"(x)); return x; }
__device__ __forceinline__ int opaque(int x) { asm volatile("" : "+v"(x)); return x; }
__device__ __forceinline__ u32x4 ld16_sc1(const void* p) {
    const unsigned long long* q = (const unsigned long long*)p;
    const unsigned long long a = __hip_atomic_load(q, __ATOMIC_RELAXED, __HIP_MEMORY_SCOPE_AGENT), b = __hip_atomic_load(q + 1, __ATOMIC_RELAXED, __HIP_MEMORY_SCOPE_AGENT);
    return (u32x4){(unsigned)a, (unsigned)(a >> 32), (unsigned)b, (unsigned)(b >> 32)};
}
#define XB_TMO      128
#define XB_XCNT(j)  (256  + 64 * (j))
#define XB_XSUB(j)  (1280 + 64 * (j))
#define XB_XGEN(j)  (2304 + 64 * (j))
#define XB_TOP      3328
#define XB_TOPGEN   3392
#define XCD_BAR_WORDS 3456
#define XB_SPIN_CAP (1u << 18)
__device__ __forceinline__ unsigned xb_ld(unsigned* p)              { return __hip_atomic_load(p, __ATOMIC_RELAXED, __HIP_MEMORY_SCOPE_AGENT); }
__device__ __forceinline__ unsigned xb_add(unsigned* p, unsigned v) { return __hip_atomic_fetch_add(p, v, __ATOMIC_RELAXED, __HIP_MEMORY_SCOPE_AGENT); }
__device__ __forceinline__ unsigned xb_xcc_id() { return (unsigned)__builtin_amdgcn_s_getreg((3 << 11) | 20) & 0xFu; }
#define XB_SPIN(cond, bar) do { unsigned _sp = 0; while (cond) { __builtin_amdgcn_s_sleep(1); \
    if ((++_sp & 255u) == 0u) { if (xb_ld(&(bar)[XB_TMO])) break; if (_sp > XB_SPIN_CAP) { atomicAdd(&(bar)[XB_TMO], 1u); break; } } } } while (0)
struct XcdBarrier { unsigned* bar; unsigned x; volatile LAS unsigned* st; };
__device__ __forceinline__ XcdBarrier xcd_barrier_post(unsigned* bar, volatile LAS unsigned* st) {
    XcdBarrier b; b.bar = bar; b.x = xb_xcc_id(); b.st = st;
    if (threadIdx.x == 0) (void)xb_add(&bar[XB_XCNT(b.x)], 1u);
    return b;
}
__device__ __forceinline__ void xcd_barrier_complete(unsigned* bar, unsigned x, unsigned& nloc, unsigned& nx) {
    const unsigned G = gridDim.x * gridDim.y * gridDim.z;
    unsigned sum, cnt, mine, sp = 0u;
    for (;;) {
        sum = 0u; cnt = 0u; mine = 0u;
#pragma unroll
        for (unsigned j = 0; j < 16; ++j) { const unsigned c = xb_ld(&bar[XB_XCNT(j)]); sum += c; cnt += (c > 0u) ? 1u : 0u; mine = (j == x) ? c : mine; }
        if (sum == G) break;
        __builtin_amdgcn_s_sleep(1);
        if ((++sp & 255u) == 0u) { if (xb_ld(&bar[XB_TMO])) break; if (sp > XB_SPIN_CAP) { atomicAdd(&bar[XB_TMO], 1u); break; } }
    }
    nloc = mine > 0u ? mine : 1u; nx = cnt > 0u ? cnt : 1u;
}
__device__ __forceinline__ void xcd_barrier(const XcdBarrier& b) {
    asm volatile("s_waitcnt vmcnt(0)" ::: "memory");
    __syncthreads();
    if (threadIdx.x == 0) {
        unsigned* bar = opaque_p(b.bar);
        __builtin_amdgcn_s_waitcnt(0);
        const unsigned bx_ = opaque_s(b.x);
        unsigned nloc = b.st[0], nx = b.st[1];
        if (nloc == 0u) { xcd_barrier_complete(bar, bx_, nloc, nx); b.st[0] = nloc; b.st[1] = nx; }
        const unsigned old = xb_add(&bar[XB_XSUB(bx_)], 1u);
        const unsigned gen = old / nloc;
        if (old + 1u == (gen + 1u) * nloc) {
            __builtin_amdgcn_fence(__ATOMIC_RELEASE, "agent");
            asm volatile("s_waitcnt vmcnt(0)" ::: "memory");
            const unsigned og = xb_add(&bar[XB_TOP], 1u);
            const unsigned tg = og / nx;
            if (og + 1u == (tg + 1u) * nx) xb_add(&bar[XB_TOPGEN], 1u);
            else XB_SPIN(xb_ld(&bar[XB_TOPGEN]) == tg, bar);
            __builtin_amdgcn_fence(__ATOMIC_ACQUIRE, "agent");
            xb_add(&bar[XB_XGEN(bx_)], 1u);
            asm volatile("s_waitcnt vmcnt(0)" ::: "memory");
        } else {
            XB_SPIN(xb_ld(&bar[XB_XGEN(bx_)]) == gen, bar);
            __builtin_amdgcn_fence(__ATOMIC_ACQUIRE, "agent");
            asm volatile("s_waitcnt vmcnt(0)" ::: "memory");
        }
    }
    __syncthreads();
}

constexpr int BM = 256, BK = 64, HALF = 128, HTB = HALF * BK * 2, STAGE_BYTES = 8 * HTB, NXCD = 8, WGM = 8;
__host__ __device__ __forceinline__ int lds_byte(int r, int c) { const int st = (r >> 4) * 2 + (c >> 5), rr = r & 15, cc = c & 31, ob = rr * 64 + cc * 2; return st * 1024 + (ob ^ (((ob >> 9) & 1) << 5)); }
__host__ __device__ __forceinline__ void stage_rc(int b, int& R, int& C) { const int st = b / 1024, sb = b % 1024, swz = sb ^ (((sb >> 9) & 1) << 5); R = (st >> 1) * 16 + swz / 64; C = (st & 1) * 32 + (swz % 64) / 2; }
__host__ __device__ __forceinline__ int perm32(int rho) { const int n = rho >> 4, i = rho & 15; return 8 * (i >> 2) + 4 * n + (i & 3); }

struct Unit { const char* A; const char* B; int nt; int pm, pn, kind; const int* rows; int nvalid; };

__device__ __forceinline__ void rect_order(int L, int nM, int nN, int& im, int& in_) {
    const int nwg = nM * nN;
    int wgid = L; { const int q = nwg / NXCD, r = nwg % NXCD, xcd = wgid % NXCD, off = wgid / NXCD; wgid = (xcd < r ? xcd * (q + 1) : r * (q + 1) + (xcd - r) * q) + off; }
    const int nig = WGM * nN, gid = wgid / nig, fm = gid * WGM, gsz = (nM - fm) < WGM ? (nM - fm) : WGM;
    im = fm + ((wgid % nig) % gsz); in_ = (wgid % nig) / gsz;
}

template <int PA, int PB, class Epi, class Sched, bool GATHER = false>
__device__ __forceinline__ void gemm_stream(LAS unsigned char* lds, const Sched& S, const Epi& E) {
    const int tid = opaque(threadIdx.x), wid = __builtin_amdgcn_readfirstlane(tid >> 6), lane = tid & 63, wr = wid >> 2, wc = wid & 3, fr = lane & 15, fq = lane >> 4;
    unsigned voffA[2], voffB[2];
#pragma unroll
    for (int i = 0; i < 2; ++i) { int R, C; stage_rc(tid * 16 + i * 8192, R, C); const int Rb = Epi::PERM ? ((R & ~31) + perm32(R & 31)) : R;
        voffA[i] = (unsigned)(R * PA + C) * 2u; voffB[i] = (unsigned)(Rb * PB + C) * 2u; }
    constexpr size_t kstep = (size_t)(BK * 2);
    constexpr size_t hstepA = (size_t)HALF * PA * 2, hstepB = (size_t)HALF * PB * 2;
    const unsigned ldsw = (unsigned)wid * 1024u;
    const int aoff = lds_byte(wr * 64 + fr, fq * 8), boff = lds_byte(wc * 32 + fr, fq * 8);
#define G_SA(b, h) (((b) * 2 + (h)) * HTB)
#define G_SB(b, h) ((4 + (b) * 2 + (h)) * HTB)
#define G_STAGE(bufoff, gbase, voff) do { _Pragma("unroll") for (int _i = 0; _i < 2; ++_i) \
        __builtin_amdgcn_global_load_lds((const unsigned*)((const char*)(gbase) + (voff)[_i]), (LAS unsigned*)(lds + (bufoff) + ldsw + _i * 8192), 16, 0, 0); } while (0)
    unsigned gc[2][2], gn[2][2];
#define G_GOFF(U, G) do { int R_, C_; stage_rc(tid * 16, R_, C_); _Pragma("unroll") for (int h_ = 0; h_ < 2; ++h_) _Pragma("unroll") for (int i_ = 0; i_ < 2; ++i_) { \
        const int ix_ = h_ * 128 + R_ + 64 * i_; const int tk_ = ix_ < (U).nvalid ? ((U).rows[ix_] >> 1) : 0; (G)[h_][i_] = (unsigned)tk_ * (unsigned)(PA * 2) + (unsigned)(C_ * 2); } } while (0)
#define G_STAGEG(bufoff, gbase, g0, g1) do { \
        __builtin_amdgcn_global_load_lds((const unsigned*)((const char*)(gbase) + (g0)), (LAS unsigned*)(lds + (bufoff) + ldsw), 16, 0, 0); \
        __builtin_amdgcn_global_load_lds((const unsigned*)((const char*)(gbase) + (g1)), (LAS unsigned*)(lds + (bufoff) + ldsw + 8192), 16, 0, 0); } while (0)
#define G_STAGEA(bufoff, gbase, h, nx) do { if constexpr (GATHER) { const unsigned o0_ = (nx) ? gn[h][0] : gc[h][0], o1_ = (nx) ? gn[h][1] : gc[h][1]; G_STAGEG(bufoff, gbase, o0_, o1_); } \
        else G_STAGE(bufoff, (gbase) + (h) * hstepA, voffA); } while (0)
#define G_LDA(dst, b, h) do { _Pragma("unroll") for (int m = 0; m < 4; ++m) _Pragma("unroll") for (int k = 0; k < 2; ++k) dst[m][k] = *(const LAS bf16x8*)(lds + G_SA(b, h) + aoff + m * 2048 + k * 1024); } while (0)
#define G_LDB(dst, b, h) do { _Pragma("unroll") for (int n = 0; n < 2; ++n) _Pragma("unroll") for (int k = 0; k < 2; ++k) dst[n][k] = *(const LAS bf16x8*)(lds + G_SB(b, h) + boff + n * 2048 + k * 1024); } while (0)
#define G_MMA(ai, bj, At, Bt) do { __builtin_amdgcn_s_setprio(1); _Pragma("unroll") for (int m = 0; m < 4; ++m) _Pragma("unroll") for (int n = 0; n < 2; ++n) _Pragma("unroll") for (int k = 0; k < 2; ++k) \
        acc[ai][bj][m][n] = __builtin_amdgcn_mfma_f32_16x16x32_bf16(Bt[n][k], At[m][k], acc[ai][bj][m][n], 0, 0, 0); __builtin_amdgcn_s_setprio(0); } while (0)
#define G_WAIT_V(n) asm volatile("s_waitcnt vmcnt(" #n ")" ::: "memory")
#define G_WAIT_L(n) asm volatile("s_waitcnt lgkmcnt(" #n ")" ::: "memory")
#define G_BAR __builtin_amdgcn_s_barrier()
#define G_SCHED __builtin_amdgcn_sched_barrier(0)
    Unit cur, nxt; int ui = 0;
    if (!S.next(0, cur)) return;
    f32x4 acc[2][2][4][2];
#pragma unroll
    for (int a = 0; a < 2; ++a)
#pragma unroll
        for (int b = 0; b < 2; ++b)
#pragma unroll
            for (int m = 0; m < 4; ++m)
#pragma unroll
                for (int n = 0; n < 2; ++n) acc[a][b][m][n] = (f32x4){0.f, 0.f, 0.f, 0.f};
    bf16x8 At[4][2], B0[2][2], B1[2][2];
    const char* cA = cur.A; const char* cB = cur.B;
    if constexpr (GATHER) { G_GOFF(cur, gc); _Pragma("unroll") for (int h_ = 0; h_ < 2; ++h_) _Pragma("unroll") for (int i_ = 0; i_ < 2; ++i_) gn[h_][i_] = gc[h_][i_]; }
    G_STAGE(G_SB(0, 0), cB, voffB); G_STAGE(G_SB(0, 1), cB + hstepB, voffB); G_STAGEA(G_SA(0, 0), cA, 0, false); G_STAGEA(G_SA(0, 1), cA, 1, false);
    if (wr == 1) G_BAR;
    G_WAIT_V(2); G_BAR;
    G_STAGE(G_SB(1, 0), cB + kstep, voffB); G_STAGEA(G_SA(1, 0), cA + kstep, 0, false); G_STAGE(G_SB(1, 1), cB + hstepB + kstep, voffB);
    G_WAIT_V(6); G_BAR;
    for (;;) {
        const bool has_next = S.next(ui + 1, nxt);
        const char* nA = has_next ? nxt.A : cA; const char* nB = has_next ? nxt.B : cB;
        if constexpr (GATHER) { if (has_next) G_GOFF(nxt, gn); }
        const int nt = cur.nt;
        for (int t = 0; t < nt; t += 2) {
            const bool last = (t == nt - 2);
            const char* a1 = cA + (size_t)(t + 1) * kstep;
            const char* a2 = last ? nA : cA + (size_t)(t + 2) * kstep; const char* b2 = last ? nB : cB + (size_t)(t + 2) * kstep;
            const char* a3 = a2 + kstep; const char* b3 = b2 + kstep;
            G_LDB(B0, 0, 0); G_LDB(B1, 0, 1); G_SCHED; G_LDA(At, 0, 0); G_STAGEA(G_SA(1, 1), a1, 1, false);
            G_WAIT_V(8); G_WAIT_L(0); G_BAR; G_MMA(0, 0, At, B0); G_MMA(0, 1, At, B1); G_BAR; G_SCHED;
            G_LDA(At, 0, 1); G_STAGE(G_SB(0, 0), b2, voffB); G_STAGE(G_SB(0, 1), b2 + hstepB, voffB); G_STAGEA(G_SA(0, 0), a2, 0, last);
            G_WAIT_V(8); G_WAIT_L(0); G_BAR; G_MMA(1, 0, At, B0); G_MMA(1, 1, At, B1); G_BAR; G_SCHED;
            G_LDB(B0, 1, 0); G_LDB(B1, 1, 1); G_SCHED; G_LDA(At, 1, 0); G_STAGEA(G_SA(0, 1), a2, 1, last);
            G_WAIT_V(8); G_WAIT_L(0); G_BAR; G_MMA(0, 0, At, B0); G_MMA(0, 1, At, B1); G_BAR; G_SCHED;
            G_LDA(At, 1, 1); G_STAGE(G_SB(1, 0), b3, voffB); G_STAGE(G_SB(1, 1), b3 + hstepB, voffB); G_STAGEA(G_SA(1, 0), a3, 0, last);
            G_WAIT_V(8); G_WAIT_L(0); G_BAR; G_MMA(1, 0, At, B0); G_MMA(1, 1, At, B1); G_BAR; G_SCHED;
        }
        if (wr == 0) G_BAR;
        E(acc, cur, wr, wc, fr, fq);
        if (!has_next) break;
#pragma unroll
        for (int a = 0; a < 2; ++a)
#pragma unroll
            for (int b = 0; b < 2; ++b)
#pragma unroll
                for (int m = 0; m < 4; ++m)
#pragma unroll
                    for (int n = 0; n < 2; ++n) acc[a][b][m][n] = (f32x4){0.f, 0.f, 0.f, 0.f};
        cur = nxt; cA = nA; cB = nB; ++ui;
        if constexpr (GATHER) { _Pragma("unroll") for (int h_ = 0; h_ < 2; ++h_) _Pragma("unroll") for (int i_ = 0; i_ < 2; ++i_) gc[h_][i_] = gn[h_][i_]; }
        if (wr == 1) G_BAR;
    }
    G_WAIT_V(0);
    G_BAR;
#undef G_SA
#undef G_SB
#undef G_STAGE
#undef G_LDA
#undef G_GOFF
#undef G_STAGEG
#undef G_STAGEA
#undef G_LDB
#undef G_MMA
#undef G_WAIT_V
#undef G_WAIT_L
#undef G_BAR
#undef G_SCHED
}

struct Args { const float* in[32]; float* out; unsigned char* ws; int ph_lo, ph_hi; };
enum { I_X = 0, I_C, I_CTX, I_CCTX, I_WMOD, I_BMOD, I_NMIX, I_NFFN, I_WIN, I_GQN, I_GKN, I_CONVW, I_CONVB, I_LWA, I_LBA, I_LWI, I_LBI, I_LLAM,
       I_MQN, I_WQB, I_MKVN, I_WKVB, I_WBA, I_WBL, I_WBM, I_WOUT, I_RW, I_RB, I_MG, I_MU, I_MD, I_FN };
struct Frame {
    LAS unsigned char* lds; unsigned char* ws; const float* const* in; float* out;
    int tid, lane, wave, G, bx;
};
__device__ __forceinline__ Frame phase_frame(const Frame& F) { Frame P = F; P.bx = (int)opaque_s((unsigned)F.bx); return P; }
#define WSP(T, off) ((T*)(F.ws + (off)))
#define CTLW(idx) (((unsigned*)(F.ws + WS_CTL)) + (idx))
__device__ __forceinline__ float* xrow_ptr(const Frame& F, int r) {
    const int b = r / TT, t = r - b * TT;
    return t < CTXL ? WSP(float, WS_XC) + ((size_t)b * CTXL + t) * D : F.out + ((size_t)b * SEQ + (t - CTXL)) * D;
}
__device__ __forceinline__ const float* mod_ptr(const Frame& F, int l, int r, int which) {
    const int b = r / TT, t = r - b * TT; const int mr = t < CTXL ? 8 : b;
    return WSP(const float, WS_MOD) + ((size_t)(l * 9 + mr) * 6 + which) * D;
}

__device__ __forceinline__ int src_col_in(int p) {
    const int tile = p >> 8, q = p & 255, bj = q >> 7, wc = (q >> 5) & 3, s = q & 31, fq = s >> 3, n = (s >> 2) & 1, j = s & 3;
    const int hd = 32 * bj + 16 * n + 4 * fq + j;
    switch (tile) {
        case 0: case 1: return OFF_Q + (4 * tile + wc) * 64 + hd;
        case 2: return wc < 2 ? OFF_K + wc * 64 + hd : OFF_V + (wc - 2) * 64 + 32 * bj + s;
        case 3: case 4: return OFF_X + (tile - 3) * 256 + q;
        case 5: case 6: return OFF_Y + (tile - 5) * 256 + q;
        case 7: return OFF_CQ + q;
        case 8: return q < 128 ? OFF_CQ + 256 + q : OFF_CKV + (q - 128);
        default: if (q < 128) return OFF_CKV + 128 + q;
                 if (q < 160) return OFF_KR + 16 * n + 8 * (j >> 1) + 2 * fq + (j & 1);
                 return -1;
    }
}
__device__ __forceinline__ int rope32_dim(int s) { const int fq = s >> 3, n = (s >> 2) & 1, j = s & 3; return 16 * n + 8 * (j >> 1) + 2 * fq + (j & 1); }

struct WMat { int rows, K, pitch, nkb, items; };
struct WItem { const float* src; const float* ksc; bf16_t* dst; int ld, pitch, p0, k0, col; };
__device__ __forceinline__ WItem p0_item(const Frame& F, int it, int pl) {
    constexpr int NI_IN = 40 * 8, NI_GATE = 48 * 8, NI_QB = 12 * 3, NI_KVB = 16 * 2, NI_BR = 3 * 16 * 4, NI_OUT = 16 * 8, NI_GU = 256 * 8, NI_DN = 256 * 4;
    constexpr int NI_L = NI_IN + NI_GATE + NI_QB + NI_KVB + NI_BR + NI_OUT + NI_GU + NI_DN;
    WItem I;
    const int l = it / NI_L; int r = it - l * NI_L;
    const float* src; int ld, pitch, nkb, nrb; bf16_t* dst; int kind; const float* ksc = nullptr;
    unsigned char* wl = F.ws + WS_W + (size_t)l * W_LAYER;
    if (r < NI_IN) { kind = 0; src = F.in[I_WIN] + (size_t)l * D * INW; ld = INW; pitch = 1024; nkb = 8; nrb = 40; dst = (bf16_t*)(wl + W_IN); }
    else if ((r -= NI_IN) < NI_GATE) { kind = 1; src = F.in[I_WIN] + (size_t)l * D * INW; ld = INW; pitch = 1024; nkb = 8; nrb = 48; dst = (bf16_t*)(wl + W_GATE); }
    else if ((r -= NI_GATE) < NI_QB) { kind = 2; src = F.in[I_WQB] + (size_t)l * 384 * 768; ld = 768; pitch = 640; nkb = 3; nrb = 12; dst = (bf16_t*)(wl + W_QB); ksc = F.in[I_MQN] + l * 384; }
    else if ((r -= NI_QB) < NI_KVB) { kind = 3; src = F.in[I_WKVB] + (size_t)l * 256 * 1024; ld = 1024; pitch = 640; nkb = 2; nrb = 16; dst = (bf16_t*)(wl + W_KVB); ksc = F.in[I_MKVN] + l * 256; }
    else if ((r -= NI_KVB) < NI_BR) { kind = 4; const int b = r / 64; r -= b * 64; src = F.in[I_WBA + b] + (size_t)l * 512 * D; ld = D; pitch = 1024; nkb = 4; nrb = 16; dst = (bf16_t*)(wl + W_BR) + (size_t)b * 1024 * 1024; }
    else if ((r -= NI_BR) < NI_OUT) { kind = 5; src = F.in[I_WOUT] + (size_t)l * D * D; ld = D; pitch = 1024; nkb = 8; nrb = 16; dst = (bf16_t*)(wl + W_OUT); }
    else if ((r -= NI_OUT) < NI_GU) { kind = 6; src = nullptr; ld = 512; pitch = 1024; nkb = 8; nrb = 256; dst = (bf16_t*)(wl + W_GU); }
    else { r -= NI_GU; kind = 7; src = nullptr; ld = D; pitch = 512; nkb = 4; nrb = 256; dst = (bf16_t*)(wl + W_DN); }
    (void)nkb;
    const int kb = r / nrb, rb = r - kb * nrb, p0 = rb * 64, k0 = kb * 128, p = p0 + pl;
    int col;
    switch (kind) {
        case 0: col = src_col_in(p); break;
        case 1: col = OFF_G + p; break;
        case 2: col = p < 512 ? (p >> 6) * 96 + (p & 63) : (4 * (((p - 512) >> 7)) + (((p - 512) >> 5) & 3)) * 96 + 64 + rope32_dim((p - 512) & 31); break;
        case 3: col = p < 512 ? (p >> 6) * 128 + (p & 63) : ((p - 512) >> 6) * 128 + 64 + ((p - 512) & 63); break;
        case 6: { const int e = p >> 10, pp = p & 1023, t4 = pp >> 8, q = pp & 255;
                  src = F.in[q < 128 ? I_MG : I_MU] + ((size_t)l * 16 + e) * D * 512; col = t4 * 128 + (q & 127); } break;
        case 7: { const int e = p >> 10; src = F.in[I_MD] + ((size_t)l * 16 + e) * 512 * D; col = p & 1023; } break;
        default: col = p; break;
    }
    I.src = src; I.ksc = ksc; I.dst = dst; I.ld = ld; I.pitch = pitch; I.p0 = p0; I.k0 = k0; I.col = col;
    return I;
}
__device__ __forceinline__ void p0_weights(const Frame& F) {
    constexpr int NI_IN = 40 * 8, NI_GATE = 48 * 8, NI_QB = 12 * 3, NI_KVB = 16 * 2, NI_BR = 3 * 16 * 4, NI_OUT = 16 * 8, NI_GU = 256 * 8, NI_DN = 256 * 4;
    constexpr int NI_L = NI_IN + NI_GATE + NI_QB + NI_KVB + NI_BR + NI_OUT + NI_GU + NI_DN, NI_S = NI_QB + NI_KVB, NI_M = NI_L - NI_S;
    const int tid_ = opaque(F.tid); const int pl = tid_ & 63, kg = tid_ >> 6;
    {
        int it = F.bx, buf = 0; bool have = false, first = true;
        WItem cur = p0_item(F, 0, pl);
        float v[16];
#pragma unroll
        for (int i = 0; i < 16; ++i) v[i] = 0.f;
#pragma unroll 1
        for (;;) {
            const bool more = it < 2 * NI_M;
            if (!have && !more) break;
            LAS unsigned char* tile = F.lds + buf * (64 * 272);
            if (have) {
                u32x4 w0, w1;
#define P0_CONSUME(N) asm volatile("s_waitcnt vmcnt(" #N ")\n\tv_cvt_pk_bf16_f32 %0, %8, %9\n\tv_cvt_pk_bf16_f32 %1, %10, %11\n\tv_cvt_pk_bf16_f32 %2, %12, %13\n\tv_cvt_pk_bf16_f32 %3, %14, %15\n\t" \
                    "v_cvt_pk_bf16_f32 %4, %16, %17\n\tv_cvt_pk_bf16_f32 %5, %18, %19\n\tv_cvt_pk_bf16_f32 %6, %20, %21\n\tv_cvt_pk_bf16_f32 %7, %22, %23" \
                    : "=&v"(w0.x), "=&v"(w0.y), "=&v"(w0.z), "=&v"(w0.w), "=&v"(w1.x), "=&v"(w1.y), "=&v"(w1.z), "=&v"(w1.w) \
                    : "v"(v[0]), "v"(v[1]), "v"(v[2]), "v"(v[3]), "v"(v[4]), "v"(v[5]), "v"(v[6]), "v"(v[7]), "v"(v[8]), "v"(v[9]), "v"(v[10]), "v"(v[11]), "v"(v[12]), "v"(v[13]), "v"(v[14]), "v"(v[15]) : "memory")
                if (first) P0_CONSUME(0); else P0_CONSUME(2);
#undef P0_CONSUME
                first = false;
                if (cur.col < 0) { w0 = (u32x4){0u, 0u, 0u, 0u}; w1 = (u32x4){0u, 0u, 0u, 0u}; }
                *(LAS u32x4*)(tile + pl * 272 + kg * 32) = w0; *(LAS u32x4*)(tile + pl * 272 + kg * 32 + 16) = w1;
            }
            WItem nxt = cur;
            if (more) {
                const int l_ = it / NI_M, rr_ = it - l_ * NI_M;
                nxt = p0_item(F, l_ * NI_L + (rr_ < NI_IN + NI_GATE ? rr_ : rr_ + NI_S), pl);
                const float* sp_ = nxt.src + (size_t)(nxt.k0 + kg * 16) * nxt.ld + (nxt.col >= 0 ? nxt.col : 0);
#pragma unroll
                for (int i = 0; i < 16; ++i) { const float* q_ = sp_ + (size_t)i * nxt.ld; asm volatile("global_load_dword %0, %1, off" : "=v"(v[i]) : "v"(q_) : "memory"); }
            }
            __syncthreads();
            if (have) {
#pragma unroll
                for (int i = 0; i < 2; ++i) { const int id = tid_ + i * 512, row = id >> 4, ch = id & 15;
                    *(u32x4*)(cur.dst + (size_t)(cur.p0 + row) * cur.pitch + cur.k0 + ch * 8) = *(LAS u32x4*)(tile + row * 272 + ch * 16); }
                buf ^= 1;
            }
            have = more; cur = nxt; it += F.G;
        }
        asm volatile("s_waitcnt vmcnt(0)" ::: "memory");
    }
    __syncthreads();
    for (int i2 = F.bx; i2 < 2 * NI_S; i2 += F.G) {
        const int l_ = i2 / NI_S; const WItem I = p0_item(F, l_ * NI_L + NI_IN + NI_GATE + (i2 - l_ * NI_S), pl);
        LAS unsigned char* tile = F.lds;
        float v[16];
#pragma unroll
        for (int i = 0; i < 16; ++i) { const int k = I.k0 + kg * 16 + i; v[i] = I.src[(size_t)k * I.ld + I.col] * I.ksc[k]; }
        u32x4 w0, w1;
        w0.x = cvt_pk_bf16(v[0], v[1]); w0.y = cvt_pk_bf16(v[2], v[3]); w0.z = cvt_pk_bf16(v[4], v[5]); w0.w = cvt_pk_bf16(v[6], v[7]);
        w1.x = cvt_pk_bf16(v[8], v[9]); w1.y = cvt_pk_bf16(v[10], v[11]); w1.z = cvt_pk_bf16(v[12], v[13]); w1.w = cvt_pk_bf16(v[14], v[15]);
        *(LAS u32x4*)(tile + pl * 272 + kg * 32) = w0; *(LAS u32x4*)(tile + pl * 272 + kg * 32 + 16) = w1;
        __syncthreads();
#pragma unroll
        for (int i = 0; i < 2; ++i) { const int id = tid_ + i * 512, row = id >> 4, ch = id & 15;
            *(u32x4*)(I.dst + (size_t)(I.p0 + row) * I.pitch + I.k0 + ch * 8) = *(LAS u32x4*)(tile + row * 272 + ch * 16); }
        __syncthreads();
    }
}
__device__ __forceinline__ void p0_misc(const Frame& F) {
    const int gt = F.bx * NTHR + opaque(F.tid), GT = F.G * NTHR;
    bf16_t* wl = WSP(bf16_t, WS_WLRU);
    for (int i = gt; i < 2 * 2 * 2 * 8 * 64 * 64; i += GT) {
        const int k = i & 63, j = (i >> 6) & 63, n = (i >> 12) & 7, g = (i >> 15) & 1, d = (i >> 16) & 1, l = i >> 17;
        const float x = F.in[g ? I_LWI : I_LWA][((((size_t)(l * 2 + d) * 8 + n) * 64 + k) * 64) + j];
        wl[i] = (bf16_t)(cvt_pk_bf16(x, 0.f) & 0xffffu);
    }
    { float* rwt = WSP(float, WS_RWT); for (int i = gt; i < 16 * 1024; i += GT) { const int e = i >> 10, k = i & 1023; rwt[i] = F.in[I_RW][k * 16 + e]; } }
    f32x2* t64 = WSP(f32x2, WS_TAB64); f32x2* t32 = WSP(f32x2, WS_TAB32);
    for (int i = gt; i < 64 * 16 + 64 * 8; i += GT) {
        if (i < 1024) { const int p = i >> 4, q = i & 15; const float a = (float)p * exp2f(-13.287712379549449f * (float)q / 16.f); t64[i] = (f32x2){cosf(a), sinf(a)}; }
        else { const int ii = i - 1024, p = ii >> 3, q = ii & 7; const float a = (float)p * exp2f(-13.287712379549449f * (float)q / 8.f); t32[ii] = (f32x2){cosf(a), sinf(a)}; }
    }
}
__device__ __forceinline__ void p0_mod(const Frame& F) {
    LAS float* sv = (LAS float*)F.lds;
    LAS float* red = (LAS float*)(F.lds + 9 * 1024 * 4);
    if (F.bx >= 192) return;
    const int tid = opaque(F.tid);
    for (int i = tid; i < 9 * 1024; i += NTHR) { const int r = i >> 10, k = i & 1023; const float x = r < 8 ? F.in[I_C][r * D + k] : F.in[I_CCTX][k]; sv[i] = silu_f(x); }
    __syncthreads();
    for (int it = F.bx; it < 192; it += F.G) {
        const int l = it / 96, n0 = (it % 96) * 64, col = tid & 63, kg = tid >> 6;
        const float* w = F.in[I_WMOD] + (size_t)l * D * 6 * D + n0 + col;
        float acc[9];
#pragma unroll
        for (int r = 0; r < 9; ++r) acc[r] = 0.f;
#pragma unroll 4
        for (int k = kg * 128; k < kg * 128 + 128; ++k) { const float wv = w[(size_t)k * 6 * D];
#pragma unroll
            for (int r = 0; r < 9; ++r) acc[r] += sv[r * 1024 + k] * wv; }
#pragma unroll
        for (int r = 0; r < 9; ++r) red[(kg * 9 + r) * 64 + col] = acc[r];
        __syncthreads();
        for (int o = tid; o < 9 * 64; o += NTHR) { const int r = o >> 6, c = o & 63; float s = F.in[I_BMOD][l * 6 * D + n0 + c];
#pragma unroll
            for (int g = 0; g < 8; ++g) s += red[(g * 9 + r) * 64 + c];
            WSP(float, WS_MOD)[((size_t)(l * 9 + r)) * 6 * D + n0 + c] = s; }
        __syncthreads();
    }
}

__device__ __forceinline__ void moe_offsets(const Frame& F, int creg) {
    volatile LAS int* off = (volatile LAS int*)(F.lds + LDS_MISC + 128);
    if (F.tid == 0) { int s = 0; for (int e = 0; e < 16; ++e) { off[e] = s; const int c = (int)*CTLW(CW_CNT + creg * 64 + e); off[17 + e] = c; s += (c + 255) & ~255; } off[16] = s; }
    __syncthreads();
}
struct RowV { f32x4 v[4]; };
__device__ __forceinline__ RowV row_load(const float* p, int lane) { RowV r; const f32x4* q = (const f32x4*)p + lane;
#pragma unroll
    for (int j = 0; j < 4; ++j) r.v[j] = q[64 * j]; return r; }
__device__ __forceinline__ void row_store(float* p, int lane, const RowV& r) { f32x4* q = (f32x4*)p + lane;
#pragma unroll
    for (int j = 0; j < 4; ++j) q[64 * j] = r.v[j]; }
__device__ __forceinline__ float row_rstd(const RowV& r) { float s = 0.f;
#pragma unroll
    for (int j = 0; j < 4; ++j) s += (r.v[j][0] * r.v[j][0] + r.v[j][1] * r.v[j][1]) + (r.v[j][2] * r.v[j][2] + r.v[j][3] * r.v[j][3]);
    return rsqrtf(wave_sum(s) * (1.f / D) + EPS); }
__device__ __forceinline__ RowV row_normmod(const RowV& x, float rstd, const float* g, const float* shift, const float* scale, int lane) {
    RowV y;
#pragma unroll
    for (int j = 0; j < 4; ++j) { const f32x4 gv = ((const f32x4*)g)[lane + 64 * j]; f32x4 t = x.v[j] * rstd * gv;
        if (scale) { const f32x4 sc = ((const f32x4*)scale)[lane + 64 * j], sh = ((const f32x4*)shift)[lane + 64 * j]; t = t * (sc + 1.f) + sh; }
        y.v[j] = t; }
    return y;
}
__device__ __forceinline__ void row_store_bf16(bf16_t* p, int lane, const RowV& r) { u32x2* q = (u32x2*)p + lane;
#pragma unroll
    for (int j = 0; j < 4; ++j) { u32x2 w; w.x = cvt_pk_bf16(r.v[j][0], r.v[j][1]); w.y = cvt_pk_bf16(r.v[j][2], r.v[j][3]); q[64 * j] = w; } }
__device__ __forceinline__ RowV row_load_bf16(const bf16_t* p, int lane) { RowV r; const u32x2* q = (const u32x2*)p + lane;
#pragma unroll
    for (int j = 0; j < 4; ++j) { const u32x2 w = q[64 * j]; r.v[j] = (f32x4){bflo(w.x), bfhi(w.x), bflo(w.y), bfhi(w.y)}; } return r; }

struct RowIn { RowV x; u32x2 y0[4], y1[4]; int valid; float w0, w1; };
template <int MODE>
__device__ __forceinline__ RowIn rows_load(const Frame& F, int r, int lane, int s0, int s1, bool last) {
    RowIn in; in.valid = 0; in.w0 = 0.f; in.w1 = 0.f;
#pragma unroll
    for (int j = 0; j < 4; ++j) { in.x.v[j] = (f32x4){0.f, 0.f, 0.f, 0.f}; in.y0[j] = (u32x2){0u, 0u}; in.y1[j] = (u32x2){0u, 0u}; }
    if (r >= MALL) return in;
    const int b = r / TT, t = r - b * TT; const bool isctx = t < CTXL;
    if (last && isctx) return in;
    in.valid = 1;
    if (MODE == 0) in.x = row_load(isctx ? F.in[I_CTX] + ((size_t)b * CTXL + t) * D : F.in[I_X] + ((size_t)b * SEQ + (t - CTXL)) * D, lane);
    else {
        in.x = row_load_bf16((const bf16_t*)xrow_ptr(F, r), lane);
        const float* tw = WSP(const float, WS_ROUTE + RT_TW) + (size_t)r * 2; in.w0 = tw[0]; in.w1 = tw[1];
        const u32x2* q0 = (const u32x2*)(WSP(const bf16_t, WS_Y) + (size_t)s0 * D) + lane; const u32x2* q1 = (const u32x2*)(WSP(const bf16_t, WS_Y) + (size_t)s1 * D) + lane;
#pragma unroll
        for (int j = 0; j < 4; ++j) { in.y0[j] = q0[64 * j]; in.y1[j] = q1[64 * j]; }
    }
    return in;
}
template <int MODE>
__device__ __forceinline__ void phase_rows(const Frame& F, int l, int dry = 0) {
    const int gw = F.bx * NWAVES + F.wave, NGW = F.G * NWAVES, lane = opaque(F.lane);
    const bool last = (MODE == 1 && l == DEPTH - 1);
    const int ln = (MODE == 0) ? 0 : l + 1;
    const int RPV = (MALL + NGW - 1) / NGW, rbeg = gw * RPV, rend = (rbeg + RPV < MALL) ? rbeg + RPV : MALL;
    int s0all = 0, s1all = 0;
    if (MODE == 1) { moe_offsets(F, CREG(l)); const volatile LAS int* off = (const volatile LAS int*)(F.lds + LDS_MISC + 128);
        const int rr = rbeg + lane; if (lane < RPV && rr < MALL && !(last && (rr % TT) < CTXL)) { const int* te = WSP(const int, WS_ROUTE + RT_TE) + (size_t)rr * 2; const int* rk = WSP(const int, WS_ROUTE + RT_RANK) + (size_t)rr * 2;
            s0all = off[te[0]] + rk[0]; s1all = off[te[1]] + rk[1]; } }
    RowIn cur = rows_load<MODE>(F, rbeg < rend ? rbeg : MALL, lane, __builtin_amdgcn_readlane(s0all, 0), __builtin_amdgcn_readlane(s1all, 0), last);
    f32x4 gtv[4], gsv[4], shv[4]; int key = -1;
#pragma unroll
    for (int j = 0; j < 4; ++j) { gtv[j] = (f32x4){0.f, 0.f, 0.f, 0.f}; gsv[j] = (f32x4){0.f, 0.f, 0.f, 0.f}; shv[j] = (f32x4){0.f, 0.f, 0.f, 0.f}; }
#pragma unroll 1
    for (int k = 0; rbeg + k < rend; ++k) {
        const int r = rbeg + k;
        const RowIn nxt = rows_load<MODE>(F, r + 1 < rend ? r + 1 : MALL, lane, __builtin_amdgcn_readlane(s0all, k + 1), __builtin_amdgcn_readlane(s1all, k + 1), last);
        if (cur.valid) {
            float* xp = xrow_ptr(F, r);
            RowV x = cur.x;
            if (MODE == 0) { if (!dry) row_store_bf16((bf16_t*)xp, lane, x); }
            { const int kk = (r % TT) < CTXL ? NB : r / TT;
              if (kk != key) { key = kk;
#pragma unroll
                for (int j = 0; j < 4; ++j) {
                    if (MODE == 1) gtv[j] = ((const f32x4*)mod_ptr(F, l, r, 5))[lane + 64 * j];
                    if (last) { gsv[j] = ((const f32x4*)F.in[I_FN])[lane + 64 * j]; }
                    else { gsv[j] = ((const f32x4*)(F.in[I_NMIX] + ln * D))[lane + 64 * j] * (((const f32x4*)mod_ptr(F, ln, r, 1))[lane + 64 * j] + 1.f); shv[j] = ((const f32x4*)mod_ptr(F, ln, r, 0))[lane + 64 * j]; } } } }
            if (MODE == 1) {
#pragma unroll
                for (int j = 0; j < 4; ++j) { const u32x2 a = cur.y0[j], c = cur.y1[j];
                    const f32x4 ys = (f32x4){cur.w0 * bflo(a.x) + cur.w1 * bflo(c.x), cur.w0 * bfhi(a.x) + cur.w1 * bfhi(c.x), cur.w0 * bflo(a.y) + cur.w1 * bflo(c.y), cur.w0 * bfhi(a.y) + cur.w1 * bfhi(c.y)};
                    x.v[j] = x.v[j] + gtv[j] * ys; }
                if (!last && !dry) row_store_bf16((bf16_t*)xp, lane, x);
            }
            const float rstd = row_rstd(x);
            RowV y;
#pragma unroll
            for (int j = 0; j < 4; ++j) y.v[j] = x.v[j] * rstd * gsv[j] + shv[j];
            if (last) { if (!dry) row_store(xp, lane, y); else row_store_bf16(WSP(bf16_t, WS_H) + (size_t)r * D, lane, y); }
            else row_store_bf16(WSP(bf16_t, WS_H) + (size_t)r * D, lane, y);
        }
        cur = nxt;
    }
}

__device__ __forceinline__ void phase_ctxsum(const Frame& F) {
    const int gw = F.bx * NWAVES + F.wave, NGW = F.G * NWAVES, lane = opaque(F.lane);
    for (int r = gw; r < NB * CTXL; r += NGW) {
        const int b = r >> 8, t = r & 255;
        bf16_t* mp = WSP(bf16_t, WS_MERGED) + ((size_t)b * TT + t) * D;
        RowV m = row_load_bf16(mp, lane); const RowV p1 = row_load_bf16(WSP(const bf16_t, WS_PB) + (size_t)r * D, lane), p2 = row_load_bf16(WSP(const bf16_t, WS_PB) + ((size_t)2048 + r) * D, lane);
#pragma unroll
        for (int j = 0; j < 4; ++j) m.v[j] = (m.v[j] + p1.v[j]) + p2.v[j];
        row_store_bf16(mp, lane, m);
    }
}
__device__ __forceinline__ void phase_router(const Frame& F, int l, int creg) {
    LAS float* rwT = (LAS float*)F.lds;
    LAS int* lcnt = (LAS int*)(F.lds + 65536);
    LAS float* LG = (LAS float*)(F.lds + 65536 + 256);
    const bool last = (l == DEPTH - 1); const int tid = opaque(F.tid);
    for (int i = tid; i < 4 * 1024; i += NTHR) ((LAS f32x4*)rwT)[i] = WSP(const f32x4, WS_RWT)[i];
    if (tid < 32) lcnt[tid] = 0;
    __syncthreads();
    const int RPW = (MALL + F.G - 1) / F.G;
    const int r0 = F.bx * RPW, r1 = (r0 + RPW < MALL) ? r0 + RPW : MALL;
    const int lane = tid & 63;
    constexpr int RJ = 3;
    RowV xn[RJ];
#pragma unroll
    for (int j = 0; j < RJ; ++j) { const int r = r0 + F.wave + NWAVES * j; xn[j] = row_load_bf16((const bf16_t*)xrow_ptr(F, r < r1 ? r : r0), lane); }
    f32x4 gs[4], sh[4]; int key = -1;
#pragma unroll
    for (int j = 0; j < 4; ++j) { gs[j] = (f32x4){0.f, 0.f, 0.f, 0.f}; sh[j] = (f32x4){0.f, 0.f, 0.f, 0.f}; }
#pragma unroll 1
    for (int rb = r0 + F.wave; rb < r1; rb += NWAVES * RJ) {
        RowV x[RJ]; bool ok[RJ];
#pragma unroll
        for (int j = 0; j < RJ; ++j) x[j] = xn[j];
#pragma unroll
        for (int j = 0; j < RJ; ++j) { const int rn = rb + NWAVES * (RJ + j); xn[j] = row_load_bf16((const bf16_t*)xrow_ptr(F, rn < r1 ? rn : r0), lane); }
#pragma unroll
        for (int j = 0; j < RJ; ++j) {
            const int r = rb + NWAVES * j; const int b = r / TT, t = r - b * TT;
            ok[j] = r < r1 && !(last && t < CTXL);
            if (ok[j]) {
                if (t < CTXL) {
                    const RowV px = row_load(WSP(const float, WS_PB) + ((size_t)b * CTXL + t) * D, lane);
#pragma unroll
                    for (int q = 0; q < 4; ++q) x[j].v[q] = x[j].v[q] + px.v[q];
                    row_store_bf16((bf16_t*)xrow_ptr(F, r), lane, x[j]); }
                const int k = t < CTXL ? NB : b;
                if (k != key) { key = k; const float* g = F.in[I_NFFN] + l * D; const float* shp = mod_ptr(F, l, r, 3); const float* scp = mod_ptr(F, l, r, 4);
#pragma unroll
                    for (int q = 0; q < 4; ++q) { gs[q] = ((const f32x4*)g)[lane + 64 * q] * (((const f32x4*)scp)[lane + 64 * q] + 1.f); sh[q] = ((const f32x4*)shp)[lane + 64 * q]; } }
                const float rstd = row_rstd(x[j]);
#pragma unroll
                for (int q = 0; q < 4; ++q) x[j].v[q] = x[j].v[q] * rstd * gs[q] + sh[q];
                row_store_bf16(WSP(bf16_t, WS_H) + (size_t)r * D, lane, x[j]);
            }
        }
        float lg[RJ][8];
#pragma unroll
        for (int i = 0; i < 8; ++i) {
            f32x4 w0[4], w1[4];
#pragma unroll
            for (int q = 0; q < 4; ++q) { w0[q] = *(const LAS f32x4*)(rwT + i * 1024 + 256 * q + 4 * lane); w1[q] = *(const LAS f32x4*)(rwT + (i + 8) * 1024 + 256 * q + 4 * lane); }
#pragma unroll
            for (int j = 0; j < RJ; ++j) { float sa = 0.f, sb = 0.f;
#pragma unroll
                for (int q = 0; q < 4; ++q) { sa += (x[j].v[q][0] * w0[q][0] + x[j].v[q][1] * w0[q][1]) + (x[j].v[q][2] * w0[q][2] + x[j].v[q][3] * w0[q][3]);
                                              sb += (x[j].v[q][0] * w1[q][0] + x[j].v[q][1] * w1[q][1]) + (x[j].v[q][2] * w1[q][2] + x[j].v[q][3] * w1[q][3]); }
                const auto sw = __builtin_amdgcn_permlane32_swap(__float_as_uint(sa), __float_as_uint(sb), false, false);
                lg[j][i] = __uint_as_float(sw[0]) + __uint_as_float(sw[1]); }
            __builtin_amdgcn_sched_barrier(0);
        }
        const bool b3 = lane & 8, b2 = lane & 4;
#pragma unroll
        for (int j = 0; j < RJ; ++j) {
            const int r = rb + NWAVES * j;
#pragma unroll
            for (int i = 0; i < 4; ++i) { const auto sw = __builtin_amdgcn_permlane16_swap(__float_as_uint(lg[j][i]), __float_as_uint(lg[j][i + 4]), false, false); lg[j][i] = __uint_as_float(sw[0]) + __uint_as_float(sw[1]); }
#pragma unroll
            for (int i = 0; i < 2; ++i) { const float snd = b3 ? lg[j][i] : lg[j][i + 2], kp = b3 ? lg[j][i + 2] : lg[j][i]; lg[j][i] = kp + dpp_mov<0x128>(snd); }
            { const float snd = b2 ? lg[j][0] : lg[j][1], kp = b2 ? lg[j][1] : lg[j][0]; lg[j][0] = kp + __uint_as_float((unsigned)__builtin_amdgcn_ds_swizzle((int)__float_as_uint(snd), 0x101F)); }
            lg[j][0] += dpp_mov<0xB1>(lg[j][0]); lg[j][0] += dpp_mov<0x4E>(lg[j][0]);
            if (r < r1) { if (ok[j]) { if ((lane & 3) == 0) LG[(r - r0) * 16 + (lane >> 2)] = lg[j][0]; }
                          else if (lane == 0) LG[(r - r0) * 16] = __builtin_nanf(""); }
        }
    }
    __syncthreads();
    int e0 = -1, e1 = -1, lr0 = 0, lr1 = 0;
    const int myr = r0 + tid;
    if (tid < r1 - r0 && !(LG[tid * 16] != LG[tid * 16])) {
        float sc[16], sel[16];
#pragma unroll
        for (int e = 0; e < 16; ++e) { sc[e] = 1.f / (1.f + __expf(-LG[tid * 16 + e])); sel[e] = sc[e] + F.in[I_RB][e]; }
        int bg = 0; float bgs = -1e30f;
#pragma unroll
        for (int g = 0; g < 4; ++g) { float m1 = -1e30f, m2 = -1e30f;
#pragma unroll
            for (int i = 0; i < 4; ++i) { const float v = sel[g * 4 + i]; if (v > m1) { m2 = m1; m1 = v; } else if (v > m2) m2 = v; }
            const float gs = m1 + m2; if (gs > bgs) { bgs = gs; bg = g; } }
        float v0 = -1e30f, v1 = -1e30f, w0 = 0.f, w1 = 0.f;
#pragma unroll
        for (int e = 0; e < 16; ++e) { if ((e >> 2) == bg) { const float v = sel[e], sv = sc[e];
            if (v > v0) { v1 = v0; e1 = e0; w1 = w0; v0 = v; e0 = e; w0 = sv; } else if (v > v1) { v1 = v; e1 = e; w1 = sv; } } }
        const float ws = w0 + w1;
        float* tw = WSP(float, WS_ROUTE + RT_TW) + (size_t)myr * 2; tw[0] = w0 / ws; tw[1] = w1 / ws;
        int* te = WSP(int, WS_ROUTE + RT_TE) + (size_t)myr * 2; te[0] = e0; te[1] = e1;
        lr0 = __hip_atomic_fetch_add(&lcnt[e0], 1, __ATOMIC_RELAXED, __HIP_MEMORY_SCOPE_WORKGROUP); lr1 = __hip_atomic_fetch_add(&lcnt[e1], 1, __ATOMIC_RELAXED, __HIP_MEMORY_SCOPE_WORKGROUP);
    }
    __syncthreads();
    if (tid < 16) lcnt[16 + tid] = (int)atomicAdd(CTLW(CW_CNT + creg * 64 + tid), (unsigned)lcnt[tid]);
    __syncthreads();
    if (e0 >= 0) { int* rk = WSP(int, WS_ROUTE + RT_RANK) + (size_t)myr * 2; const int k0 = lcnt[16 + e0] + lr0, k1 = lcnt[16 + e1] + lr1; rk[0] = k0; rk[1] = k1;
        int* rl = WSP(int, WS_ROWL); rl[(size_t)e0 * MALL + k0] = myr * 2; rl[(size_t)e1 * MALL + k1] = myr * 2 + 1; }
    __syncthreads();
}

__device__ __forceinline__ int lat_tile(int j) { return (j >> 3) * 9 + 1 + (j & 7); }

struct SchedIn {
    const char* H; const char* W; int G, c; bool need_ctx;
    __device__ __forceinline__ bool next(int i, Unit& u) const {
        const int L = i * G + c; int pm, pn;
        if (need_ctx) { if (L >= NRT * 10) return false; rect_order(L, NRT, 10, pm, pn); }
        else if (L < 640) { int im; rect_order(L, 64, 10, im, pn); pm = lat_tile(im); }
        else { const int Lc = L - 640; if (Lc >= 40) return false; pm = (Lc / 5) * 9; const int q = Lc % 5; pn = q < 3 ? 2 + q : 5 + q; }
        u.pm = pm; u.pn = pn; u.kind = 0; u.nt = 16;
        u.A = H + (size_t)pm * 256 * 1024 * 2; u.B = W + (size_t)pn * 256 * 1024 * 2;
        return true;
    }
};
struct EpiIn {
    static constexpr bool PERM = true;
    bf16_t *QG, *KB, *VB, *XM, *CQKV, *KR; float *SSP; const float *qg, *kg; const f32x2 *t64, *t32; unsigned* kmx;
    __device__ __forceinline__ void operator()(const f32x4 (&acc)[2][2][4][2], const Unit& u, int wr, int wc, int fr, int fq) const {
        const int pn = u.pn, pmod = u.pm % 9; const bool lat = pmod != 0;
        const int rowb = u.pm * 256 + wr * 64 + fr, tb = (pmod - 1) * 256 + wr * 64 + fr;
        if (pn <= 2) {
            if (pn == 2 && wc >= 2) {
#pragma unroll
                for (int ai = 0; ai < 2; ++ai)
#pragma unroll
                    for (int m = 0; m < 4; ++m) { const size_t row = rowb + ai * 128 + m * 16;
#pragma unroll
                        for (int bj = 0; bj < 2; ++bj) *(u32x4*)(VB + row * 128 + (wc - 2) * 64 + 32 * bj + 8 * fq) = pack8(acc[ai][bj][m][0], acc[ai][bj][m][1]); }
            } else {
                const float* g = pn < 2 ? qg : kg; const float osc = pn < 2 ? C2Q : 1.f;
                float kmax = 0.f;
                f32x4 gv[2][2];
#pragma unroll
                for (int bj = 0; bj < 2; ++bj)
#pragma unroll
                    for (int n = 0; n < 2; ++n) gv[bj][n] = *(const f32x4*)(g + 32 * bj + 16 * n + 4 * fq);
#pragma unroll
                for (int ai = 0; ai < 2; ++ai)
#pragma unroll
                    for (int m = 0; m < 4; ++m) {
                        const size_t row = rowb + ai * 128 + m * 16;
                        f32x4 v[2][2]; float ss = 0.f;
#pragma unroll
                        for (int bj = 0; bj < 2; ++bj)
#pragma unroll
                            for (int n = 0; n < 2; ++n) { v[bj][n] = acc[ai][bj][m][n]; ss += (v[bj][n][0] * v[bj][n][0] + v[bj][n][1] * v[bj][n][1]) + (v[bj][n][2] * v[bj][n][2] + v[bj][n][3] * v[bj][n][3]); }
                        ss += __shfl_xor(ss, 16); ss += __shfl_xor(ss, 32);
                        const float rs = rsqrtf(ss * (1.f / 64.f) + EPS);
#pragma unroll
                        for (int bj = 0; bj < 2; ++bj)
#pragma unroll
                            for (int n = 0; n < 2; ++n) v[bj][n] = v[bj][n] * rs * gv[bj][n];
                        if (lat) {
                            const int t = tb + ai * 128 + m * 16, pr = t >> 6, pc = t & 63;
#pragma unroll
                            for (int j = 0; j < 4; ++j) {
                                const f32x2 cr = t64[pr * 16 + 4 * fq + j], cc = t64[pc * 16 + 4 * fq + j];
                                const float a1 = v[0][0][j], a2 = v[0][1][j]; v[0][0][j] = a1 * cr.x - a2 * cr.y; v[0][1][j] = a2 * cr.x + a1 * cr.y;
                                const float b1 = v[1][0][j], b2 = v[1][1][j]; v[1][0][j] = b1 * cc.x - b2 * cc.y; v[1][1][j] = b2 * cc.x + b1 * cc.y;
                            }
                        }
                        bf16_t* dst = pn < 2 ? QG + row * 1024 + (4 * pn + wc) * 64 : KB + row * 128 + wc * 64;
#pragma unroll
                        for (int bj = 0; bj < 2; ++bj) *(u32x4*)(dst + 32 * bj + 8 * fq) = pack8(v[bj][0] * osc, v[bj][1] * osc);
                        if (pn == 2) { float n2 = 0.f;
#pragma unroll
                            for (int bj = 0; bj < 2; ++bj)
#pragma unroll
                                for (int n = 0; n < 2; ++n) n2 += (v[bj][n][0] * v[bj][n][0] + v[bj][n][1] * v[bj][n][1]) + (v[bj][n][2] * v[bj][n][2] + v[bj][n][3] * v[bj][n][3]);
                            n2 += __shfl_xor(n2, 16); n2 += __shfl_xor(n2, 32); kmax = fmaxf(kmax, n2); }
                    }
                if (pn == 2) {
#pragma unroll
                    for (int o = 1; o < 16; o <<= 1) kmax = fmaxf(kmax, __shfl_xor(kmax, o));
                    if (fr == 0 && fq == 0) atomicMax(kmx + (u.pm / 9) * 32 + wc, __float_as_uint(kmax)); }
            }
        } else if (pn <= 4) {
#pragma unroll
            for (int ai = 0; ai < 2; ++ai)
#pragma unroll
                for (int m = 0; m < 4; ++m) { const size_t row = rowb + ai * 128 + m * 16;
#pragma unroll
                    for (int bj = 0; bj < 2; ++bj) *(u32x4*)(XM + row * 1024 + (pn - 3) * 256 + 128 * bj + 32 * wc + 8 * fq) = pack8(acc[ai][bj][m][0], acc[ai][bj][m][1]); }
        } else if (pn <= 6) {
#pragma unroll
            for (int ai = 0; ai < 2; ++ai)
#pragma unroll
                for (int m = 0; m < 4; ++m) { const size_t row = rowb + ai * 128 + m * 16;
#pragma unroll
                    for (int bj = 0; bj < 2; ++bj) { f32x4 a = acc[ai][bj][m][0], b = acc[ai][bj][m][1];
#pragma unroll
                        for (int j = 0; j < 4; ++j) { a[j] = gelu_tanh_f(a[j]); b[j] = gelu_tanh_f(b[j]); }
                        *(u32x4*)(QG + row * 1024 + 512 + (pn - 5) * 256 + 128 * bj + 32 * wc + 8 * fq) = pack8(a, b); } }
        } else {
#pragma unroll
            for (int bj = 0; bj < 2; ++bj) {
                const int sec = pn == 7 ? 0 : (pn == 8 ? bj : 1 + bj);
                if (sec == 2) {
                    if (wc != 0) continue;
                    float kmax = 0.f;
#pragma unroll
                    for (int ai = 0; ai < 2; ++ai)
#pragma unroll
                        for (int m = 0; m < 4; ++m) { const size_t row = rowb + ai * 128 + m * 16;
                            f32x4 v[2] = {acc[ai][1][m][0], acc[ai][1][m][1]};
                            if (lat) { const int t = tb + ai * 128 + m * 16, pr = t >> 6, pc = t & 63;
#pragma unroll
                                for (int j = 0; j < 2; ++j) { const f32x2 cr = t32[pr * 8 + 2 * fq + j], cc = t32[pc * 8 + 2 * fq + j];
                                    const float a1 = v[0][j], a2 = v[0][j + 2]; v[0][j] = a1 * cr.x - a2 * cr.y; v[0][j + 2] = a2 * cr.x + a1 * cr.y;
                                    const float b1 = v[1][j], b2 = v[1][j + 2]; v[1][j] = b1 * cc.x - b2 * cc.y; v[1][j + 2] = b2 * cc.x + b1 * cc.y; } }
                            *(u32x4*)(KR + row * 32 + 8 * fq) = pack8(v[0], v[1]);
                            float n2 = (v[0][0] * v[0][0] + v[0][1] * v[0][1]) + (v[0][2] * v[0][2] + v[0][3] * v[0][3]) + (v[1][0] * v[1][0] + v[1][1] * v[1][1]) + (v[1][2] * v[1][2] + v[1][3] * v[1][3]);
                            n2 += __shfl_xor(n2, 16); n2 += __shfl_xor(n2, 32); kmax = fmaxf(kmax, n2); }
#pragma unroll
                    for (int o = 1; o < 16; o <<= 1) kmax = fmaxf(kmax, __shfl_xor(kmax, o));
                    if (fr == 0 && fq == 0) atomicMax(kmx + (u.pm / 9) * 32 + 2, __float_as_uint(kmax));
                } else {
                    const int colb = (pn == 7 ? 128 * bj : (pn == 8 ? (bj == 0 ? 256 : 384) : 384 + 128)) + 32 * wc + 8 * fq;
                    const int grp = (pn == 7 ? 4 * bj : (pn == 8 ? (bj == 0 ? 8 : 12) : 16)) + wc;
#pragma unroll
                    for (int ai = 0; ai < 2; ++ai)
#pragma unroll
                        for (int m = 0; m < 4; ++m) { const size_t row = rowb + ai * 128 + m * 16;
                            const f32x4 a = acc[ai][bj][m][0], b = acc[ai][bj][m][1];
                            *(u32x4*)(CQKV + row * 640 + colb) = pack8(a, b);
                            float ss = (a[0] * a[0] + a[1] * a[1]) + (a[2] * a[2] + a[3] * a[3]) + (b[0] * b[0] + b[1] * b[1]) + (b[2] * b[2] + b[3] * b[3]);
                            ss += __shfl_xor(ss, 16); ss += __shfl_xor(ss, 32);
                            if (fq == 0) SSP[row * 20 + grp] = ss; }
                }
            }
        }
    }
};

struct SchedQKV {
    const char* CQKV; const char* WQ; const char* WKV; int G, c; bool need_ctx;
    __device__ __forceinline__ bool next(int i, Unit& u) const {
        const int L = i * G + c; const int nq = need_ctx ? NRT : 64;
        if (L < nq * 3) { int im, pn; rect_order(L, nq, 3, im, pn); const int pm = need_ctx ? im : lat_tile(im);
            u.pm = pm; u.pn = pn; u.kind = 0; u.nt = 6; u.A = CQKV + (size_t)pm * 256 * 640 * 2; u.B = WQ + (size_t)pn * 256 * 640 * 2; return true; }
        const int L2 = L - nq * 3; if (L2 >= NRT * 4) return false;
        int pm, pn; rect_order(L2, NRT, 4, pm, pn);
        u.pm = pm; u.pn = pn; u.kind = 1; u.nt = 4; u.A = CQKV + (size_t)pm * 256 * 640 * 2 + 384 * 2; u.B = WKV + (size_t)pn * 256 * 640 * 2; return true;
    }
};
struct EpiQKV {
    static constexpr bool PERM = true;
    bf16_t *QM, *KVM; const float *SSP; const f32x2* t32; unsigned* kmx;
    __device__ __forceinline__ void operator()(const f32x4 (&acc)[2][2][4][2], const Unit& u, int wr, int wc, int fr, int fq) const {
        const int pn = u.pn, pmod = u.pm % 9; const bool lat = pmod != 0;
        const int rowb = u.pm * 256 + wr * 64 + fr, tb = (pmod - 1) * 256 + wr * 64 + fr;
        float kmax[2] = {0.f, 0.f};
        float rsv[2][4];
#pragma unroll
        for (int ai = 0; ai < 2; ++ai)
#pragma unroll
            for (int m = 0; m < 4; ++m) { const size_t row = rowb + ai * 128 + m * 16;
                if (u.kind == 1) { const f32x4 s0 = *(const f32x4*)(SSP + row * 20 + 12), s1 = *(const f32x4*)(SSP + row * 20 + 16);
                    rsv[ai][m] = rsqrtf((((s0[0] + s0[1]) + (s0[2] + s0[3])) + ((s1[0] + s1[1]) + (s1[2] + s1[3]))) * (1.f / 256.f) + EPS); }
                else { const f32x4 s0 = *(const f32x4*)(SSP + row * 20), s1 = *(const f32x4*)(SSP + row * 20 + 4), s2 = *(const f32x4*)(SSP + row * 20 + 8);
                    rsv[ai][m] = rsqrtf((((s0[0] + s0[1]) + (s0[2] + s0[3])) + ((s1[0] + s1[1]) + (s1[2] + s1[3])) + ((s2[0] + s2[1]) + (s2[2] + s2[3]))) * (1.f / 384.f) + EPS); } }
#pragma unroll
        for (int ai = 0; ai < 2; ++ai)
#pragma unroll
            for (int m = 0; m < 4; ++m) {
                const size_t row = rowb + ai * 128 + m * 16;
                if (u.kind == 1) {
                    const float rs = rsv[ai][m];
#pragma unroll
                    for (int bj = 0; bj < 2; ++bj) { const f32x4 a = acc[ai][bj][m][0] * rs, c = acc[ai][bj][m][1] * rs;
                        *(u32x4*)(KVM + row * 1024 + pn * 256 + 128 * bj + 32 * wc + 8 * fq) = pack8(a, c);
                        if (pn < 2) { float n2 = (a[0] * a[0] + a[1] * a[1]) + (a[2] * a[2] + a[3] * a[3]) + (c[0] * c[0] + c[1] * c[1]) + (c[2] * c[2] + c[3] * c[3]);
                            n2 += __shfl_xor(n2, 16); n2 += __shfl_xor(n2, 32); kmax[bj] = fmaxf(kmax[bj], n2); } }
                } else {
                    const float rs = rsv[ai][m];
                    if (pn < 2) {
#pragma unroll
                        for (int bj = 0; bj < 2; ++bj) *(u32x4*)(QM + row * 768 + pn * 256 + 128 * bj + 32 * wc + 8 * fq) = pack8(acc[ai][bj][m][0] * (rs * C2M), acc[ai][bj][m][1] * (rs * C2M));
                    } else {
                        const int t = tb + ai * 128 + m * 16, pr = t >> 6, pc = t & 63;
#pragma unroll
                        for (int bj = 0; bj < 2; ++bj) {
                            f32x4 v[2] = {acc[ai][bj][m][0] * rs, acc[ai][bj][m][1] * rs};
                            if (lat) {
#pragma unroll
                                for (int j = 0; j < 2; ++j) { const f32x2 cr = t32[pr * 8 + 2 * fq + j], cc = t32[pc * 8 + 2 * fq + j];
                                    const float a1 = v[0][j], a2 = v[0][j + 2]; v[0][j] = a1 * cr.x - a2 * cr.y; v[0][j + 2] = a2 * cr.x + a1 * cr.y;
                                    const float b1 = v[1][j], b2 = v[1][j + 2]; v[1][j] = b1 * cc.x - b2 * cc.y; v[1][j + 2] = b2 * cc.x + b1 * cc.y; } }
                            *(u32x4*)(QM + row * 768 + 512 + (4 * bj + wc) * 32 + 8 * fq) = pack8(v[0] * C2M, v[1] * C2M);
                        }
                    }
                }
            }
        if (u.kind == 1 && pn < 2) {
#pragma unroll
            for (int bj = 0; bj < 2; ++bj) { float km = kmax[bj];
#pragma unroll
                for (int o = 1; o < 16; o <<= 1) km = fmaxf(km, __shfl_xor(km, o));
                if (fr == 0 && fq == 0) atomicMax(kmx + (u.pm / 9) * 32 + 8 + 2 * (4 * pn + 2 * bj + (wc >> 1)) + (wc & 1), __float_as_uint(km)); }
        }
    }
};

struct SchedMerge {
    const char *H, *QG, *XM, *WG, *WB; int G, c; bool need_ctx;
    __device__ __forceinline__ bool next(int i, Unit& u) const {
        const int nlat = c < 256 ? (256 - c + G - 1) / G : 0;
        int pm, pn, sub, ctxf = 0;
        if (i < 6 * nlat) { const int ti = i / 6; sub = i - ti * 6; int im; rect_order(ti * G + c, 64, 4, im, pn); pm = lat_tile(im); }
        else {
            if (!need_ctx) return false;
            const int q = (i - 6 * nlat) >> 1, ci = c + q * G; if (ci >= 96) return false;
            const int ct = ci / 3, b = ci - ct * 3; pm = (ct >> 2) * 9; pn = ct & 3; sub = 2 * b + ((i - 6 * nlat) & 1); ctxf = 8;
        }
        const int b = sub >> 1;
        u.pm = pm; u.pn = pn; u.kind = sub | ctxf;
        if ((sub & 1) == 0) { u.nt = 16; u.A = H + (size_t)pm * 256 * 1024 * 2; u.B = WG + (size_t)(b * 1024 + pn * 256) * 1024 * 2; }
        else { u.nt = 8; u.A = (b == 0 ? QG : (b == 1 ? QG + 512 * 2 : XM + 512 * 2)) + (size_t)pm * 256 * 1024 * 2; u.B = WB + (size_t)(b * 1024 + pn * 256) * 1024 * 2; }
        return true;
    }
};
struct EpiMerge {
    static constexpr bool PERM = true;
    bf16_t* MERGED; u32x4* stash; bf16_t* PB;
    __device__ __forceinline__ void operator()(const f32x4 (&acc)[2][2][4][2], const Unit& u, int wr, int wc, int fr, int fq) const {
        const int rowb = u.pm * 256 + wr * 64 + fr, tid = opaque(threadIdx.x), b = (u.kind & 7) >> 1; const bool ctxs = (u.kind & 8) != 0;
        if ((u.kind & 1) == 0) {
#pragma unroll
            for (int ai = 0; ai < 2; ++ai)
#pragma unroll
                for (int m = 0; m < 4; ++m)
#pragma unroll
                    for (int bj = 0; bj < 2; ++bj) { f32x4 a = acc[ai][bj][m][0], c = acc[ai][bj][m][1];
#pragma unroll
                        for (int j = 0; j < 4; ++j) { a[j] = sigmoid_f(a[j]); c[j] = sigmoid_f(c[j]); }
                        stash[(size_t)(((ai * 4 + m) * 2 + bj) * 512 + tid)] = pack8(a, c); }
            return;
        }
        const bool rmw = b > 0 && !ctxs;
        u32x4 g[2][2], p[2][2], gq[2][2], pq[2][2];
#define EM_LOAD(G, P, am) do { const int ai_ = (am) >> 1, mh_ = (am) & 1; _Pragma("unroll") for (int mm = 0; mm < 2; ++mm) _Pragma("unroll") for (int bj = 0; bj < 2; ++bj) { const int m = mh_ * 2 + mm; \
        G[mm][bj] = ld16_sc1(stash + (size_t)(((ai_ * 4 + m) * 2 + bj) * 512 + tid)); \
        const u32x4* mp_ = (const u32x4*)(MERGED + (size_t)(rowb + ai_ * 128 + m * 16) * 1024 + u.pn * 256 + 128 * bj + 32 * wc + 8 * fq); \
        P[mm][bj] = rmw ? ld16_sc1(mp_) : (u32x4){0u, 0u, 0u, 0u}; } } while (0)
        EM_LOAD(g, p, 0);
#pragma unroll
        for (int am = 0; am < 4; ++am) { const int ai = am >> 1, mh = am & 1;
            if (am < 3) EM_LOAD(gq, pq, am + 1);
#pragma unroll
            for (int mm = 0; mm < 2; ++mm)
#pragma unroll
                for (int bj = 0; bj < 2; ++bj) { const int m = mh * 2 + mm; const u32x4 gg = g[mm][bj], pp = p[mm][bj];
                    f32x4 a = acc[ai][bj][m][0], c = acc[ai][bj][m][1];
                    a[0] = a[0] * bflo(gg.x) + bflo(pp.x); a[1] = a[1] * bfhi(gg.x) + bfhi(pp.x); a[2] = a[2] * bflo(gg.y) + bflo(pp.y); a[3] = a[3] * bfhi(gg.y) + bfhi(pp.y);
                    c[0] = c[0] * bflo(gg.z) + bflo(pp.z); c[1] = c[1] * bfhi(gg.z) + bfhi(pp.z); c[2] = c[2] * bflo(gg.w) + bflo(pp.w); c[3] = c[3] * bfhi(gg.w) + bfhi(pp.w);
                    u32x4* mp = (u32x4*)(MERGED + (size_t)(rowb + ai * 128 + m * 16) * 1024 + u.pn * 256 + 128 * bj + 32 * wc + 8 * fq);
                    if (ctxs && b > 0) mp = (u32x4*)(PB + ((size_t)(b - 1) * 2048 + (u.pm / 9) * 256 + wr * 64 + fr + ai * 128 + m * 16) * 1024 + u.pn * 256 + 128 * bj + 32 * wc + 8 * fq);
                    *mp = pack8(a, c); g[mm][bj] = gq[mm][bj]; p[mm][bj] = pq[mm][bj]; }
        }
#undef EM_LOAD
    }
};

struct SchedOut {
    const char *A, *W; int G, c; bool need_ctx;
    __device__ __forceinline__ bool next(int i, Unit& u) const {
        const int nlat = c < 256 ? (256 - c + G - 1) / G : 0;
        if (i < nlat) { int im, pn; rect_order(i * G + c, 64, 4, im, pn); const int pm = lat_tile(im);
            u.pm = pm; u.pn = pn; u.kind = 0; u.nt = 16; u.A = A + (size_t)pm * 256 * 1024 * 2; u.B = W + (size_t)pn * 256 * 1024 * 2; return true; }
        if (!need_ctx) return false;
        const int ci = c + (i - nlat) * G; if (ci >= 64) return false;
        const int ct = ci >> 1, kh = ci & 1, pm = (ct >> 2) * 9, pn = ct & 3;
        u.pm = pm; u.pn = pn; u.kind = 1 + kh; u.nt = 8; u.A = A + (size_t)pm * 256 * 1024 * 2 + kh * 512 * 2; u.B = W + (size_t)pn * 256 * 1024 * 2 + kh * 512 * 2; return true;
    }
};
struct EpiOut {
    static constexpr bool PERM = true;
    static constexpr int XP = 2048;
    float* xc; float* xl; const float* mod; float* PX;
    __device__ __forceinline__ void operator()(const f32x4 (&acc)[2][2][4][2], const Unit& u, int wr, int wc, int fr, int fq) const {
        const int b = u.pm / 9, pmod = u.pm - b * 9;
        const float* gate = mod + ((size_t)(pmod == 0 ? 8 : b) * 6 + 2) * D;
        const size_t row0 = pmod == 0 ? (size_t)b * CTXL : (size_t)b * SEQ + (pmod - 1) * 256;
        float* pxb = PX + (size_t)b * CTXL * D;
        bf16_t* xw = (bf16_t*)(pmod == 0 ? xc : xl) + row0 * XP;
        const int r0 = opaque(wr * 64 + fr), c0 = u.pn * 256 + 32 * wc + 8 * fq;
        f32x4 gv[2][2];
#pragma unroll
        for (int bj = 0; bj < 2; ++bj)
#pragma unroll
            for (int n = 0; n < 2; ++n) gv[bj][n] = *(const f32x4*)(gate + c0 + 128 * bj + 4 * n);
        u32x4 xv[2][2], xn[2][2];
#define EO_LOAD(dst, am) do { const int ai_ = (am) >> 1, m0_ = ((am) & 1) * 2; _Pragma("unroll") for (int mm = 0; mm < 2; ++mm) _Pragma("unroll") for (int bj = 0; bj < 2; ++bj) \
        dst[mm][bj] = (u.kind != 2) ? *(const u32x4*)(xw + (size_t)(r0 + ai_ * 128 + (m0_ + mm) * 16) * XP + c0 + 128 * bj) : (u32x4){0u, 0u, 0u, 0u}; } while (0)
        EO_LOAD(xv, 0);
#pragma unroll
        for (int am = 0; am < 4; ++am) { const int ai = am >> 1, m0 = (am & 1) * 2;
            if (am < 3) EO_LOAD(xn, am + 1);
#pragma unroll
            for (int mm = 0; mm < 2; ++mm)
#pragma unroll
                for (int bj = 0; bj < 2; ++bj) { const size_t row = r0 + ai * 128 + (m0 + mm) * 16; const u32x4 w = xv[mm][bj];
                    const f32x4 o0 = (f32x4){bflo(w.x), bfhi(w.x), bflo(w.y), bfhi(w.y)} + gv[bj][0] * acc[ai][bj][m0 + mm][0], o1 = (f32x4){bflo(w.z), bfhi(w.z), bflo(w.w), bfhi(w.w)} + gv[bj][1] * acc[ai][bj][m0 + mm][1];
                    if (u.kind == 2) { *(f32x4*)(pxb + row * D + c0 + 128 * bj) = o0; *(f32x4*)(pxb + row * D + c0 + 128 * bj + 4) = o1; }
                    else *(u32x4*)(xw + row * XP + c0 + 128 * bj) = pack8(o0, o1);
                    xv[mm][bj] = xn[mm][bj]; }
        }
#undef EO_LOAD
    }
};

struct SchedMoe {
    const char *A, *W; const int* rowl; const volatile LAS int* off; int G, c, second;
    __device__ __forceinline__ bool next(int i, Unit& u) const {
        const int L = i * G + c; const int ntile = off[16] >> 8;
        if (L >= ntile * 4) return false;
        int im, pn; rect_order(L, ntile, 4, im, pn);
        int e = 0;
#pragma unroll
        for (int q = 1; q < 16; ++q) e += (im * 256 >= off[q]) ? 1 : 0;
        e = __builtin_amdgcn_readfirstlane(e);
        u.pm = im; u.pn = pn; u.kind = e;
        if (!second) { const int j0 = im * 256 - off[e]; u.nt = 16; u.A = A; u.rows = rowl + (size_t)e * MALL + j0; u.nvalid = off[17 + e] - j0; u.B = W + (size_t)(e * 1024 + pn * 256) * 1024 * 2; }
        else { u.nt = 8; u.A = A + (size_t)im * 256 * 512 * 2; u.rows = nullptr; u.nvalid = 0; u.B = W + (size_t)(e * 1024 + pn * 256) * 512 * 2; }
        return true;
    }
};
struct EpiMoe1 {
    static constexpr bool PERM = true;
    bf16_t* ACT;
    __device__ __forceinline__ void operator()(const f32x4 (&acc)[2][2][4][2], const Unit& u, int wr, int wc, int fr, int fq) const {
        const int rowb = u.pm * 256 + wr * 64 + fr;
#pragma unroll
        for (int ai = 0; ai < 2; ++ai)
#pragma unroll
            for (int m = 0; m < 4; ++m) { const size_t row = rowb + ai * 128 + m * 16;
                f32x4 o[2];
#pragma unroll
                for (int n = 0; n < 2; ++n)
#pragma unroll
                    for (int j = 0; j < 4; ++j) o[n][j] = silu_f(acc[ai][0][m][n][j]) * acc[ai][1][m][n][j];
                *(u32x4*)(ACT + row * 512 + u.pn * 128 + 32 * wc + 8 * fq) = pack8(o[0], o[1]); }
    }
};
struct EpiMoe2 {
    static constexpr bool PERM = true;
    bf16_t* Y;
    __device__ __forceinline__ void operator()(const f32x4 (&acc)[2][2][4][2], const Unit& u, int wr, int wc, int fr, int fq) const {
        const int rowb = u.pm * 256 + wr * 64 + fr;
#pragma unroll
        for (int ai = 0; ai < 2; ++ai)
#pragma unroll
            for (int m = 0; m < 4; ++m)
#pragma unroll
                for (int bj = 0; bj < 2; ++bj) *(u32x4*)(Y + (size_t)(rowb + ai * 128 + m * 16) * 1024 + u.pn * 256 + 128 * bj + 32 * wc + 8 * fq) = pack8(acc[ai][bj][m][0], acc[ai][bj][m][1]);
    }
};

constexpr int AT_VB = 8192, AT_KB = 16384;
constexpr int AT_V = 0, AT_K = 3 * AT_VB, AT_WS = AT_K + 3 * AT_KB, AT_OST = AT_WS + NWAVES * 256, AT_BYTES = AT_OST + NWAVES * 4096;
static_assert(AT_BYTES <= LDS_STAGE, "attention LDS");
__device__ __forceinline__ int crow(int r, int hi) { return (r & 3) + 8 * (r >> 2) + 4 * hi; }
template <int DK> __device__ __forceinline__ int kswz(int row, int colB) { return DK == 64 ? row * 128 + (colB ^ (((row >> 1) & 7) << 4)) : row * 256 + (colB ^ ((row & 15) << 4)); }
__device__ __forceinline__ int v_st(int k, int c) { const int kk = (k & ~0xC) | ((k & 4) << 1) | ((k & 8) >> 1); return ((kk >> 3) * 2 + (c >> 5)) * 512 + ((kk & 7) * 32 + (c & 31)) * 2; }
__device__ __forceinline__ int v_rd_base(int lane) { return ((lane & 3) << 3) | (((lane >> 2) & 3) << 6) | (((lane >> 4) & 1) << 5) | (((lane >> 5) & 1) << 8); }
constexpr int v_rd_off(int d0, int ks, int half) { return d0 * 512 + ks * 2048 + half * 1024; }
template <int OFF> __device__ __forceinline__ s16x4 tr_read(int vb) { s16x4 r; asm volatile("ds_read_b64_tr_b16 %0, %1 offset:%2" : "=&v"(r) : "v"(vb), "i"(OFF) : "memory"); return r; }

__device__ __forceinline__ void expA(f32x16& p0) {
#pragma unroll
    for (int r = 0; r < 16; ++r) p0[r] = fast_exp2(p0[r]);
}
__device__ __forceinline__ void finishSM(f32x16& p0, f32x16& p1, float& l_reg, bf16x8& pa0, bf16x8& pa1, bf16x8& pa2, bf16x8& pa3) {
#pragma unroll
    for (int r = 0; r < 16; ++r) p1[r] = fast_exp2(p1[r]);
    float ps = 0;
#pragma unroll
    for (int r = 0; r < 16; ++r) ps += p0[r];
#pragma unroll
    for (int r = 0; r < 16; ++r) ps += p1[r];
    l_reg += ps;
#define PK4(P, BASE, OUT) do { unsigned a0 = cvt_pk_bf16(P[BASE + 0], P[BASE + 1]), a1 = cvt_pk_bf16(P[BASE + 2], P[BASE + 3]);   \
    unsigned b0 = cvt_pk_bf16(P[BASE + 4], P[BASE + 5]), b1 = cvt_pk_bf16(P[BASE + 6], P[BASE + 7]);                              \
    auto r0 = __builtin_amdgcn_permlane32_swap(a0, b0, false, false); auto r1 = __builtin_amdgcn_permlane32_swap(a1, b1, false, false); \
    u32x4 w = {r0[0], r1[0], r0[1], r1[1]}; OUT = *reinterpret_cast<bf16x8*>(&w); } while (0)
    PK4(p0, 0, pa0); PK4(p0, 8, pa1); PK4(p1, 0, pa2); PK4(p1, 8, pa3);
#undef PK4
}
template <int DK>
__device__ __forceinline__ void qkt(f32x16& p0, f32x16& p1, int Ks, const bf16x8* qr, const f32x16& cinit, int r32, int hi) {
#pragma unroll
    for (int d0 = 0; d0 < DK / 16; ++d0) { const int cb = (d0 * 16 + hi * 8) * 2;
        const bf16x8 b0 = *(const LAS bf16x8*)(uintptr_t)(Ks + kswz<DK>(r32, cb));
        const bf16x8 b1 = *(const LAS bf16x8*)(uintptr_t)(Ks + kswz<DK>(32 + r32, cb));
        if (d0 == 0) { p0 = __builtin_amdgcn_mfma_f32_32x32x16_bf16(b0, qr[0], cinit, 0, 0, 0); p1 = __builtin_amdgcn_mfma_f32_32x32x16_bf16(b1, qr[0], cinit, 0, 0, 0); }
        else { p0 = __builtin_amdgcn_mfma_f32_32x32x16_bf16(b0, qr[d0], p0, 0, 0, 0); p1 = __builtin_amdgcn_mfma_f32_32x32x16_bf16(b1, qr[d0], p1, 0, 0, 0); } }
}
__device__ __forceinline__ void pv_d0(f32x16* o, int vb, bf16x8 pa0, bf16x8 pa1, bf16x8 pa2, bf16x8 pa3) {
#define TR8(D0, l0, h0, l1, h1, l2, h2, l3, h3) const s16x4 l0 = tr_read<v_rd_off(D0, 0, 0)>(vb), h0 = tr_read<v_rd_off(D0, 0, 1)>(vb), l1 = tr_read<v_rd_off(D0, 1, 0)>(vb), h1 = tr_read<v_rd_off(D0, 1, 1)>(vb), \
    l2 = tr_read<v_rd_off(D0, 2, 0)>(vb), h2 = tr_read<v_rd_off(D0, 2, 1)>(vb), l3 = tr_read<v_rd_off(D0, 3, 0)>(vb), h3 = tr_read<v_rd_off(D0, 3, 1)>(vb)
    TR8(0, a0, b0, a1, b1, a2, b2, a3, b3); TR8(1, c0, d0, c1, d1, c2, d2, c3, d3);
#undef TR8
    asm volatile("s_waitcnt lgkmcnt(0)" ::: "memory"); SBAR();
#define PK(L, H) (bf16x8){L[0], L[1], L[2], L[3], H[0], H[1], H[2], H[3]}
    o[0] = __builtin_amdgcn_mfma_f32_32x32x16_bf16(pa0, PK(a0, b0), o[0], 0, 0, 0); o[1] = __builtin_amdgcn_mfma_f32_32x32x16_bf16(pa0, PK(c0, d0), o[1], 0, 0, 0);
    o[0] = __builtin_amdgcn_mfma_f32_32x32x16_bf16(pa1, PK(a1, b1), o[0], 0, 0, 0); o[1] = __builtin_amdgcn_mfma_f32_32x32x16_bf16(pa1, PK(c1, d1), o[1], 0, 0, 0);
    o[0] = __builtin_amdgcn_mfma_f32_32x32x16_bf16(pa2, PK(a2, b2), o[0], 0, 0, 0); o[1] = __builtin_amdgcn_mfma_f32_32x32x16_bf16(pa2, PK(c2, d2), o[1], 0, 0, 0);
    o[0] = __builtin_amdgcn_mfma_f32_32x32x16_bf16(pa3, PK(a3, b3), o[0], 0, 0, 0); o[1] = __builtin_amdgcn_mfma_f32_32x32x16_bf16(pa3, PK(c3, d3), o[1], 0, 0, 0);
#undef PK
}
template <int DK>
__device__ __forceinline__ void attn_unit(const bf16_t* Qb, int ldq, const bf16_t* Qr, const bf16_t* __restrict__ Kh, int ldk, const bf16_t* __restrict__ K2,
                                          const bf16_t* __restrict__ Vh, int ldv, bf16_t* Ob, int ldo, int nkeys, float k2max, int ldsb) {
    const int tid = opaque(threadIdx.x), wid = tid >> 6, lane = tid & 63, r32 = lane & 31, hi = lane >> 5;
    const int V_lds = ldsb + AT_V, K_lds = ldsb + AT_K;
    LAS float* li_l = (LAS float*)(uintptr_t)(ldsb + AT_WS + wid * 256);
    float l_reg = 0; f32x16 o[2] = {}; bf16x8 qr[DK / 16];
    { const bf16_t* Qw = Qb + (size_t)(wid * 32 + r32) * ldq + hi * 8;
#pragma unroll
      for (int d0 = 0; d0 < 4; ++d0) qr[d0] = *(const bf16x8*)(Qw + d0 * 16);
      if constexpr (DK == 96) { const bf16_t* Qw2 = Qr + (size_t)(wid * 32 + r32) * ldq + hi * 8;
#pragma unroll
        for (int d0 = 0; d0 < 2; ++d0) qr[4 + d0] = *(const bf16x8*)(Qw2 + d0 * 16); } }
    f32x16 cinit;
    {
        float qn = 0.f;
#pragma unroll
        for (int d0 = 0; d0 < DK / 16; ++d0) { const u32x4 w = *reinterpret_cast<const u32x4*>(&qr[d0]);
            qn += (bflo(w.x) * bflo(w.x) + bfhi(w.x) * bfhi(w.x)) + (bflo(w.y) * bflo(w.y) + bfhi(w.y) * bfhi(w.y)) + (bflo(w.z) * bflo(w.z) + bfhi(w.z) * bfhi(w.z)) + (bflo(w.w) * bflo(w.w) + bfhi(w.w) * bfhi(w.w)); }
        qn += __shfl_xor(qn, 32);
        const float nm = 32.f - sqrtf(qn * k2max * 1.03f);
#pragma unroll
        for (int r = 0; r < 16; ++r) cinit[r] = nm;
    }
    const int sr = tid >> 3, sc = (tid & 7) * 8;
    const int sr2 = (tid >> 2) & 63, sc2 = (tid & 3) * 8;
    const int kst = kswz<DK>(sr, sc * 2), kst2 = kswz<DK>(sr2, (64 + sc2) * 2), vst = v_st(sr, sc);
    const int vb0 = V_lds + v_rd_base(lane);
    constexpr int SD = 2, S1 = SD - 1;
    struct { bf16x8 k, k2, v; } sr_[SD];
#define SLOAD(i, k0) do { sr_[i].v = *(const bf16x8*)(Vh + (size_t)((k0) + sr) * ldv + sc); sr_[i].k = *(const bf16x8*)(Kh + (size_t)((k0) + sr) * ldk + sc); \
    if constexpr (DK == 96) sr_[i].k2 = *(const bf16x8*)(K2 + (size_t)((k0) + sr2) * 32 + sc2); } while (0)
#define SWRITE(b, i) do { *(LAS bf16x8*)(uintptr_t)(V_lds + (b) * AT_VB + vst) = sr_[i].v; *(LAS bf16x8*)(uintptr_t)(K_lds + (b) * AT_KB + kst) = sr_[i].k; \
    if constexpr (DK == 96) *(LAS bf16x8*)(uintptr_t)(K_lds + (b) * AT_KB + kst2) = sr_[i].k2; } while (0)
    f32x16 pA0, pA1, pB0, pB1; bf16x8 pa0, pa1, pa2, pa3; const int NT = nkeys / 64;
    SLOAD(0, 0); SWRITE(0, 0); SLOAD(S1, 64); SWRITE(1, S1); if constexpr (SD == 2) { if (2 < NT) SLOAD(0, 128); }
    __syncthreads();
    qkt<DK>(pA0, pA1, K_lds, qr, cinit, r32, hi); expA(pA0);
    int bp = 0, bq = 1, bn = 2;
#define STEP(C0, C1, P0, P1, SL_LD, SL_WR, J) do { \
        SBAR(); qkt<DK>(C0, C1, K_lds + bq * AT_KB, qr, cinit, r32, hi); \
        finishSM(P0, P1, l_reg, pa0, pa1, pa2, pa3); SBAR(); \
        if ((J) + SD < NT) SLOAD(SL_LD, ((J) + SD) * 64); SBAR(); \
        pv_d0(o, vb0 + bp * AT_VB, pa0, pa1, pa2, pa3); expA(C0); \
        if ((J) + 1 < NT) SWRITE(bn, SL_WR); \
        __syncthreads(); \
        bp = bq; bq = bn; bn = (bn == 2) ? 0 : bn + 1; } while (0)
    for (int j = 1; j + 1 < NT; j += 2) {
        STEP(pB0, pB1, pA0, pA1, S1, 0, j);
        STEP(pA0, pA1, pB0, pB1, 0, S1, j + 1);
    }
    SBAR(); qkt<DK>(pB0, pB1, K_lds + bq * AT_KB, qr, cinit, r32, hi);
    finishSM(pA0, pA1, l_reg, pa0, pa1, pa2, pa3); SBAR();
    pv_d0(o, vb0 + bp * AT_VB, pa0, pa1, pa2, pa3); expA(pB0);
    finishSM(pB0, pB1, l_reg, pa0, pa1, pa2, pa3); SBAR();
    pv_d0(o, vb0 + bq * AT_VB, pa0, pa1, pa2, pa3);
#undef STEP
    l_reg += __shfl_xor(l_reg, 32);
    if (hi == 0) li_l[r32] = l_reg; asm volatile("s_waitcnt lgkmcnt(0)" ::: "memory");
    {
        const int ost = ldsb + AT_OST + wid * 4096;
#pragma unroll
        for (int r = 0; r < 16; ++r) { const int orow = crow(r, hi); const float rl = fast_rcp(li_l[orow]);
#pragma unroll
            for (int d0 = 0; d0 < 2; ++d0) *(LAS unsigned short*)(uintptr_t)(ost + orow * 128 + (d0 * 32 + r32) * 2) = (unsigned short)(cvt_pk_bf16(o[d0][r] * rl, 0.f) & 0xffffu); }
        asm volatile("s_waitcnt lgkmcnt(0)" ::: "memory");
        bf16_t* Ow = Ob + (size_t)(wid * 32) * ldo;
#pragma unroll
        for (int i = 0; i < 4; ++i) { const int id = lane + 64 * i, row = id >> 3, ch = id & 7;
            *(u32x4*)(Ow + (size_t)row * ldo + ch * 8) = *(const LAS u32x4*)(uintptr_t)(ost + row * 128 + ch * 16); }
    }
    __syncthreads();
#undef SLOAD
#undef SWRITE
}

constexpr int LRU_UROW = 1040;
constexpr int LRU_GY = 64 * LRU_UROW;
static_assert(LRU_GY + 64 * LRU_UROW <= LDS_MISC, "lru lds");
template <bool FINAL, int DIR>
__device__ __forceinline__ void lru_dir(const Frame& F, int l, int b, int ch, int nt2, f32x16 (&hf)[2], float cin_in) {
    const int lane = opaque(F.lane), w = F.wave, r32 = lane & 31, hi = lane >> 5, d = DIR;
    LAS unsigned char* U = F.lds;
    LAS unsigned char* GYT = F.lds + LRU_GY;
    const int c = w * 64 + nt2 * 32 + r32;
    const bf16_t* WL = WSP(const bf16_t, WS_WLRU) + (size_t)l * (2 * 2 * 8 * 64 * 64);
    float* TOT = WSP(float, WS_TOT);
    const float nba = -LOG2E * F.in[I_LBA][(l * 2 + d) * 512 + c], nbi = -LOG2E * F.in[I_LBI][(l * 2 + d) * 512 + c];
    const float c8 = -8.f * LOG2E * log1pf(__expf(-F.in[I_LLAM][(l * 2 + d) * 512 + c]));
    f32x16 av[2], bq[2];
    bf16x8 wa[4], wi[4];
#pragma unroll
    for (int ks = 0; ks < 4; ++ks) {
        wa[ks] = *(const bf16x8*)(WL + ((size_t)((d * 2 + 0) * 8 + w) * 64 + nt2 * 32 + r32) * 64 + ks * 16 + hi * 8);
        wi[ks] = *(const bf16x8*)(WL + ((size_t)((d * 2 + 1) * 8 + w) * 64 + nt2 * 32 + r32) * 64 + ks * 16 + hi * 8); }
#pragma unroll
    for (int mt = 0; mt < 2; ++mt) {
        f32x16 xa = {}, xi = {};
#pragma unroll
        for (int ks = 0; ks < 4; ++ks) {
            const bf16x8 af = *(const LAS bf16x8*)(U + (mt * 32 + r32) * LRU_UROW + (w * 64 + ks * 16 + hi * 8) * 2);
            xa = __builtin_amdgcn_mfma_f32_32x32x16_bf16(af, wa[ks], xa, 0, 0, 0); xi = __builtin_amdgcn_mfma_f32_32x32x16_bf16(af, wi[ks], xi, 0, 0, 0); }
#pragma unroll
        for (int r = 0; r < 16; ++r) {
            const float uv = bf2f(*(const LAS unsigned short*)(U + (mt * 32 + crow(r, hi)) * LRU_UROW + c * 2));
            const float rg = fast_rcp(1.f + fast_exp2(fmaf(xa[r], -LOG2E, nba))), ig = fast_rcp(1.f + fast_exp2(fmaf(xi[r], -LOG2E, nbi)));
            const float a = fast_exp2(c8 * rg);
            av[mt][r] = a; bq[mt][r] = __builtin_amdgcn_sqrtf(fmaxf(fmaf(-a, a, 1.f), 0.f)) * ig * uv;
        }
    }
    float cin = FINAL ? cin_in : 0.f, Atot = 1.f;
    float mycin[2][4];
#pragma unroll
    for (int q = 0; q < 2; ++q) {
        const int mt = d == 0 ? q : 1 - q;
#pragma unroll
        for (int qs = 0; qs < 4; ++qs) {
            const int sl = d == 0 ? qs : 3 - qs;
            float As = 1.f, Bs = 0.f;
#pragma unroll
            for (int k = 0; k < 4; ++k) { const int r = 4 * sl + (d == 0 ? k : 3 - k); As *= av[mt][r]; Bs = av[mt][r] * Bs + bq[mt][r]; }
            const auto ra = __builtin_amdgcn_permlane32_swap(__float_as_uint(As), __float_as_uint(As), false, false), rb = __builtin_amdgcn_permlane32_swap(__float_as_uint(Bs), __float_as_uint(Bs), false, false);
            const float A0 = __uint_as_float(ra[0]), A1 = __uint_as_float(ra[1]), B0 = __uint_as_float(rb[0]), B1 = __uint_as_float(rb[1]);
            float c0v, c1v;
            if (d == 0) { c0v = cin; cin = A0 * cin + B0; c1v = cin; cin = A1 * cin + B1; }
            else { c1v = cin; cin = A1 * cin + B1; c0v = cin; cin = A0 * cin + B0; }
            mycin[mt][sl] = hi ? c1v : c0v; Atot *= A0 * A1;
        }
    }
    if (!FINAL) { if (hi == 0) { float* tp = TOT + ((size_t)(b * 2 + d) * NCH + ch) * 1024 + c; tp[0] = Atot; tp[512] = cin; } }
    else {
#pragma unroll
        for (int mt = 0; mt < 2; ++mt)
#pragma unroll
            for (int sl = 0; sl < 4; ++sl) { float h = mycin[mt][sl];
#pragma unroll
                for (int k = 0; k < 4; ++k) { const int r = 4 * sl + (d == 0 ? k : 3 - k); h = av[mt][r] * h + bq[mt][r];
                    if (d == 0) hf[mt][r] = h;
                    else { LAS unsigned short* op = (LAS unsigned short*)(GYT + (mt * 32 + crow(r, hi)) * LRU_UROW + c * 2);
                           *op = (unsigned short)(cvt_pk_bf16((hf[mt][r] + h) * bf2f(*op), 0.f) & 0xffffu); } } }
    }
}
template <bool FINAL>
__device__ __forceinline__ void lru_unit(const Frame& F, int l, int b, int ch, int half = -1) {
    const int tid = opaque(F.tid);
    LAS unsigned char* U = F.lds;
    const bf16_t* XM = WSP(const bf16_t, WS_XM);
    const int t0 = ch * 64, seglo = ch < 4 ? 0 : CTXL, seghi = ch < 4 ? CTXL : TT;
    float cpre[2][2] = {{0.f, 0.f}, {0.f, 0.f}};
    if (FINAL) {
        const int r32 = opaque(F.lane) & 31;
#pragma unroll
        for (int d = 0; d < 2; ++d) {
            const float* tp = WSP(const float, WS_TOT) + ((size_t)(b * 2 + d) * NCH) * 1024 + F.wave * 64 + r32;
            const int n0 = d == 0 ? 0 : (ch >= 4 ? 4 : 3 - ch);
            const int nst = d == 0 ? ch : (ch >= 4 ? 4 + (NCH - 1 - ch) : 3 - ch);
            float c0 = 0.f, c1 = 0.f;
#pragma unroll 1
            for (int s0 = 0; s0 < nst; s0 += 16) {
                float Aq[2][16], Bq[2][16];
#pragma unroll
                for (int q = 0; q < 16; ++q) { const int st = s0 + q; const bool ok = st < nst;
                    const int j = d == 0 ? st : (st < n0 ? 3 - st : NCH - 1 - (st - n0));
                    const int jj = ok ? j : 0;
#pragma unroll
                    for (int n = 0; n < 2; ++n) { const float Av = tp[jj * 1024 + n * 32], Bv = tp[jj * 1024 + 512 + n * 32]; Aq[n][q] = ok ? Av : 1.f; Bq[n][q] = ok ? Bv : 0.f; } }
#pragma unroll
                for (int q = 0; q < 16; ++q) { c0 = Aq[0][q] * c0 + Bq[0][q]; c1 = Aq[1][q] * c1 + Bq[1][q]; }
            }
            cpre[0][d] = c0; cpre[1][d] = c1;
        }
    }
    {
        const int c0 = (tid & 63) * 8, tg = tid >> 6;
        u32x4 xr[11];
#pragma unroll
        for (int i = 0; i < 11; ++i) { const int t = t0 + tg * 8 - 1 + i;
            xr[i] = (t >= seglo && t < seghi) ? *(const u32x4*)(XM + (size_t)(b * TT + t) * 1024 + c0) : (u32x4){0u, 0u, 0u, 0u}; }
        const float* cw = F.in[I_CONVW] + (size_t)l * 4 * 512 + c0; const float* cb = F.in[I_CONVB] + l * 512 + c0;
        f32x4 wv[4][2], bv[2];
#pragma unroll
        for (int j = 0; j < 4; ++j) { wv[j][0] = *(const f32x4*)(cw + j * 512); wv[j][1] = *(const f32x4*)(cw + j * 512 + 4); }
        bv[0] = *(const f32x4*)cb; bv[1] = *(const f32x4*)(cb + 4);
#pragma unroll
        for (int tt = 0; tt < 8; ++tt) { f32x4 a0 = bv[0], a1 = bv[1];
#pragma unroll
            for (int j = 0; j < 4; ++j) { const u32x4 x = xr[tt + j];
                a0 += wv[j][0] * (f32x4){bflo(x.x), bfhi(x.x), bflo(x.y), bfhi(x.y)}; a1 += wv[j][1] * (f32x4){bflo(x.z), bfhi(x.z), bflo(x.w), bfhi(x.w)}; }
            *(LAS u32x4*)(U + (tg * 8 + tt) * LRU_UROW + c0 * 2) = pack8(a0, a1); }
        if (FINAL) {
            bf16_t* QG = WSP(bf16_t, WS_QG);
            if (half < 0 || ((c0 >> 5) & 1) == half) {
#pragma unroll
            for (int tt = 0; tt < 8; ++tt) *(LAS u32x4*)(F.lds + LRU_GY + (tg * 8 + tt) * LRU_UROW + c0 * 2) = *(const u32x4*)(QG + (size_t)(b * TT + t0 + tg * 8 + tt) * 1024 + 512 + c0); }
        }
    }
    __syncthreads();
#pragma unroll 1
    for (int nt2 = (half < 0 ? 0 : half); nt2 < (half < 0 ? 2 : half + 1); ++nt2) {
        f32x16 hf[2];
        lru_dir<FINAL, 0>(F, l, b, ch, nt2, hf, nt2 ? cpre[1][0] : cpre[0][0]);
        lru_dir<FINAL, 1>(F, l, b, ch, nt2, hf, nt2 ? cpre[1][1] : cpre[0][1]);
    }
    __syncthreads();
    if (FINAL) {
        const int tid2 = opaque(F.tid), c0 = (tid2 & 63) * 8, tg = tid2 >> 6; bf16_t* QG = WSP(bf16_t, WS_QG);
        if (half < 0 || ((c0 >> 5) & 1) == half) {
#pragma unroll
        for (int tt = 0; tt < 8; ++tt) *(u32x4*)(QG + (size_t)(b * TT + t0 + tg * 8 + tt) * 1024 + 512 + c0) = *(const LAS u32x4*)(F.lds + LRU_GY + (tg * 8 + tt) * LRU_UROW + c0 * 2); }
        __syncthreads();
    }
}
#ifdef MK_DBG_DET
namespace mkdbg {
__global__ void k_chk(const unsigned* base, long rows, long pitch_w, long off_w, long width_w, const int* rowidx, unsigned long long* acc) {
    unsigned long long s = 0;
    const long total = rows * width_w;
    for (long i = blockIdx.x * (long)blockDim.x + threadIdx.x; i < total; i += (long)gridDim.x * blockDim.x) {
        const long r = i / width_w, c = i - r * width_w; const long rr = rowidx ? rowidx[r] : r;
        const unsigned v = base[rr * pitch_w + off_w + c];
        s += (unsigned long long)v * (unsigned long long)(2 * (i % 1021) + 1);
    }
    for (int o = 32; o > 0; o >>= 1) s += __shfl_xor(s, o);
    if ((threadIdx.x & 63) == 0) atomicAdd(acc, s);
}
__global__ void k_verdict(const unsigned long long* a, const unsigned long long* b, int n, float* out, long nout) {
    int code = n;
    for (int p = n - 1; p >= 0; --p) if (a[p] != b[p]) code = p;
    const float v = exp2f((float)(code + 1));
    for (long i = blockIdx.x * (long)blockDim.x + threadIdx.x; i < nout; i += (long)gridDim.x * blockDim.x) out[i] = v;
}
}
#endif

__device__ __forceinline__ void phase_attn(const Frame& F, int l) {
    const bool need_ctx = (l < DEPTH - 1);
    const int ldsb = (int)(uintptr_t)F.lds;
    bf16_t* QG = WSP(bf16_t, WS_QG); bf16_t* XM = WSP(bf16_t, WS_XM);
    const bf16_t* KB = WSP(const bf16_t, WS_KB); const bf16_t* VB = WSP(const bf16_t, WS_VB);
    const bf16_t* QM = WSP(const bf16_t, WS_QM); const bf16_t* KVM = WSP(const bf16_t, WS_KVM); const bf16_t* KR = WSP(const bf16_t, WS_KR);
    const float* kmx = (const float*)CTLW(CW_KMAX + l * 256);
    const int n_ctx = need_ctx ? 128 : 0, n_lru = need_ctx ? NB * NCH * 2 : NB * (NCH - 4);
    const int total = 1024 + n_ctx + n_lru;
    for (int id = F.bx; id < total; id += F.G) {
        int typ, b, h, qrow, nk, ch = 0, half = -1;
        if (id < 512) {
            const int r = id >> 8, wq = id & 255, x = wq & 7, j = wq >> 3, pp = x + 8 * r; b = pp >> 1; h = (pp & 1) * 4 + (j >> 3); qrow = CTXL + (j & 7) * 256; nk = TT; typ = 0;
        } else if (id < 1024) {
            const int i2 = id - 512, r = i2 >> 8, wq = i2 & 255, x = wq & 7, j = wq >> 3, idx = (x + 8 * r) * 4 + (j >> 3); b = idx >> 3; h = idx & 7; qrow = CTXL + (j & 7) * 256; nk = TT; typ = 1;
        } else if (id < 1024 + n_lru) { const int i2 = id - 1024; typ = 2; h = 0; qrow = 0; nk = 0;
            if (need_ctx) { const int u2 = i2 >> 1; half = i2 & 1; b = u2 / NCH; ch = u2 - b * NCH; } else { b = i2 / (NCH - 4); ch = 4 + i2 - b * (NCH - 4); } }
        else { const int i2 = id - 1024 - n_lru; b = (i2 & 63) >> 3; h = i2 & 7; qrow = 0; nk = CTXL; typ = i2 < 64 ? 0 : 1; }
        const size_t row0 = (size_t)b * TT + qrow, key0 = (size_t)b * TT;
        if (typ == 0) { const int kvh = h >> 2;
            if (nk == TT) attn_unit<64>(QG + row0 * 1024 + h * 64, 1024, nullptr, KB + key0 * 128 + kvh * 64, 128, nullptr, VB + key0 * 128 + kvh * 64, 128, QG + row0 * 1024 + h * 64, 1024, TT, kmx[b * 32 + kvh], ldsb);
            else attn_unit<64>(QG + row0 * 1024 + h * 64, 1024, nullptr, KB + key0 * 128 + kvh * 64, 128, nullptr, VB + key0 * 128 + kvh * 64, 128, QG + row0 * 1024 + h * 64, 1024, CTXL, kmx[b * 32 + kvh], ldsb);
        } else if (typ == 1) { const float k2 = kmx[b * 32 + 8 + 2 * h] + kmx[b * 32 + 9 + 2 * h] + kmx[b * 32 + 2];
            if (nk == TT) attn_unit<96>(QM + row0 * 768 + h * 64, 768, QM + row0 * 768 + 512 + h * 32, KVM + key0 * 1024 + h * 64, 1024, KR + key0 * 32, KVM + key0 * 1024 + 512 + h * 64, 1024, XM + row0 * 1024 + 512 + h * 64, 1024, TT, k2, ldsb);
            else attn_unit<96>(QM + row0 * 768 + h * 64, 768, QM + row0 * 768 + 512 + h * 32, KVM + key0 * 1024 + h * 64, 1024, KR + key0 * 32, KVM + key0 * 1024 + 512 + h * 64, 1024, XM + row0 * 1024 + 512 + h * 64, 1024, CTXL, k2, ldsb);
        } else lru_unit<true>(F, l, b, ch, half);
    }
}

constexpr int NPHASE = 2 + DEPTH * 10;
#ifndef MK_MASK
#define MK_MASK 0xFFF
#endif
#define PM(k) ((MK_MASK >> (k)) & 1)
#ifndef MK_REPGRP
#define MK_REPGRP 0
#endif
#define REPN(k) (1 + ((MK_REP >> (k)) & 1))
__global__ void __launch_bounds__(NTHR, 2) mk_fwd(Args args) {
    extern __shared__ __attribute__((aligned(16))) unsigned char lds_raw[];
    Frame F0;
    F0.lds = (LAS unsigned char*)lds_raw; F0.ws = args.ws; F0.in = args.in; F0.out = args.out;
    F0.tid = threadIdx.x; F0.lane = F0.tid & 63; F0.wave = __builtin_amdgcn_readfirstlane(F0.tid >> 6); F0.G = gridDim.x; F0.bx = blockIdx.x;
    const Frame& F = F0;
    volatile LAS unsigned* misc = (volatile LAS unsigned*)(F.lds + LDS_MISC);
    if (F.tid < 64) misc[F.tid] = 0u;
    __syncthreads();
    XcdBarrier bar; bar.bar = CTLW(CW_BAR); bar.x = 0; bar.st = nullptr;
#if !MK_PER_PHASE
    bar = xcd_barrier_post(CTLW(CW_BAR), misc + 8);
#endif
    const int lo = args.ph_lo, hi = args.ph_hi;
#ifndef MK_TIME_BLK
#define MK_TIME_BLK 0
#endif
#ifdef MK_TIME_A
#define STAMP(k) do { if (F.bx == MK_TIME_BLK && F.tid == 0) { if ((k) == MK_TIME_A) misc[16] = (unsigned)__builtin_amdgcn_s_memrealtime(); if ((k) == MK_TIME_B) misc[17] = (unsigned)__builtin_amdgcn_s_memrealtime(); } } while (0)
#else
#define STAMP(k) do { } while (0)
#endif
#define IN(k) (lo <= (k) && (k) < hi)
#if MK_PER_PHASE
#define SEAM(k) do { } while (0)
#else
#define SEAM(k) do { if (IN(k) && IN((k) + 1)) xcd_barrier(bar); } while (0)
#endif
    STAMP(0);
    if (PM(0) && IN(0)) for (int rep_ = 0; rep_ < REPN(0); ++rep_) { if (rep_) xcd_barrier(bar); const Frame F = phase_frame(F0); p0_mod(F); __syncthreads();
        p0_weights(F); p0_misc(F); }
    SEAM(0);
    STAMP(1);
    if (PM(1) && IN(1)) for (int rep_ = 0; rep_ < REPN(1); ++rep_) { if (rep_) xcd_barrier(bar); const Frame F = phase_frame(F0); phase_rows<0>(F, 0); }
    SEAM(1);
#pragma unroll 1
    for (int l = 0; l < DEPTH; ++l) {
        const int pb = 2 + l * 10; const bool need_ctx = (l < DEPTH - 1);
        STAMP(pb + 0);
#if MK_REPGRP
        for (int grp_ = 0; grp_ < 2; ++grp_) { if (grp_) xcd_barrier(bar);
#endif
        if (PM(2) && IN(pb + 0)) for (int rep_ = 0; rep_ < REPN(2); ++rep_) { if (rep_) xcd_barrier(bar); const Frame F = phase_frame(F0); unsigned char* wl = F.ws + WS_W + (size_t)l * W_LAYER;
            SchedIn S{(const char*)(F.ws + WS_H), (const char*)(wl + W_IN), F.G, F.bx, need_ctx};
            EpiIn E{WSP(bf16_t, WS_QG), WSP(bf16_t, WS_KB), WSP(bf16_t, WS_VB), WSP(bf16_t, WS_XM), WSP(bf16_t, WS_CQKV), WSP(bf16_t, WS_KR),
                    WSP(float, WS_SSP), F.in[I_GQN] + l * 64, F.in[I_GKN] + l * 64, WSP(const f32x2, WS_TAB64), WSP(const f32x2, WS_TAB32), CTLW(CW_KMAX + l * 256)};
            gemm_stream<1024, 1024, EpiIn, SchedIn>(F.lds, S, E);
        }
        SEAM(pb + 0);
        STAMP(pb + 1);
        if (PM(3) && IN(pb + 1)) for (int rep_ = 0; rep_ < REPN(3); ++rep_) { if (rep_) xcd_barrier(bar); const Frame F = phase_frame(F0); unsigned char* wl = F.ws + WS_W + (size_t)l * W_LAYER;
            const int nx = NB * NCH - F.G > 0 && NB * NCH - F.G < F.G ? NB * NCH - F.G : 0;
            SchedQKV S{(const char*)(F.ws + WS_CQKV), (const char*)(wl + W_QB), (const char*)(wl + W_KVB), F.G - nx, F.bx >= nx ? F.bx - nx : (1 << 28), need_ctx};
            EpiQKV E{WSP(bf16_t, WS_QM), WSP(bf16_t, WS_KVM), WSP(const float, WS_SSP), WSP(const f32x2, WS_TAB32), CTLW(CW_KMAX + l * 256)};
            gemm_stream<640, 640, EpiQKV, SchedQKV>(F.lds, S, E);
            __syncthreads();
            for (int id = F.bx; id < NB * NCH; id += F.G) lru_unit<false>(F, l, id / NCH, id % NCH);
        }
        SEAM(pb + 1);
        STAMP(pb + 2);
        if (PM(4) && IN(pb + 2)) for (int rep_ = 0; rep_ < REPN(4); ++rep_) { if (rep_) xcd_barrier(bar); const Frame F = phase_frame(F0); phase_attn(F, l); }
#if MK_REPGRP
        if (grp_ == 0) continue; }
#endif
        SEAM(pb + 2);
        STAMP(pb + 3);
        if (PM(5) && IN(pb + 3)) for (int rep_ = 0; rep_ < REPN(5); ++rep_) { if (rep_) xcd_barrier(bar); const Frame F = phase_frame(F0); unsigned char* wl = F.ws + WS_W + (size_t)l * W_LAYER;
            SchedMerge S{(const char*)(F.ws + WS_H), (const char*)(F.ws + WS_QG), (const char*)(F.ws + WS_XM), (const char*)(wl + W_GATE), (const char*)(wl + W_BR), F.G, F.bx, need_ctx};
            EpiMerge E{WSP(bf16_t, WS_MERGED), (u32x4*)(F.ws + WS_STASH + (size_t)(F.bx & 255) * 131072), WSP(bf16_t, WS_PB)};
            gemm_stream<1024, 1024, EpiMerge, SchedMerge>(F.lds, S, E);
        }
        SEAM(pb + 3);
        STAMP(pb + 4);
        if (IN(pb + 4) && need_ctx) { const Frame F = phase_frame(F0); phase_ctxsum(F); }
        if (need_ctx) SEAM(pb + 4);
        STAMP(pb + 5);
        if (PM(6) && IN(pb + 5)) for (int rep_ = 0; rep_ < REPN(6); ++rep_) { if (rep_) xcd_barrier(bar); const Frame F = phase_frame(F0); unsigned char* wl = F.ws + WS_W + (size_t)l * W_LAYER;
            SchedOut S{(const char*)(F.ws + WS_MERGED), (const char*)(wl + W_OUT), F.G, F.bx, need_ctx};
            EpiOut E{WSP(float, WS_XC), F.out, WSP(const float, WS_MOD) + (size_t)l * 9 * 6 * D, WSP(float, WS_PB)};
            gemm_stream<1024, 1024, EpiOut, SchedOut>(F.lds, S, E);
        }
        SEAM(pb + 5);
        STAMP(pb + 6);
        if (PM(7) && IN(pb + 6)) for (int rep_ = 0; rep_ < REPN(7); ++rep_) { if (rep_) xcd_barrier(bar); const Frame F = phase_frame(F0); phase_router(F, l, l * 2 + rep_); }
        SEAM(pb + 6);
        STAMP(pb + 7);
        if (PM(9) && IN(pb + 7)) for (int rep_ = 0; rep_ < REPN(9); ++rep_) { if (rep_) xcd_barrier(bar); const Frame F = phase_frame(F0); unsigned char* wl = F.ws + WS_W + (size_t)l * W_LAYER;
            moe_offsets(F, CREG(l));
            SchedMoe S{(const char*)(F.ws + WS_H), (const char*)(wl + W_GU), WSP(const int, WS_ROWL), (const volatile LAS int*)(F.lds + LDS_MISC + 128), F.G, F.bx, 0};
            EpiMoe1 E{WSP(bf16_t, WS_ACT)};
            gemm_stream<1024, 1024, EpiMoe1, SchedMoe, true>(F.lds, S, E);
        }
        SEAM(pb + 7);
        STAMP(pb + 8);
        if (PM(10) && IN(pb + 8)) for (int rep_ = 0; rep_ < REPN(10); ++rep_) { if (rep_) xcd_barrier(bar); const Frame F = phase_frame(F0); unsigned char* wl = F.ws + WS_W + (size_t)l * W_LAYER;
            moe_offsets(F, CREG(l));
            SchedMoe S{(const char*)(F.ws + WS_ACT), (const char*)(wl + W_DN), nullptr, (const volatile LAS int*)(F.lds + LDS_MISC + 128), F.G, F.bx, 1};
            EpiMoe2 E{WSP(bf16_t, WS_Y)};
            gemm_stream<512, 512, EpiMoe2, SchedMoe>(F.lds, S, E);
        }
        SEAM(pb + 8);
        STAMP(pb + 9);
        if (PM(11) && IN(pb + 9)) for (int rep_ = 0; rep_ < REPN(11); ++rep_) { if (rep_) xcd_barrier(bar); const Frame F = phase_frame(F0); phase_rows<1>(F, l, rep_ + 1 < REPN(11)); }
        SEAM(pb + 9);
    }
    STAMP(NPHASE);
#ifdef MK_TIME_A
    if (F.bx == MK_TIME_BLK && F.tid == 0) { const unsigned long long dly = (unsigned long long)(misc[17] - misc[16]) * 8ull, t0 = __builtin_amdgcn_s_memrealtime(); while (__builtin_amdgcn_s_memrealtime() - t0 < dly) __builtin_amdgcn_s_sleep(16); }
#endif
#undef IN
#undef SEAM
}
}

extern "C" void kernel_launch(void* const* d_in, const int* in_sizes, int n_in, void* d_out, int out_size, void* d_ws, size_t ws_size, hipStream_t stream) {
    using namespace mk;
    static int grid = 0;
    if (grid == 0) {
        if (n_in != 32 || out_size != NB * SEQ * D || ws_size < WS_END) { fprintf(stderr, "kernel_launch: unexpected shapes (n_in %d out %d ws %zu, need %zu)\n", n_in, out_size, ws_size, (size_t)WS_END); grid = -1; return; }
        int dev = 0, cus = 0, per_cu = 0;
        if (hipGetDevice(&dev) != hipSuccess || hipDeviceGetAttribute(&cus, hipDeviceAttributeMultiprocessorCount, dev) != hipSuccess) { grid = -1; return; }
        if (hipFuncSetAttribute((const void*)mk_fwd, hipFuncAttributeMaxDynamicSharedMemorySize, LDS_BYTES) != hipSuccess) { fprintf(stderr, "kernel_launch: hipFuncSetAttribute failed\n"); grid = -1; return; }
        if (hipOccupancyMaxActiveBlocksPerMultiprocessor(&per_cu, (const void*)mk_fwd, NTHR, LDS_BYTES) != hipSuccess || per_cu < 1) { fprintf(stderr, "kernel_launch: occupancy query says %d\n", per_cu); per_cu = 1; }
        (void)hipGetLastError();
        grid = cus;
    }
    if (grid < 0) return;
    if (hipMemsetAsync((char*)d_ws + WS_CTL, 0, CTL_BYTES, stream) != hipSuccess) return;
#ifdef MK_DBG_ZERO
    (void)hipMemsetAsync((char*)d_ws + CTL_BYTES, 0, WS_END - CTL_BYTES, stream);
    (void)hipMemsetAsync(d_out, 0, (size_t)NB * SEQ * D * 4, stream);
#endif
    Args a{};
    for (int i = 0; i < 32; ++i) a.in[i] = (const float*)d_in[i];
    a.out = (float*)d_out; a.ws = (unsigned char*)d_ws;
#if defined(MK_DBG_DET)
    {
        unsigned char* ws = (unsigned char*)d_ws;
        unsigned long long* chk = (unsigned long long*)(ws + WS_CTL + 512 * 1024);
        unsigned long long* chkA = (unsigned long long*)(ws + WS_ROUTE + RT_END + 1024);
        auto CHK = [&](int p, const void* base, long rows, long pitch_b, long off_b, long width_b, const int* rowidx) {
            hipLaunchKernelGGL(mk::mkdbg::k_chk, dim3(1024), dim3(256), 0, stream, (const unsigned*)base, rows, pitch_b / 4, off_b / 4, width_b / 4, rowidx, chk + p); };
        const int* tslot = (const int*)(ws + WS_ROUTE + RT_SLOT);
        for (int run = 0; run < 2; ++run) {
            if (run == 1) { hipMemcpyAsync(chkA, chk, 32 * 8, hipMemcpyDeviceToDevice, stream); hipMemsetAsync((char*)d_ws + WS_CTL, 0, CTL_BYTES, stream); }
            for (int p = 0; p < 12; ++p) {
                a.ph_lo = p; a.ph_hi = p + 1; hipLaunchKernelGGL(mk_fwd, dim3(grid), dim3(NTHR), LDS_BYTES, stream, a);
                switch (p) {
                    case 0: CHK(p, ws + WS_MOD, 1, 0, 0, 2 * 9 * 6 * D * 4 + 64 * 16 * 8 + 64 * 8 * 8, nullptr); CHK(p, ws + WS_WLRU, 1, 0, 0, 512 * 1024, nullptr); CHK(p, ws + WS_W, 1, 0, 0, 2 * W_LAYER, nullptr); break;
                    case 1: case 6: case 11: CHK(p, ws + WS_XC, 1, 0, 0, (long)NB * CTXL * D * 4, nullptr); CHK(p, d_out, 1, 0, 0, (long)NB * SEQ * D * 4, nullptr); if (p != 6) CHK(p, ws + WS_H, 1, 0, 0, SZ_R1K, nullptr); break;
                    case 2: CHK(p, ws + WS_QG, 1, 0, 0, SZ_R1K, nullptr); CHK(p, ws + WS_XM, MALL, 2048, 0, 1024, nullptr); CHK(p, ws + WS_KB, 1, 0, 0, (long)MALL * 128 * 2 * 2, nullptr);
                            CHK(p, ws + WS_CQKV, 1, 0, 0, (long)MALL * 640 * 2, nullptr); CHK(p, ws + WS_KR, 1, 0, 0, (long)MALL * 32 * 2, nullptr); CHK(p, ws + WS_SSP, 1, 0, 0, (long)MALL * 20 * 4, nullptr); break;
                    case 3: CHK(p, ws + WS_QM, 1, 0, 0, (long)MALL * 768 * 2, nullptr); CHK(p, ws + WS_KVM, 1, 0, 0, SZ_R1K, nullptr); CHK(p, ws + WS_TOT, 1, 0, 0, (long)NB * 2 * NCH * 1024 * 4, nullptr); break;
                    case 4: CHK(p, ws + WS_QG, 1, 0, 0, SZ_R1K, nullptr); CHK(p, ws + WS_XM, MALL, 2048, 1024, 1024, nullptr); break;
                    case 5: CHK(p, ws + WS_MERGED, 1, 0, 0, SZ_R1K, nullptr); break;
                    case 7: CHK(p, ws + WS_H, 1, 0, 0, SZ_R1K, nullptr); CHK(p, ws + WS_ROUTE + RT_TE, 1, 0, 0, (long)MALL * 2 * 4 * 2, nullptr); break;
                    case 8: CHK(p, ws + WS_H2S, (long)MALL * 2, 2048, 0, 2048, tslot); CHK(p, ws + WS_ROUTE + RT_SLOTW, (long)MALL * 2, 4, 0, 4, tslot); break;
                    case 9: CHK(p, ws + WS_ACT, (long)MALL * 2, 1024, 0, 1024, tslot); break;
                    case 10: CHK(p, ws + WS_Y, (long)MALL * 2, 2048, 0, 2048, tslot); break;
                }
            }
        }
        hipLaunchKernelGGL(mk::mkdbg::k_verdict, dim3(1024), dim3(256), 0, stream, (const unsigned long long*)chkA, (const unsigned long long*)chk, 12, (float*)d_out, (long)NB * SEQ * D);
    }
#elif MK_PER_PHASE
    for (int p = 0; p < NPHASE; ++p) { a.ph_lo = p; a.ph_hi = p + 1; hipLaunchKernelGGL(mk_fwd, dim3(grid), dim3(NTHR), LDS_BYTES, stream, a); }
#else
    a.ph_lo = 0; a.ph_hi = NPHASE;
    hipLaunchKernelGGL(mk_fwd, dim3(grid), dim3(NTHR), LDS_BYTES, stream, a);
#endif
    const hipError_t le = hipPeekAtLastError();
    if (le != hipSuccess) fprintf(stderr, "kernel_launch: launch failed: %s\n", hipGetErrorName(le));
}
```

```cpp
#include <hip/hip_runtime.h>
#include <cstdio>
#include <cstdint>

#ifndef MK_PER_PHASE
#define MK_PER_PHASE 0
#endif

#ifndef MK_REP
#define MK_REP 0
#endif
#define CREG(l) ((l) * 2 + ((MK_REP >> 7) & 1))
namespace mk {
#define LAS __attribute__((address_space(3)))
#define GAS __attribute__((address_space(1)))
typedef unsigned short bf16_t;
typedef short bf16x8 __attribute__((ext_vector_type(8)));
typedef short s16x4 __attribute__((ext_vector_type(4)));
typedef float f32x4 __attribute__((ext_vector_type(4)));
typedef float f32x2 __attribute__((ext_vector_type(2)));
typedef float f32x16 __attribute__((ext_vector_type(16)));
typedef unsigned u32x4 __attribute__((ext_vector_type(4)));
typedef unsigned u32x2 __attribute__((ext_vector_type(2)));

constexpr int D = 1024, NB = 8, SEQ = 2048, CTXL = 256, TT = CTXL + SEQ, MALL = NB * TT, NRT = MALL / 256;
constexpr int DEPTH = 2, INW = 5536;
constexpr int OFF_Q = 0, OFF_K = 512, OFF_V = 640, OFF_X = 768, OFF_Y = 1280, OFF_CQ = 1792, OFF_CKV = 2176, OFF_KR = 2432, OFF_G = 2464;
constexpr float EPS = 1e-6f, LOG2E = 1.4426950408889634f;
constexpr float C2Q = 0.125f * LOG2E;
constexpr float C2M = 0.10206207261596575f * LOG2E;
constexpr int NWAVES = 8, NTHR = 512;
constexpr int MAXSLOT = 40960, MAXTILE = 160;
constexpr int NCH = TT / 64;

constexpr size_t MiB = 1u << 20;
constexpr size_t WS_CTL = 0, CTL_BYTES = 1 * MiB;
constexpr int CW_BAR = 1024;
constexpr int CW_KMAX = 12288;
constexpr int CW_CNT = 8192;
constexpr size_t WS_MOD = 1 * MiB;
constexpr size_t WS_TAB64 = WS_MOD + 2 * 9 * 6 * D * 4;
constexpr size_t WS_TAB32 = WS_TAB64 + 64 * 16 * 8;
constexpr size_t WS_RWT = WS_TAB32 + 64 * 8 * 8;
constexpr size_t WS_ROUTE = WS_RWT + 16 * 1024 * 4;
constexpr size_t RT_TE = 0, RT_TW = RT_TE + MALL * 2 * 4, RT_RANK = RT_TW + MALL * 2 * 4, RT_SLOT = RT_RANK + MALL * 2 * 4, RT_SLOTW = RT_SLOT + MALL * 2 * 4,
                 RT_TILEE = RT_SLOTW + MAXSLOT * 4, RT_END = RT_TILEE + 256 * 4;
static_assert(WS_ROUTE + RT_END <= 3 * MiB, "route");
constexpr size_t WS_WLRU = 3 * MiB;
constexpr size_t WS_TOT = WS_WLRU + MiB / 2;
constexpr size_t WS_XC = 6 * MiB;
constexpr size_t WS_SSP = 14 * MiB;
constexpr size_t WS_W = 16 * MiB;
constexpr size_t W_IN = 0, W_GATE = W_IN + 2560 * 1024 * 2, W_QB = W_GATE + 3072 * 1024 * 2, W_KVB = W_QB + 768 * 640 * 2, W_BR = W_KVB + 1024 * 640 * 2,
                 W_OUT = W_BR + 3 * 1024 * 1024 * 2, W_GU = W_OUT + 1024 * 1024 * 2, W_DN = W_GU + (size_t)16 * 1024 * 1024 * 2, W_LAYER = W_DN + (size_t)16 * 1024 * 512 * 2;
static_assert(W_LAYER % 256 == 0, "w");
constexpr size_t WS_ACT0 = WS_W + 2 * W_LAYER;
constexpr size_t SZ_R1K = (size_t)MALL * 1024 * 2;
constexpr size_t WS_H = WS_ACT0;
constexpr size_t WS_QG = WS_H + SZ_R1K;
constexpr size_t WS_XM = WS_QG + SZ_R1K;
constexpr size_t WS_KB = WS_XM + SZ_R1K;
constexpr size_t WS_VB = WS_KB + (size_t)MALL * 128 * 2;
constexpr size_t WS_CQKV = WS_VB + (size_t)MALL * 128 * 2;
constexpr size_t WS_KR = WS_CQKV + (size_t)MALL * 640 * 2;
constexpr size_t WS_QM = WS_KR + (size_t)MALL * 32 * 2;
constexpr size_t WS_KVM = WS_QM + (size_t)MALL * 768 * 2;
constexpr size_t WS_END = WS_KVM + SZ_R1K;
constexpr size_t WS_MERGED = WS_KVM;
constexpr size_t WS_STASH = WS_CQKV;
static_assert(WS_STASH + (size_t)256 * 131072 <= WS_KVM, "stash");
constexpr size_t WS_PB = WS_QM + 16 * MiB;
static_assert(WS_PB >= WS_STASH + (size_t)256 * 131072 && WS_PB + (size_t)2 * 2048 * 1024 * 2 <= WS_KVM, "pb");
constexpr size_t WS_ROWL = WS_XM;
constexpr size_t WS_Y = WS_QG;
static_assert(WS_Y + (size_t)MAXSLOT * 1024 * 2 <= WS_CQKV, "y");
static_assert((size_t)16 * MALL * 4 <= SZ_R1K, "rowlist");
constexpr size_t WS_ACT = WS_CQKV;
static_assert(WS_ACT + (size_t)MAXSLOT * 512 * 2 <= WS_KVM, "act");
static_assert(WS_END <= (size_t)380 * MiB, "workspace must fit in sum(inputs) = 380.7 MiB");

constexpr int LDS_STAGE = 131072;
constexpr int LDS_MISC = 133120;
constexpr int LDS_BYTES = LDS_MISC + 512;

typedef __bf16 bf16x2v __attribute__((ext_vector_type(2)));
__device__ __forceinline__ unsigned cvt_pk_bf16(float lo, float hi) { const f32x2 v = {lo, hi}; const bf16x2v b = __builtin_convertvector(v, bf16x2v); return __builtin_bit_cast(unsigned, b); }
__device__ __forceinline__ float bf2f(unsigned short b) { return __uint_as_float(((unsigned)b) << 16); }
__device__ __forceinline__ float bflo(unsigned w) { return __uint_as_float(w << 16); }
__device__ __forceinline__ float bfhi(unsigned w) { return __uint_as_float(w & 0xffff0000u); }
__device__ __forceinline__ float fast_exp2(float x) { return __builtin_amdgcn_exp2f(x); }
__device__ __forceinline__ float fast_rcp(float x) { return __builtin_amdgcn_rcpf(x); }
__device__ __forceinline__ float sigmoid_f(float x) { return fast_rcp(1.f + fast_exp2(-LOG2E * x)); }
__device__ __forceinline__ float silu_f(float x) { return x * sigmoid_f(x); }
__device__ __forceinline__ float gelu_tanh_f(float x) {
    const float u = 0.7978845608028654f * (x + 0.044715f * x * x * x);
    return x * sigmoid_f(2.f * u);
}
template <int CTRL> __device__ __forceinline__ float dpp_mov(float v) { return __uint_as_float((unsigned)__builtin_amdgcn_update_dpp(0, (int)__float_as_uint(v), CTRL, 0xF, 0xF, true)); }
__device__ __forceinline__ float wave_sum(float v) {
    v += dpp_mov<0xB1>(v); v += dpp_mov<0x4E>(v); v += dpp_mov<0x141>(v); v += dpp_mov<0x140>(v);
    const unsigned u = __float_as_uint(v);
    return (__uint_as_float(__builtin_amdgcn_readlane(u, 0)) + __uint_as_float(__builtin_amdgcn_readlane(u, 16))) + (__uint_as_float(__builtin_amdgcn_readlane(u, 32)) + __uint_as_float(__builtin_amdgcn_readlane(u, 48)));
}
__device__ __forceinline__ u32x4 pack8(f32x4 a, f32x4 b) { u32x4 w; w.x = cvt_pk_bf16(a[0], a[1]); w.y = cvt_pk_bf16(a[2], a[3]); w.z = cvt_pk_bf16(b[0], b[1]); w.w = cvt_pk_bf16(b[2], b[3]); return w; }

#define SBAR() __builtin_amdgcn_sched_barrier(0)
template <class T> __device__ __forceinline__ T* opaque_p(T* p) { asm volatile("" : "+s"(p)); return p; }
__device__ __forceinline__ unsigned opaque_s(unsigned x) { asm volatile("" : "+s"(x)); return x; }
__device__ __forceinline__ int opaque(int x) { asm volatile("" : "+v"(x)); return x; }
__device__ __forceinline__ u32x4 ld16_sc1(const void* p) {
    const unsigned long long* q = (const unsigned long long*)p;
    const unsigned long long a = __hip_atomic_load(q, __ATOMIC_RELAXED, __HIP_MEMORY_SCOPE_AGENT), b = __hip_atomic_load(q + 1, __ATOMIC_RELAXED, __HIP_MEMORY_SCOPE_AGENT);
    return (u32x4){(unsigned)a, (unsigned)(a >> 32), (unsigned)b, (unsigned)(b >> 32)};
}
#define XB_TMO      128
#define XB_XCNT(j)  (256  + 64 * (j))
#define XB_XSUB(j)  (1280 + 64 * (j))
#define XB_XGEN(j)  (2304 + 64 * (j))
#define XB_TOP      3328
#define XB_TOPGEN   3392
#define XCD_BAR_WORDS 3456
#define XB_SPIN_CAP (1u << 18)
__device__ __forceinline__ unsigned xb_ld(unsigned* p)              { return __hip_atomic_load(p, __ATOMIC_RELAXED, __HIP_MEMORY_SCOPE_AGENT); }
__device__ __forceinline__ unsigned xb_add(unsigned* p, unsigned v) { return __hip_atomic_fetch_add(p, v, __ATOMIC_RELAXED, __HIP_MEMORY_SCOPE_AGENT); }
__device__ __forceinline__ unsigned xb_xcc_id() { return (unsigned)__builtin_amdgcn_s_getreg((3 << 11) | 20) & 0xFu; }
#define XB_SPIN(cond, bar) do { unsigned _sp = 0; while (cond) { __builtin_amdgcn_s_sleep(1); \
    if ((++_sp & 255u) == 0u) { if (xb_ld(&(bar)[XB_TMO])) break; if (_sp > XB_SPIN_CAP) { atomicAdd(&(bar)[XB_TMO], 1u); break; } } } } while (0)
struct XcdBarrier { unsigned* bar; unsigned x; volatile LAS unsigned* st; };
__device__ __forceinline__ XcdBarrier xcd_barrier_post(unsigned* bar, volatile LAS unsigned* st) {
    XcdBarrier b; b.bar = bar; b.x = xb_xcc_id(); b.st = st;
    if (threadIdx.x == 0) (void)xb_add(&bar[XB_XCNT(b.x)], 1u);
    return b;
}
__device__ __forceinline__ void xcd_barrier_complete(unsigned* bar, unsigned x, unsigned& nloc, unsigned& nx) {
    const unsigned G = gridDim.x * gridDim.y * gridDim.z;
    unsigned sum, cnt, mine, sp = 0u;
    for (;;) {
        sum = 0u; cnt = 0u; mine = 0u;
#pragma unroll
        for (unsigned j = 0; j < 16; ++j) { const unsigned c = xb_ld(&bar[XB_XCNT(j)]); sum += c; cnt += (c > 0u) ? 1u : 0u; mine = (j == x) ? c : mine; }
        if (sum == G) break;
        __builtin_amdgcn_s_sleep(1);
        if ((++sp & 255u) == 0u) { if (xb_ld(&bar[XB_TMO])) break; if (sp > XB_SPIN_CAP) { atomicAdd(&bar[XB_TMO], 1u); break; } }
    }
    nloc = mine > 0u ? mine : 1u; nx = cnt > 0u ? cnt : 1u;
}
__device__ __forceinline__ void xcd_barrier(const XcdBarrier& b) {
    asm volatile("s_waitcnt vmcnt(0)" ::: "memory");
    __syncthreads();
    if (threadIdx.x == 0) {
        unsigned* bar = opaque_p(b.bar);
        __builtin_amdgcn_s_waitcnt(0);
        const unsigned bx_ = opaque_s(b.x);
        unsigned nloc = b.st[0], nx = b.st[1];
        if (nloc == 0u) { xcd_barrier_complete(bar, bx_, nloc, nx); b.st[0] = nloc; b.st[1] = nx; }
        const unsigned old = xb_add(&bar[XB_XSUB(bx_)], 1u);
        const unsigned gen = old / nloc;
        if (old + 1u == (gen + 1u) * nloc) {
            __builtin_amdgcn_fence(__ATOMIC_RELEASE, "agent");
            asm volatile("s_waitcnt vmcnt(0)" ::: "memory");
            const unsigned og = xb_add(&bar[XB_TOP], 1u);
            const unsigned tg = og / nx;
            if (og + 1u == (tg + 1u) * nx) xb_add(&bar[XB_TOPGEN], 1u);
            else XB_SPIN(xb_ld(&bar[XB_TOPGEN]) == tg, bar);
            __builtin_amdgcn_fence(__ATOMIC_ACQUIRE, "agent");
            xb_add(&bar[XB_XGEN(bx_)], 1u);
            asm volatile("s_waitcnt vmcnt(0)" ::: "memory");
        } else {
            XB_SPIN(xb_ld(&bar[XB_XGEN(bx_)]) == gen, bar);
            __builtin_amdgcn_fence(__ATOMIC_ACQUIRE, "agent");
            asm volatile("s_waitcnt vmcnt(0)" ::: "memory");
        }
    }
    __syncthreads();
}

constexpr int BM = 256, BK = 64, HALF = 128, HTB = HALF * BK * 2, STAGE_BYTES = 8 * HTB, NXCD = 8, WGM = 8;
__host__ __device__ __forceinline__ int lds_byte(int r, int c) { const int st = (r >> 4) * 2 + (c >> 5), rr = r & 15, cc = c & 31, ob = rr * 64 + cc * 2; return st * 1024 + (ob ^ (((ob >> 9) & 1) << 5)); }
__host__ __device__ __forceinline__ void stage_rc(int b, int& R, int& C) { const int st = b / 1024, sb = b % 1024, swz = sb ^ (((sb >> 9) & 1) << 5); R = (st >> 1) * 16 + swz / 64; C = (st & 1) * 32 + (swz % 64) / 2; }
__host__ __device__ __forceinline__ int perm32(int rho) { const int n = rho >> 4, i = rho & 15; return 8 * (i >> 2) + 4 * n + (i & 3); }

struct Unit { const char* A; const char* B; int nt; int pm, pn, kind; const int* rows; int nvalid; };

__device__ __forceinline__ void rect_order(int L, int nM, int nN, int& im, int& in_) {
    const int nwg = nM * nN;
    int wgid = L; { const int q = nwg / NXCD, r = nwg % NXCD, xcd = wgid % NXCD, off = wgid / NXCD; wgid = (xcd < r ? xcd * (q + 1) : r * (q + 1) + (xcd - r) * q) + off; }
    const int nig = WGM * nN, gid = wgid / nig, fm = gid * WGM, gsz = (nM - fm) < WGM ? (nM - fm) : WGM;
    im = fm + ((wgid % nig) % gsz); in_ = (wgid % nig) / gsz;
}

template <int PA, int PB, class Epi, class Sched, bool GATHER = false>
__device__ __forceinline__ void gemm_stream(LAS unsigned char* lds, const Sched& S, const Epi& E) {
    const int tid = opaque(threadIdx.x), wid = __builtin_amdgcn_readfirstlane(tid >> 6), lane = tid & 63, wr = wid >> 2, wc = wid & 3, fr = lane & 15, fq = lane >> 4;
    unsigned voffA[2], voffB[2];
#pragma unroll
    for (int i = 0; i < 2; ++i) { int R, C; stage_rc(tid * 16 + i * 8192, R, C); const int Rb = Epi::PERM ? ((R & ~31) + perm32(R & 31)) : R;
        voffA[i] = (unsigned)(R * PA + C) * 2u; voffB[i] = (unsigned)(Rb * PB + C) * 2u; }
    constexpr size_t kstep = (size_t)(BK * 2);
    constexpr size_t hstepA = (size_t)HALF * PA * 2, hstepB = (size_t)HALF * PB * 2;
    const unsigned ldsw = (unsigned)wid * 1024u;
    const int aoff = lds_byte(wr * 64 + fr, fq * 8), boff = lds_byte(wc * 32 + fr, fq * 8);
#define G_SA(b, h) (((b) * 2 + (h)) * HTB)
#define G_SB(b, h) ((4 + (b) * 2 + (h)) * HTB)
#define G_STAGE(bufoff, gbase, voff) do { _Pragma("unroll") for (int _i = 0; _i < 2; ++_i) \
        __builtin_amdgcn_global_load_lds((const unsigned*)((const char*)(gbase) + (voff)[_i]), (LAS unsigned*)(lds + (bufoff) + ldsw + _i * 8192), 16, 0, 0); } while (0)
    unsigned gc[2][2], gn[2][2];
#define G_GOFF(U, G) do { int R_, C_; stage_rc(tid * 16, R_, C_); _Pragma("unroll") for (int h_ = 0; h_ < 2; ++h_) _Pragma("unroll") for (int i_ = 0; i_ < 2; ++i_) { \
        const int ix_ = h_ * 128 + R_ + 64 * i_; const int tk_ = ix_ < (U).nvalid ? ((U).rows[ix_] >> 1) : 0; (G)[h_][i_] = (unsigned)tk_ * (unsigned)(PA * 2) + (unsigned)(C_ * 2); } } while (0)
#define G_STAGEG(bufoff, gbase, g0, g1) do { \
        __builtin_amdgcn_global_load_lds((const unsigned*)((const char*)(gbase) + (g0)), (LAS unsigned*)(lds + (bufoff) + ldsw), 16, 0, 0); \
        __builtin_amdgcn_global_load_lds((const unsigned*)((const char*)(gbase) + (g1)), (LAS unsigned*)(lds + (bufoff) + ldsw + 8192), 16, 0, 0); } while (0)
#define G_STAGEA(bufoff, gbase, h, nx) do { if constexpr (GATHER) { const unsigned o0_ = (nx) ? gn[h][0] : gc[h][0], o1_ = (nx) ? gn[h][1] : gc[h][1]; G_STAGEG(bufoff, gbase, o0_, o1_); } \
        else G_STAGE(bufoff, (gbase) + (h) * hstepA, voffA); } while (0)
#define G_LDA(dst, b, h) do { _Pragma("unroll") for (int m = 0; m < 4; ++m) _Pragma("unroll") for (int k = 0; k < 2; ++k) dst[m][k] = *(const LAS bf16x8*)(lds + G_SA(b, h) + aoff + m * 2048 + k * 1024); } while (0)
#define G_LDB(dst, b, h) do { _Pragma("unroll") for (int n = 0; n < 2; ++n) _Pragma("unroll") for (int k = 0; k < 2; ++k) dst[n][k] = *(const LAS bf16x8*)(lds + G_SB(b, h) + boff + n * 2048 + k * 1024); } while (0)
#define G_MMA(ai, bj, At, Bt) do { __builtin_amdgcn_s_setprio(1); _Pragma("unroll") for (int m = 0; m < 4; ++m) _Pragma("unroll") for (int n = 0; n < 2; ++n) _Pragma("unroll") for (int k = 0; k < 2; ++k) \
        acc[ai][bj][m][n] = __builtin_amdgcn_mfma_f32_16x16x32_bf16(Bt[n][k], At[m][k], acc[ai][bj][m][n], 0, 0, 0); __builtin_amdgcn_s_setprio(0); } while (0)
#define G_WAIT_V(n) asm volatile("s_waitcnt vmcnt(" #n ")" ::: "memory")
#define G_WAIT_L(n) asm volatile("s_waitcnt lgkmcnt(" #n ")" ::: "memory")
#define G_BAR __builtin_amdgcn_s_barrier()
#define G_SCHED __builtin_amdgcn_sched_barrier(0)
    Unit cur, nxt; int ui = 0;
    if (!S.next(0, cur)) return;
    f32x4 acc[2][2][4][2];
#pragma unroll
    for (int a = 0; a < 2; ++a)
#pragma unroll
        for (int b = 0; b < 2; ++b)
#pragma unroll
            for (int m = 0; m < 4; ++m)
#pragma unroll
                for (int n = 0; n < 2; ++n) acc[a][b][m][n] = (f32x4){0.f, 0.f, 0.f, 0.f};
    bf16x8 At[4][2], B0[2][2], B1[2][2];
    const char* cA = cur.A; const char* cB = cur.B;
    if constexpr (GATHER) { G_GOFF(cur, gc); _Pragma("unroll") for (int h_ = 0; h_ < 2; ++h_) _Pragma("unroll") for (int i_ = 0; i_ < 2; ++i_) gn[h_][i_] = gc[h_][i_]; }
    G_STAGE(G_SB(0, 0), cB, voffB); G_STAGE(G_SB(0, 1), cB + hstepB, voffB); G_STAGEA(G_SA(0, 0), cA, 0, false); G_STAGEA(G_SA(0, 1), cA, 1, false);
    if (wr == 1) G_BAR;
    G_WAIT_V(2); G_BAR;
    G_STAGE(G_SB(1, 0), cB + kstep, voffB); G_STAGEA(G_SA(1, 0), cA + kstep, 0, false); G_STAGE(G_SB(1, 1), cB + hstepB + kstep, voffB);
    G_WAIT_V(6); G_BAR;
    for (;;) {
        const bool has_next = S.next(ui + 1, nxt);
        const char* nA = has_next ? nxt.A : cA; const char* nB = has_next ? nxt.B : cB;
        if constexpr (GATHER) { if (has_next) G_GOFF(nxt, gn); }
        const int nt = cur.nt;
        for (int t = 0; t < nt; t += 2) {
            const bool last = (t == nt - 2);
            const char* a1 = cA + (size_t)(t + 1) * kstep;
            const char* a2 = last ? nA : cA + (size_t)(t + 2) * kstep; const char* b2 = last ? nB : cB + (size_t)(t + 2) * kstep;
            const char* a3 = a2 + kstep; const char* b3 = b2 + kstep;
            G_LDB(B0, 0, 0); G_LDB(B1, 0, 1); G_SCHED; G_LDA(At, 0, 0); G_STAGEA(G_SA(1, 1), a1, 1, false);
            G_WAIT_V(8); G_WAIT_L(0); G_BAR; G_MMA(0, 0, At, B0); G_MMA(0, 1, At, B1); G_BAR; G_SCHED;
            G_LDA(At, 0, 1); G_STAGE(G_SB(0, 0), b2, voffB); G_STAGE(G_SB(0, 1), b2 + hstepB, voffB); G_STAGEA(G_SA(0, 0), a2, 0, last);
            G_WAIT_V(8); G_WAIT_L(0); G_BAR; G_MMA(1, 0, At, B0); G_MMA(1, 1, At, B1); G_BAR; G_SCHED;
            G_LDB(B0, 1, 0); G_LDB(B1, 1, 1); G_SCHED; G_LDA(At, 1, 0); G_STAGEA(G_SA(0, 1), a2, 1, last);
            G_WAIT_V(8); G_WAIT_L(0); G_BAR; G_MMA(0, 0, At, B0); G_MMA(0, 1, At, B1); G_BAR; G_SCHED;
            G_LDA(At, 1, 1); G_STAGE(G_SB(1, 0), b3, voffB); G_STAGE(G_SB(1, 1), b3 + hstepB, voffB); G_STAGEA(G_SA(1, 0), a3, 0, last);
            G_WAIT_V(8); G_WAIT_L(0); G_BAR; G_MMA(1, 0, At, B0); G_MMA(1, 1, At, B1); G_BAR; G_SCHED;
        }
        if (wr == 0) G_BAR;
        E(acc, cur, wr, wc, fr, fq);
        if (!has_next) break;
#pragma unroll
        for (int a = 0; a < 2; ++a)
#pragma unroll
            for (int b = 0; b < 2; ++b)
#pragma unroll
                for (int m = 0; m < 4; ++m)
#pragma unroll
                    for (int n = 0; n < 2; ++n) acc[a][b][m][n] = (f32x4){0.f, 0.f, 0.f, 0.f};
        cur = nxt; cA = nA; cB = nB; ++ui;
        if constexpr (GATHER) { _Pragma("unroll") for (int h_ = 0; h_ < 2; ++h_) _Pragma("unroll") for (int i_ = 0; i_ < 2; ++i_) gc[h_][i_] = gn[h_][i_]; }
        if (wr == 1) G_BAR;
    }
    G_WAIT_V(0);
    G_BAR;
#undef G_SA
#undef G_SB
#undef G_STAGE
#undef G_LDA
#undef G_GOFF
#undef G_STAGEG
#undef G_STAGEA
#undef G_LDB
#undef G_MMA
#undef G_WAIT_V
#undef G_WAIT_L
#undef G_BAR
#undef G_SCHED
}

struct Args { const float* in[32]; float* out; unsigned char* ws; int ph_lo, ph_hi; };
enum { I_X = 0, I_C, I_CTX, I_CCTX, I_WMOD, I_BMOD, I_NMIX, I_NFFN, I_WIN, I_GQN, I_GKN, I_CONVW, I_CONVB, I_LWA, I_LBA, I_LWI, I_LBI, I_LLAM,
       I_MQN, I_WQB, I_MKVN, I_WKVB, I_WBA, I_WBL, I_WBM, I_WOUT, I_RW, I_RB, I_MG, I_MU, I_MD, I_FN };
struct Frame {
    LAS unsigned char* lds; unsigned char* ws; const float* const* in; float* out;
    int tid, lane, wave, G, bx;
};
__device__ __forceinline__ Frame phase_frame(const Frame& F) { Frame P = F; P.bx = (int)opaque_s((unsigned)F.bx); return P; }
#define WSP(T, off) ((T*)(F.ws + (off)))
#define CTLW(idx) (((unsigned*)(F.ws + WS_CTL)) + (idx))
__device__ __forceinline__ float* xrow_ptr(const Frame& F, int r) {
    const int b = r / TT, t = r - b * TT;
    return t < CTXL ? WSP(float, WS_XC) + ((size_t)b * CTXL + t) * D : F.out + ((size_t)b * SEQ + (t - CTXL)) * D;
}
__device__ __forceinline__ const float* mod_ptr(const Frame& F, int l, int r, int which) {
    const int b = r / TT, t = r - b * TT; const int mr = t < CTXL ? 8 : b;
    return WSP(const float, WS_MOD) + ((size_t)(l * 9 + mr) * 6 + which) * D;
}

__device__ __forceinline__ int src_col_in(int p) {
    const int tile = p >> 8, q = p & 255, bj = q >> 7, wc = (q >> 5) & 3, s = q & 31, fq = s >> 3, n = (s >> 2) & 1, j = s & 3;
    const int hd = 32 * bj + 16 * n + 4 * fq + j;
    switch (tile) {
        case 0: case 1: return OFF_Q + (4 * tile + wc) * 64 + hd;
        case 2: return wc < 2 ? OFF_K + wc * 64 + hd : OFF_V + (wc - 2) * 64 + 32 * bj + s;
        case 3: case 4: return OFF_X + (tile - 3) * 256 + q;
        case 5: case 6: return OFF_Y + (tile - 5) * 256 + q;
        case 7: return OFF_CQ + q;
        case 8: return q < 128 ? OFF_CQ + 256 + q : OFF_CKV + (q - 128);
        default: if (q < 128) return OFF_CKV + 128 + q;
                 if (q < 160) return OFF_KR + 16 * n + 8 * (j >> 1) + 2 * fq + (j & 1);
                 return -1;
    }
}
__device__ __forceinline__ int rope32_dim(int s) { const int fq = s >> 3, n = (s >> 2) & 1, j = s & 3; return 16 * n + 8 * (j >> 1) + 2 * fq + (j & 1); }

struct WMat { int rows, K, pitch, nkb, items; };
struct WItem { const float* src; const float* ksc; bf16_t* dst; int ld, pitch, p0, k0, col; };
__device__ __forceinline__ WItem p0_item(const Frame& F, int it, int pl) {
    constexpr int NI_IN = 40 * 8, NI_GATE = 48 * 8, NI_QB = 12 * 3, NI_KVB = 16 * 2, NI_BR = 3 * 16 * 4, NI_OUT = 16 * 8, NI_GU = 256 * 8, NI_DN = 256 * 4;
    constexpr int NI_L = NI_IN + NI_GATE + NI_QB + NI_KVB + NI_BR + NI_OUT + NI_GU + NI_DN;
    WItem I;
    const int l = it / NI_L; int r = it - l * NI_L;
    const float* src; int ld, pitch, nkb, nrb; bf16_t* dst; int kind; const float* ksc = nullptr;
    unsigned char* wl = F.ws + WS_W + (size_t)l * W_LAYER;
    if (r < NI_IN) { kind = 0; src = F.in[I_WIN] + (size_t)l * D * INW; ld = INW; pitch = 1024; nkb = 8; nrb = 40; dst = (bf16_t*)(wl + W_IN); }
    else if ((r -= NI_IN) < NI_GATE) { kind = 1; src = F.in[I_WIN] + (size_t)l * D * INW; ld = INW; pitch = 1024; nkb = 8; nrb = 48; dst = (bf16_t*)(wl + W_GATE); }
    else if ((r -= NI_GATE) < NI_QB) { kind = 2; src = F.in[I_WQB] + (size_t)l * 384 * 768; ld = 768; pitch = 640; nkb = 3; nrb = 12; dst = (bf16_t*)(wl + W_QB); ksc = F.in[I_MQN] + l * 384; }
    else if ((r -= NI_QB) < NI_KVB) { kind = 3; src = F.in[I_WKVB] + (size_t)l * 256 * 1024; ld = 1024; pitch = 640; nkb = 2; nrb = 16; dst = (bf16_t*)(wl + W_KVB); ksc = F.in[I_MKVN] + l * 256; }
    else if ((r -= NI_KVB) < NI_BR) { kind = 4; const int b = r / 64; r -= b * 64; src = F.in[I_WBA + b] + (size_t)l * 512 * D; ld = D; pitch = 1024; nkb = 4; nrb = 16; dst = (bf16_t*)(wl + W_BR) + (size_t)b * 1024 * 1024; }
    else if ((r -= NI_BR) < NI_OUT) { kind = 5; src = F.in[I_WOUT] + (size_t)l * D * D; ld = D; pitch = 1024; nkb = 8; nrb = 16; dst = (bf16_t*)(wl + W_OUT); }
    else if ((r -= NI_OUT) < NI_GU) { kind = 6; src = nullptr; ld = 512; pitch = 1024; nkb = 8; nrb = 256; dst = (bf16_t*)(wl + W_GU); }
    else { r -= NI_GU; kind = 7; src = nullptr; ld = D; pitch = 512; nkb = 4; nrb = 256; dst = (bf16_t*)(wl + W_DN); }
    (void)nkb;
    const int kb = r / nrb, rb = r - kb * nrb, p0 = rb * 64, k0 = kb * 128, p = p0 + pl;
    int col;
    switch (kind) {
        case 0: col = src_col_in(p); break;
        case 1: col = OFF_G + p; break;
        case 2: col = p < 512 ? (p >> 6) * 96 + (p & 63) : (4 * (((p - 512) >> 7)) + (((p - 512) >> 5) & 3)) * 96 + 64 + rope32_dim((p - 512) & 31); break;
        case 3: col = p < 512 ? (p >> 6) * 128 + (p & 63) : ((p - 512) >> 6) * 128 + 64 + ((p - 512) & 63); break;
        case 6: { const int e = p >> 10, pp = p & 1023, t4 = pp >> 8, q = pp & 255;
                  src = F.in[q < 128 ? I_MG : I_MU] + ((size_t)l * 16 + e) * D * 512; col = t4 * 128 + (q & 127); } break;
        case 7: { const int e = p >> 10; src = F.in[I_MD] + ((size_t)l * 16 + e) * 512 * D; col = p & 1023; } break;
        default: col = p; break;
    }
    I.src = src; I.ksc = ksc; I.dst = dst; I.ld = ld; I.pitch = pitch; I.p0 = p0; I.k0 = k0; I.col = col;
    return I;
}
__device__ __forceinline__ void p0_weights(const Frame& F) {
    constexpr int NI_IN = 40 * 8, NI_GATE = 48 * 8, NI_QB = 12 * 3, NI_KVB = 16 * 2, NI_BR = 3 * 16 * 4, NI_OUT = 16 * 8, NI_GU = 256 * 8, NI_DN = 256 * 4;
    constexpr int NI_L = NI_IN + NI_GATE + NI_QB + NI_KVB + NI_BR + NI_OUT + NI_GU + NI_DN, NI_S = NI_QB + NI_KVB, NI_M = NI_L - NI_S;
    const int tid_ = opaque(F.tid); const int pl = tid_ & 63, kg = tid_ >> 6;
    {
        int it = F.bx, buf = 0; bool have = false, first = true;
        WItem cur = p0_item(F, 0, pl);
        float v[16];
#pragma unroll
        for (int i = 0; i < 16; ++i) v[i] = 0.f;
#pragma unroll 1
        for (;;) {
            const bool more = it < 2 * NI_M;
            if (!have && !more) break;
            LAS unsigned char* tile = F.lds + buf * (64 * 272);
            if (have) {
                u32x4 w0, w1;
#define P0_CONSUME(N) asm volatile("s_waitcnt vmcnt(" #N ")\n\tv_cvt_pk_bf16_f32 %0, %8, %9\n\tv_cvt_pk_bf16_f32 %1, %10, %11\n\tv_cvt_pk_bf16_f32 %2, %12, %13\n\tv_cvt_pk_bf16_f32 %3, %14, %15\n\t" \
                    "v_cvt_pk_bf16_f32 %4, %16, %17\n\tv_cvt_pk_bf16_f32 %5, %18, %19\n\tv_cvt_pk_bf16_f32 %6, %20, %21\n\tv_cvt_pk_bf16_f32 %7, %22, %23" \
                    : "=&v"(w0.x), "=&v"(w0.y), "=&v"(w0.z), "=&v"(w0.w), "=&v"(w1.x), "=&v"(w1.y), "=&v"(w1.z), "=&v"(w1.w) \
                    : "v"(v[0]), "v"(v[1]), "v"(v[2]), "v"(v[3]), "v"(v[4]), "v"(v[5]), "v"(v[6]), "v"(v[7]), "v"(v[8]), "v"(v[9]), "v"(v[10]), "v"(v[11]), "v"(v[12]), "v"(v[13]), "v"(v[14]), "v"(v[15]) : "memory")
                if (first) P0_CONSUME(0); else P0_CONSUME(2);
#undef P0_CONSUME
                first = false;
                if (cur.col < 0) { w0 = (u32x4){0u, 0u, 0u, 0u}; w1 = (u32x4){0u, 0u, 0u, 0u}; }
                *(LAS u32x4*)(tile + pl * 272 + kg * 32) = w0; *(LAS u32x4*)(tile + pl * 272 + kg * 32 + 16) = w1;
            }
            WItem nxt = cur;
            if (more) {
                const int l_ = it / NI_M, rr_ = it - l_ * NI_M;
                nxt = p0_item(F, l_ * NI_L + (rr_ < NI_IN + NI_GATE ? rr_ : rr_ + NI_S), pl);
                const float* sp_ = nxt.src + (size_t)(nxt.k0 + kg * 16) * nxt.ld + (nxt.col >= 0 ? nxt.col : 0);
#pragma unroll
                for (int i = 0; i < 16; ++i) { const float* q_ = sp_ + (size_t)i * nxt.ld; asm volatile("global_load_dword %0, %1, off" : "=v"(v[i]) : "v"(q_) : "memory"); }
            }
            __syncthreads();
            if (have) {
#pragma unroll
                for (int i = 0; i < 2; ++i) { const int id = tid_ + i * 512, row = id >> 4, ch = id & 15;
                    *(u32x4*)(cur.dst + (size_t)(cur.p0 + row) * cur.pitch + cur.k0 + ch * 8) = *(LAS u32x4*)(tile + row * 272 + ch * 16); }
                buf ^= 1;
            }
            have = more; cur = nxt; it += F.G;
        }
        asm volatile("s_waitcnt vmcnt(0)" ::: "memory");
    }
    __syncthreads();
    for (int i2 = F.bx; i2 < 2 * NI_S; i2 += F.G) {
        const int l_ = i2 / NI_S; const WItem I = p0_item(F, l_ * NI_L + NI_IN + NI_GATE + (i2 - l_ * NI_S), pl);
        LAS unsigned char* tile = F.lds;
        float v[16];
#pragma unroll
        for (int i = 0; i < 16; ++i) { const int k = I.k0 + kg * 16 + i; v[i] = I.src[(size_t)k * I.ld + I.col] * I.ksc[k]; }
        u32x4 w0, w1;
        w0.x = cvt_pk_bf16(v[0], v[1]); w0.y = cvt_pk_bf16(v[2], v[3]); w0.z = cvt_pk_bf16(v[4], v[5]); w0.w = cvt_pk_bf16(v[6], v[7]);
        w1.x = cvt_pk_bf16(v[8], v[9]); w1.y = cvt_pk_bf16(v[10], v[11]); w1.z = cvt_pk_bf16(v[12], v[13]); w1.w = cvt_pk_bf16(v[14], v[15]);
        *(LAS u32x4*)(tile + pl * 272 + kg * 32) = w0; *(LAS u32x4*)(tile + pl * 272 + kg * 32 + 16) = w1;
        __syncthreads();
#pragma unroll
        for (int i = 0; i < 2; ++i) { const int id = tid_ + i * 512, row = id >> 4, ch = id & 15;
            *(u32x4*)(I.dst + (size_t)(I.p0 + row) * I.pitch + I.k0 + ch * 8) = *(LAS u32x4*)(tile + row * 272 + ch * 16); }
        __syncthreads();
    }
}
__device__ __forceinline__ void p0_misc(const Frame& F) {
    const int gt = F.bx * NTHR + opaque(F.tid), GT = F.G * NTHR;
    bf16_t* wl = WSP(bf16_t, WS_WLRU);
    for (int i = gt; i < 2 * 2 * 2 * 8 * 64 * 64; i += GT) {
        const int k = i & 63, j = (i >> 6) & 63, n = (i >> 12) & 7, g = (i >> 15) & 1, d = (i >> 16) & 1, l = i >> 17;
        const float x = F.in[g ? I_LWI : I_LWA][((((size_t)(l * 2 + d) * 8 + n) * 64 + k) * 64) + j];
        wl[i] = (bf16_t)(cvt_pk_bf16(x, 0.f) & 0xffffu);
    }
    { float* rwt = WSP(float, WS_RWT); for (int i = gt; i < 16 * 1024; i += GT) { const int e = i >> 10, k = i & 1023; rwt[i] = F.in[I_RW][k * 16 + e]; } }
    f32x2* t64 = WSP(f32x2, WS_TAB64); f32x2* t32 = WSP(f32x2, WS_TAB32);
    for (int i = gt; i < 64 * 16 + 64 * 8; i += GT) {
        if (i < 1024) { const int p = i >> 4, q = i & 15; const float a = (float)p * exp2f(-13.287712379549449f * (float)q / 16.f); t64[i] = (f32x2){cosf(a), sinf(a)}; }
        else { const int ii = i - 1024, p = ii >> 3, q = ii & 7; const float a = (float)p * exp2f(-13.287712379549449f * (float)q / 8.f); t32[ii] = (f32x2){cosf(a), sinf(a)}; }
    }
}
__device__ __forceinline__ void p0_mod(const Frame& F) {
    LAS float* sv = (LAS float*)F.lds;
    LAS float* red = (LAS float*)(F.lds + 9 * 1024 * 4);
    if (F.bx >= 192) return;
    const int tid = opaque(F.tid);
    for (int i = tid; i < 9 * 1024; i += NTHR) { const int r = i >> 10, k = i & 1023; const float x = r < 8 ? F.in[I_C][r * D + k] : F.in[I_CCTX][k]; sv[i] = silu_f(x); }
    __syncthreads();
    for (int it = F.bx; it < 192; it += F.G) {
        const int l = it / 96, n0 = (it % 96) * 64, col = tid & 63, kg = tid >> 6;
        const float* w = F.in[I_WMOD] + (size_t)l * D * 6 * D + n0 + col;
        float acc[9];
#pragma unroll
        for (int r = 0; r < 9; ++r) acc[r] = 0.f;
#pragma unroll 4
        for (int k = kg * 128; k < kg * 128 + 128; ++k) { const float wv = w[(size_t)k * 6 * D];
#pragma unroll
            for (int r = 0; r < 9; ++r) acc[r] += sv[r * 1024 + k] * wv; }
#pragma unroll
        for (int r = 0; r < 9; ++r) red[(kg * 9 + r) * 64 + col] = acc[r];
        __syncthreads();
        for (int o = tid; o < 9 * 64; o += NTHR) { const int r = o >> 6, c = o & 63; float s = F.in[I_BMOD][l * 6 * D + n0 + c];
#pragma unroll
            for (int g = 0; g < 8; ++g) s += red[(g * 9 + r) * 64 + c];
            WSP(float, WS_MOD)[((size_t)(l * 9 + r)) * 6 * D + n0 + c] = s; }
        __syncthreads();
    }
}

__device__ __forceinline__ void moe_offsets(const Frame& F, int creg) {
    volatile LAS int* off = (volatile LAS int*)(F.lds + LDS_MISC + 128);
    if (F.tid == 0) { int s = 0; for (int e = 0; e < 16; ++e) { off[e] = s; const int c = (int)*CTLW(CW_CNT + creg * 64 + e); off[17 + e] = c; s += (c + 255) & ~255; } off[16] = s; }
    __syncthreads();
}
struct RowV { f32x4 v[4]; };
__device__ __forceinline__ RowV row_load(const float* p, int lane) { RowV r; const f32x4* q = (const f32x4*)p + lane;
#pragma unroll
    for (int j = 0; j < 4; ++j) r.v[j] = q[64 * j]; return r; }
__device__ __forceinline__ void row_store(float* p, int lane, const RowV& r) { f32x4* q = (f32x4*)p + lane;
#pragma unroll
    for (int j = 0; j < 4; ++j) q[64 * j] = r.v[j]; }
__device__ __forceinline__ float row_rstd(const RowV& r) { float s = 0.f;
#pragma unroll
    for (int j = 0; j < 4; ++j) s += (r.v[j][0] * r.v[j][0] + r.v[j][1] * r.v[j][1]) + (r.v[j][2] * r.v[j][2] + r.v[j][3] * r.v[j][3]);
    return rsqrtf(wave_sum(s) * (1.f / D) + EPS); }
__device__ __forceinline__ RowV row_normmod(const RowV& x, float rstd, const float* g, const float* shift, const float* scale, int lane) {
    RowV y;
#pragma unroll
    for (int j = 0; j < 4; ++j) { const f32x4 gv = ((const f32x4*)g)[lane + 64 * j]; f32x4 t = x.v[j] * rstd * gv;
        if (scale) { const f32x4 sc = ((const f32x4*)scale)[lane + 64 * j], sh = ((const f32x4*)shift)[lane + 64 * j]; t = t * (sc + 1.f) + sh; }
        y.v[j] = t; }
    return y;
}
__device__ __forceinline__ void row_store_bf16(bf16_t* p, int lane, const RowV& r) { u32x2* q = (u32x2*)p + lane;
#pragma unroll
    for (int j = 0; j < 4; ++j) { u32x2 w; w.x = cvt_pk_bf16(r.v[j][0], r.v[j][1]); w.y = cvt_pk_bf16(r.v[j][2], r.v[j][3]); q[64 * j] = w; } }
__device__ __forceinline__ RowV row_load_bf16(const bf16_t* p, int lane) { RowV r; const u32x2* q = (const u32x2*)p + lane;
#pragma unroll
    for (int j = 0; j < 4; ++j) { const u32x2 w = q[64 * j]; r.v[j] = (f32x4){bflo(w.x), bfhi(w.x), bflo(w.y), bfhi(w.y)}; } return r; }

struct RowIn { RowV x; u32x2 y0[4], y1[4]; int valid; float w0, w1; };
template <int MODE>
__device__ __forceinline__ RowIn rows_load(const Frame& F, int r, int lane, int s0, int s1, bool last) {
    RowIn in; in.valid = 0; in.w0 = 0.f; in.w1 = 0.f;
#pragma unroll
    for (int j = 0; j < 4; ++j) { in.x.v[j] = (f32x4){0.f, 0.f, 0.f, 0.f}; in.y0[j] = (u32x2){0u, 0u}; in.y1[j] = (u32x2){0u, 0u}; }
    if (r >= MALL) return in;
    const int b = r / TT, t = r - b * TT; const bool isctx = t < CTXL;
    if (last && isctx) return in;
    in.valid = 1;
    if (MODE == 0) in.x = row_load(isctx ? F.in[I_CTX] + ((size_t)b * CTXL + t) * D : F.in[I_X] + ((size_t)b * SEQ + (t - CTXL)) * D, lane);
    else {
        in.x = row_load_bf16((const bf16_t*)xrow_ptr(F, r), lane);
        const float* tw = WSP(const float, WS_ROUTE + RT_TW) + (size_t)r * 2; in.w0 = tw[0]; in.w1 = tw[1];
        const u32x2* q0 = (const u32x2*)(WSP(const bf16_t, WS_Y) + (size_t)s0 * D) + lane; const u32x2* q1 = (const u32x2*)(WSP(const bf16_t, WS_Y) + (size_t)s1 * D) + lane;
#pragma unroll
        for (int j = 0; j < 4; ++j) { in.y0[j] = q0[64 * j]; in.y1[j] = q1[64 * j]; }
    }
    return in;
}
template <int MODE>
__device__ __forceinline__ void phase_rows(const Frame& F, int l, int dry = 0) {
    const int gw = F.bx * NWAVES + F.wave, NGW = F.G * NWAVES, lane = opaque(F.lane);
    const bool last = (MODE == 1 && l == DEPTH - 1);
    const int ln = (MODE == 0) ? 0 : l + 1;
    const int RPV = (MALL + NGW - 1) / NGW, rbeg = gw * RPV, rend = (rbeg + RPV < MALL) ? rbeg + RPV : MALL;
    int s0all = 0, s1all = 0;
    if (MODE == 1) { moe_offsets(F, CREG(l)); const volatile LAS int* off = (const volatile LAS int*)(F.lds + LDS_MISC + 128);
        const int rr = rbeg + lane; if (lane < RPV && rr < MALL && !(last && (rr % TT) < CTXL)) { const int* te = WSP(const int, WS_ROUTE + RT_TE) + (size_t)rr * 2; const int* rk = WSP(const int, WS_ROUTE + RT_RANK) + (size_t)rr * 2;
            s0all = off[te[0]] + rk[0]; s1all = off[te[1]] + rk[1]; } }
    RowIn cur = rows_load<MODE>(F, rbeg < rend ? rbeg : MALL, lane, __builtin_amdgcn_readlane(s0all, 0), __builtin_amdgcn_readlane(s1all, 0), last);
    RowIn nx1 = rows_load<MODE>(F, rbeg + 1 < rend ? rbeg + 1 : MALL, lane, __builtin_amdgcn_readlane(s0all, 1), __builtin_amdgcn_readlane(s1all, 1), last);
    f32x4 gtv[4], gsv[4], shv[4]; int key = -1;
#pragma unroll
    for (int j = 0; j < 4; ++j) { gtv[j] = (f32x4){0.f, 0.f, 0.f, 0.f}; gsv[j] = (f32x4){0.f, 0.f, 0.f, 0.f}; shv[j] = (f32x4){0.f, 0.f, 0.f, 0.f}; }
#pragma unroll 1
    for (int k = 0; rbeg + k < rend; ++k) {
        const int r = rbeg + k;
        const RowIn nxt = rows_load<MODE>(F, r + 2 < rend ? r + 2 : MALL, lane, __builtin_amdgcn_readlane(s0all, k + 2), __builtin_amdgcn_readlane(s1all, k + 2), last);
        if (cur.valid) {
            float* xp = xrow_ptr(F, r);
            RowV x = cur.x;
            if (MODE == 0) { if (!dry) row_store_bf16((bf16_t*)xp, lane, x); }
            { const int kk = (r % TT) < CTXL ? NB : r / TT;
              if (kk != key) { key = kk;
#pragma unroll
                for (int j = 0; j < 4; ++j) {
                    if (MODE == 1) gtv[j] = ((const f32x4*)mod_ptr(F, l, r, 5))[lane + 64 * j];
                    if (last) { gsv[j] = ((const f32x4*)F.in[I_FN])[lane + 64 * j]; }
                    else { gsv[j] = ((const f32x4*)(F.in[I_NMIX] + ln * D))[lane + 64 * j] * (((const f32x4*)mod_ptr(F, ln, r, 1))[lane + 64 * j] + 1.f); shv[j] = ((const f32x4*)mod_ptr(F, ln, r, 0))[lane + 64 * j]; } } } }
            if (MODE == 1) {
#pragma unroll
                for (int j = 0; j < 4; ++j) { const u32x2 a = cur.y0[j], c = cur.y1[j];
                    const f32x4 ys = (f32x4){cur.w0 * bflo(a.x) + cur.w1 * bflo(c.x), cur.w0 * bfhi(a.x) + cur.w1 * bfhi(c.x), cur.w0 * bflo(a.y) + cur.w1 * bflo(c.y), cur.w0 * bfhi(a.y) + cur.w1 * bfhi(c.y)};
                    x.v[j] = x.v[j] + gtv[j] * ys; }
                if (!last && !dry) row_store_bf16((bf16_t*)xp, lane, x);
            }
            const float rstd = row_rstd(x);
            RowV y;
#pragma unroll
            for (int j = 0; j < 4; ++j) y.v[j] = x.v[j] * rstd * gsv[j] + shv[j];
            if (last) { if (!dry) row_store(xp, lane, y); else row_store_bf16(WSP(bf16_t, WS_H) + (size_t)r * D, lane, y); }
            else row_store_bf16(WSP(bf16_t, WS_H) + (size_t)r * D, lane, y);
        }
        cur = nx1; nx1 = nxt;
    }
}

__device__ __forceinline__ void phase_ctxsum(const Frame& F) {
    const int gw = F.bx * NWAVES + F.wave, NGW = F.G * NWAVES, lane = opaque(F.lane);
    for (int r = gw; r < NB * CTXL; r += NGW) {
        const int b = r >> 8, t = r & 255;
        bf16_t* mp = WSP(bf16_t, WS_MERGED) + ((size_t)b * TT + t) * D;
        RowV m = row_load_bf16(mp, lane); const RowV p1 = row_load_bf16(WSP(const bf16_t, WS_PB) + (size_t)r * D, lane), p2 = row_load_bf16(WSP(const bf16_t, WS_PB) + ((size_t)2048 + r) * D, lane);
#pragma unroll
        for (int j = 0; j < 4; ++j) m.v[j] = (m.v[j] + p1.v[j]) + p2.v[j];
        row_store_bf16(mp, lane, m);
    }
}
__device__ __forceinline__ void phase_router(const Frame& F, int l, int creg) {
    LAS float* rwT = (LAS float*)F.lds;
    LAS int* lcnt = (LAS int*)(F.lds + 65536);
    LAS float* LG = (LAS float*)(F.lds + 65536 + 256);
    const bool last = (l == DEPTH - 1); const int tid = opaque(F.tid);
    for (int i = tid; i < 4 * 1024; i += NTHR) ((LAS f32x4*)rwT)[i] = WSP(const f32x4, WS_RWT)[i];
    if (tid < 32) lcnt[tid] = 0;
    __syncthreads();
    const int RPW = (MALL + F.G - 1) / F.G;
    const int r0 = F.bx * RPW, r1 = (r0 + RPW < MALL) ? r0 + RPW : MALL;
    const int lane = tid & 63;
    constexpr int RJ = 3;
    RowV xn[RJ];
#pragma unroll
    for (int j = 0; j < RJ; ++j) { const int r = r0 + F.wave + NWAVES * j; xn[j] = row_load_bf16((const bf16_t*)xrow_ptr(F, r < r1 ? r : r0), lane); }
    f32x4 gs[4], sh[4]; int key = -1;
#pragma unroll
    for (int j = 0; j < 4; ++j) { gs[j] = (f32x4){0.f, 0.f, 0.f, 0.f}; sh[j] = (f32x4){0.f, 0.f, 0.f, 0.f}; }
#pragma unroll 1
    for (int rb = r0 + F.wave; rb < r1; rb += NWAVES * RJ) {
        RowV x[RJ]; bool ok[RJ];
#pragma unroll
        for (int j = 0; j < RJ; ++j) x[j] = xn[j];
#pragma unroll
        for (int j = 0; j < RJ; ++j) { const int rn = rb + NWAVES * (RJ + j); xn[j] = row_load_bf16((const bf16_t*)xrow_ptr(F, rn < r1 ? rn : r0), lane); }
#pragma unroll
        for (int j = 0; j < RJ; ++j) {
            const int r = rb + NWAVES * j; const int b = r / TT, t = r - b * TT;
            ok[j] = r < r1 && !(last && t < CTXL);
            if (ok[j]) {
                if (t < CTXL) {
                    const RowV px = row_load(WSP(const float, WS_PB) + ((size_t)b * CTXL + t) * D, lane);
#pragma unroll
                    for (int q = 0; q < 4; ++q) x[j].v[q] = x[j].v[q] + px.v[q];
                    row_store_bf16((bf16_t*)xrow_ptr(F, r), lane, x[j]); }
                const int k = t < CTXL ? NB : b;
                if (k != key) { key = k; const float* g = F.in[I_NFFN] + l * D; const float* shp = mod_ptr(F, l, r, 3); const float* scp = mod_ptr(F, l, r, 4);
#pragma unroll
                    for (int q = 0; q < 4; ++q) { gs[q] = ((const f32x4*)g)[lane + 64 * q] * (((const f32x4*)scp)[lane + 64 * q] + 1.f); sh[q] = ((const f32x4*)shp)[lane + 64 * q]; } }
                const float rstd = row_rstd(x[j]);
#pragma unroll
                for (int q = 0; q < 4; ++q) x[j].v[q] = x[j].v[q] * rstd * gs[q] + sh[q];
                row_store_bf16(WSP(bf16_t, WS_H) + (size_t)r * D, lane, x[j]);
            }
        }
        float lg[RJ][8];
#pragma unroll
        for (int i = 0; i < 8; ++i) {
            f32x4 w0[4], w1[4];
#pragma unroll
            for (int q = 0; q < 4; ++q) { w0[q] = *(const LAS f32x4*)(rwT + i * 1024 + 256 * q + 4 * lane); w1[q] = *(const LAS f32x4*)(rwT + (i + 8) * 1024 + 256 * q + 4 * lane); }
#pragma unroll
            for (int j = 0; j < RJ; ++j) { float sa = 0.f, sb = 0.f;
#pragma unroll
                for (int q = 0; q < 4; ++q) { sa += (x[j].v[q][0] * w0[q][0] + x[j].v[q][1] * w0[q][1]) + (x[j].v[q][2] * w0[q][2] + x[j].v[q][3] * w0[q][3]);
                                              sb += (x[j].v[q][0] * w1[q][0] + x[j].v[q][1] * w1[q][1]) + (x[j].v[q][2] * w1[q][2] + x[j].v[q][3] * w1[q][3]); }
                const auto sw = __builtin_amdgcn_permlane32_swap(__float_as_uint(sa), __float_as_uint(sb), false, false);
                lg[j][i] = __uint_as_float(sw[0]) + __uint_as_float(sw[1]); }
            __builtin_amdgcn_sched_barrier(0);
        }
        const bool b3 = lane & 8, b2 = lane & 4;
#pragma unroll
        for (int j = 0; j < RJ; ++j) {
            const int r = rb + NWAVES * j;
#pragma unroll
            for (int i = 0; i < 4; ++i) { const auto sw = __builtin_amdgcn_permlane16_swap(__float_as_uint(lg[j][i]), __float_as_uint(lg[j][i + 4]), false, false); lg[j][i] = __uint_as_float(sw[0]) + __uint_as_float(sw[1]); }
#pragma unroll
            for (int i = 0; i < 2; ++i) { const float snd = b3 ? lg[j][i] : lg[j][i + 2], kp = b3 ? lg[j][i + 2] : lg[j][i]; lg[j][i] = kp + dpp_mov<0x128>(snd); }
            { const float snd = b2 ? lg[j][0] : lg[j][1], kp = b2 ? lg[j][1] : lg[j][0]; lg[j][0] = kp + __uint_as_float((unsigned)__builtin_amdgcn_ds_swizzle((int)__float_as_uint(snd), 0x101F)); }
            lg[j][0] += dpp_mov<0xB1>(lg[j][0]); lg[j][0] += dpp_mov<0x4E>(lg[j][0]);
            if (r < r1) { if (ok[j]) { if ((lane & 3) == 0) LG[(r - r0) * 16 + (lane >> 2)] = lg[j][0]; }
                          else if (lane == 0) LG[(r - r0) * 16] = __builtin_nanf(""); }
        }
    }
    __syncthreads();
    int e0 = -1, e1 = -1, lr0 = 0, lr1 = 0;
    const int myr = r0 + tid;
    if (tid < r1 - r0 && !(LG[tid * 16] != LG[tid * 16])) {
        float sc[16], sel[16];
#pragma unroll
        for (int e = 0; e < 16; ++e) { sc[e] = 1.f / (1.f + __expf(-LG[tid * 16 + e])); sel[e] = sc[e] + F.in[I_RB][e]; }
        int bg = 0; float bgs = -1e30f;
#pragma unroll
        for (int g = 0; g < 4; ++g) { float m1 = -1e30f, m2 = -1e30f;
#pragma unroll
            for (int i = 0; i < 4; ++i) { const float v = sel[g * 4 + i]; if (v > m1) { m2 = m1; m1 = v; } else if (v > m2) m2 = v; }
            const float gs = m1 + m2; if (gs > bgs) { bgs = gs; bg = g; } }
        float v0 = -1e30f, v1 = -1e30f, w0 = 0.f, w1 = 0.f;
#pragma unroll
        for (int e = 0; e < 16; ++e) { if ((e >> 2) == bg) { const float v = sel[e], sv = sc[e];
            if (v > v0) { v1 = v0; e1 = e0; w1 = w0; v0 = v; e0 = e; w0 = sv; } else if (v > v1) { v1 = v; e1 = e; w1 = sv; } } }
        const float ws = w0 + w1;
        float* tw = WSP(float, WS_ROUTE + RT_TW) + (size_t)myr * 2; tw[0] = w0 / ws; tw[1] = w1 / ws;
        int* te = WSP(int, WS_ROUTE + RT_TE) + (size_t)myr * 2; te[0] = e0; te[1] = e1;
        lr0 = __hip_atomic_fetch_add(&lcnt[e0], 1, __ATOMIC_RELAXED, __HIP_MEMORY_SCOPE_WORKGROUP); lr1 = __hip_atomic_fetch_add(&lcnt[e1], 1, __ATOMIC_RELAXED, __HIP_MEMORY_SCOPE_WORKGROUP);
    }
    __syncthreads();
    if (tid < 16) lcnt[16 + tid] = (int)atomicAdd(CTLW(CW_CNT + creg * 64 + tid), (unsigned)lcnt[tid]);
    __syncthreads();
    if (e0 >= 0) { int* rk = WSP(int, WS_ROUTE + RT_RANK) + (size_t)myr * 2; const int k0 = lcnt[16 + e0] + lr0, k1 = lcnt[16 + e1] + lr1; rk[0] = k0; rk[1] = k1;
        int* rl = WSP(int, WS_ROWL); rl[(size_t)e0 * MALL + k0] = myr * 2; rl[(size_t)e1 * MALL + k1] = myr * 2 + 1; }
    __syncthreads();
}

__device__ __forceinline__ int lat_tile(int j) { return (j >> 3) * 9 + 1 + (j & 7); }

struct SchedIn {
    const char* H; const char* W; int G, c; bool need_ctx;
    __device__ __forceinline__ bool next(int i, Unit& u) const {
        const int L = i * G + c; int pm, pn;
        if (need_ctx) { if (L >= NRT * 10) return false; rect_order(L, NRT, 10, pm, pn); }
        else if (L < 640) { int im; rect_order(L, 64, 10, im, pn); pm = lat_tile(im); }
        else { const int Lc = L - 640; if (Lc >= 40) return false; pm = (Lc / 5) * 9; const int q = Lc % 5; pn = q < 3 ? 2 + q : 5 + q; }
        u.pm = pm; u.pn = pn; u.kind = 0; u.nt = 16;
        u.A = H + (size_t)pm * 256 * 1024 * 2; u.B = W + (size_t)pn * 256 * 1024 * 2;
        return true;
    }
};
struct EpiIn {
    static constexpr bool PERM = true;
    bf16_t *QG, *KB, *VB, *XM, *CQKV, *KR; float *SSP; const float *qg, *kg; const f32x2 *t64, *t32; unsigned* kmx;
    __device__ __forceinline__ void operator()(const f32x4 (&acc)[2][2][4][2], const Unit& u, int wr, int wc, int fr, int fq) const {
        const int pn = u.pn, pmod = u.pm % 9; const bool lat = pmod != 0;
        const int rowb = u.pm * 256 + wr * 64 + fr, tb = (pmod - 1) * 256 + wr * 64 + fr;
        if (pn <= 2) {
            if (pn == 2 && wc >= 2) {
#pragma unroll
                for (int ai = 0; ai < 2; ++ai)
#pragma unroll
                    for (int m = 0; m < 4; ++m) { const size_t row = rowb + ai * 128 + m * 16;
#pragma unroll
                        for (int bj = 0; bj < 2; ++bj) *(u32x4*)(VB + row * 128 + (wc - 2) * 64 + 32 * bj + 8 * fq) = pack8(acc[ai][bj][m][0], acc[ai][bj][m][1]); }
            } else {
                const float* g = pn < 2 ? qg : kg; const float osc = pn < 2 ? C2Q : 1.f;
                float kmax = 0.f;
                f32x4 gv[2][2];
#pragma unroll
                for (int bj = 0; bj < 2; ++bj)
#pragma unroll
                    for (int n = 0; n < 2; ++n) gv[bj][n] = *(const f32x4*)(g + 32 * bj + 16 * n + 4 * fq);
#pragma unroll
                for (int ai = 0; ai < 2; ++ai)
#pragma unroll
                    for (int m = 0; m < 4; ++m) {
                        const size_t row = rowb + ai * 128 + m * 16;
                        f32x4 v[2][2]; float ss = 0.f;
#pragma unroll
                        for (int bj = 0; bj < 2; ++bj)
#pragma unroll
                            for (int n = 0; n < 2; ++n) { v[bj][n] = acc[ai][bj][m][n]; ss += (v[bj][n][0] * v[bj][n][0] + v[bj][n][1] * v[bj][n][1]) + (v[bj][n][2] * v[bj][n][2] + v[bj][n][3] * v[bj][n][3]); }
                        ss += __shfl_xor(ss, 16); ss += __shfl_xor(ss, 32);
                        const float rs = rsqrtf(ss * (1.f / 64.f) + EPS);
#pragma unroll
                        for (int bj = 0; bj < 2; ++bj)
#pragma unroll
                            for (int n = 0; n < 2; ++n) v[bj][n] = v[bj][n] * rs * gv[bj][n];
                        if (lat) {
                            const int t = tb + ai * 128 + m * 16, pr = t >> 6, pc = t & 63;
#pragma unroll
                            for (int j = 0; j < 4; ++j) {
                                const f32x2 cr = t64[pr * 16 + 4 * fq + j], cc = t64[pc * 16 + 4 * fq + j];
                                const float a1 = v[0][0][j], a2 = v[0][1][j]; v[0][0][j] = a1 * cr.x - a2 * cr.y; v[0][1][j] = a2 * cr.x + a1 * cr.y;
                                const float b1 = v[1][0][j], b2 = v[1][1][j]; v[1][0][j] = b1 * cc.x - b2 * cc.y; v[1][1][j] = b2 * cc.x + b1 * cc.y;
                            }
                        }
                        bf16_t* dst = pn < 2 ? QG + row * 1024 + (4 * pn + wc) * 64 : KB + row * 128 + wc * 64;
#pragma unroll
                        for (int bj = 0; bj < 2; ++bj) *(u32x4*)(dst + 32 * bj + 8 * fq) = pack8(v[bj][0] * osc, v[bj][1] * osc);
                        if (pn == 2) { float n2 = 0.f;
#pragma unroll
                            for (int bj = 0; bj < 2; ++bj)
#pragma unroll
                                for (int n = 0; n < 2; ++n) n2 += (v[bj][n][0] * v[bj][n][0] + v[bj][n][1] * v[bj][n][1]) + (v[bj][n][2] * v[bj][n][2] + v[bj][n][3] * v[bj][n][3]);
                            n2 += __shfl_xor(n2, 16); n2 += __shfl_xor(n2, 32); kmax = fmaxf(kmax, n2); }
                    }
                if (pn == 2) {
#pragma unroll
                    for (int o = 1; o < 16; o <<= 1) kmax = fmaxf(kmax, __shfl_xor(kmax, o));
                    if (fr == 0 && fq == 0) atomicMax(kmx + (u.pm / 9) * 32 + wc, __float_as_uint(kmax)); }
            }
        } else if (pn <= 4) {
#pragma unroll
            for (int ai = 0; ai < 2; ++ai)
#pragma unroll
                for (int m = 0; m < 4; ++m) { const size_t row = rowb + ai * 128 + m * 16;
#pragma unroll
                    for (int bj = 0; bj < 2; ++bj) *(u32x4*)(XM + row * 1024 + (pn - 3) * 256 + 128 * bj + 32 * wc + 8 * fq) = pack8(acc[ai][bj][m][0], acc[ai][bj][m][1]); }
        } else if (pn <= 6) {
#pragma unroll
            for (int ai = 0; ai < 2; ++ai)
#pragma unroll
                for (int m = 0; m < 4; ++m) { const size_t row = rowb + ai * 128 + m * 16;
#pragma unroll
                    for (int bj = 0; bj < 2; ++bj) { f32x4 a = acc[ai][bj][m][0], b = acc[ai][bj][m][1];
#pragma unroll
                        for (int j = 0; j < 4; ++j) { a[j] = gelu_tanh_f(a[j]); b[j] = gelu_tanh_f(b[j]); }
                        *(u32x4*)(QG + row * 1024 + 512 + (pn - 5) * 256 + 128 * bj + 32 * wc + 8 * fq) = pack8(a, b); } }
        } else {
#pragma unroll
            for (int bj = 0; bj < 2; ++bj) {
                const int sec = pn == 7 ? 0 : (pn == 8 ? bj : 1 + bj);
                if (sec == 2) {
                    if (wc != 0) continue;
                    float kmax = 0.f;
#pragma unroll
                    for (int ai = 0; ai < 2; ++ai)
#pragma unroll
                        for (int m = 0; m < 4; ++m) { const size_t row = rowb + ai * 128 + m * 16;
                            f32x4 v[2] = {acc[ai][1][m][0], acc[ai][1][m][1]};
                            if (lat) { const int t = tb + ai * 128 + m * 16, pr = t >> 6, pc = t & 63;
#pragma unroll
                                for (int j = 0; j < 2; ++j) { const f32x2 cr = t32[pr * 8 + 2 * fq + j], cc = t32[pc * 8 + 2 * fq + j];
                                    const float a1 = v[0][j], a2 = v[0][j + 2]; v[0][j] = a1 * cr.x - a2 * cr.y; v[0][j + 2] = a2 * cr.x + a1 * cr.y;
                                    const float b1 = v[1][j], b2 = v[1][j + 2]; v[1][j] = b1 * cc.x - b2 * cc.y; v[1][j + 2] = b2 * cc.x + b1 * cc.y; } }
                            *(u32x4*)(KR + row * 32 + 8 * fq) = pack8(v[0], v[1]);
                            float n2 = (v[0][0] * v[0][0] + v[0][1] * v[0][1]) + (v[0][2] * v[0][2] + v[0][3] * v[0][3]) + (v[1][0] * v[1][0] + v[1][1] * v[1][1]) + (v[1][2] * v[1][2] + v[1][3] * v[1][3]);
                            n2 += __shfl_xor(n2, 16); n2 += __shfl_xor(n2, 32); kmax = fmaxf(kmax, n2); }
#pragma unroll
                    for (int o = 1; o < 16; o <<= 1) kmax = fmaxf(kmax, __shfl_xor(kmax, o));
                    if (fr == 0 && fq == 0) atomicMax(kmx + (u.pm / 9) * 32 + 2, __float_as_uint(kmax));
                } else {
                    const int colb = (pn == 7 ? 128 * bj : (pn == 8 ? (bj == 0 ? 256 : 384) : 384 + 128)) + 32 * wc + 8 * fq;
                    const int grp = (pn == 7 ? 4 * bj : (pn == 8 ? (bj == 0 ? 8 : 12) : 16)) + wc;
#pragma unroll
                    for (int ai = 0; ai < 2; ++ai)
#pragma unroll
                        for (int m = 0; m < 4; ++m) { const size_t row = rowb + ai * 128 + m * 16;
                            const f32x4 a = acc[ai][bj][m][0], b = acc[ai][bj][m][1];
                            *(u32x4*)(CQKV + row * 640 + colb) = pack8(a, b);
                            float ss = (a[0] * a[0] + a[1] * a[1]) + (a[2] * a[2] + a[3] * a[3]) + (b[0] * b[0] + b[1] * b[1]) + (b[2] * b[2] + b[3] * b[3]);
                            ss += __shfl_xor(ss, 16); ss += __shfl_xor(ss, 32);
                            if (fq == 0) SSP[row * 20 + grp] = ss; }
                }
            }
        }
    }
};

struct SchedQKV {
    const char* CQKV; const char* WQ; const char* WKV; int G, c; bool need_ctx;
    __device__ __forceinline__ bool next(int i, Unit& u) const {
        const int L = i * G + c; const int nq = need_ctx ? NRT : 64;
        if (L < nq * 3) { int im, pn; rect_order(L, nq, 3, im, pn); const int pm = need_ctx ? im : lat_tile(im);
            u.pm = pm; u.pn = pn; u.kind = 0; u.nt = 6; u.A = CQKV + (size_t)pm * 256 * 640 * 2; u.B = WQ + (size_t)pn * 256 * 640 * 2; return true; }
        const int L2 = L - nq * 3; if (L2 >= NRT * 4) return false;
        int pm, pn; rect_order(L2, NRT, 4, pm, pn);
        u.pm = pm; u.pn = pn; u.kind = 1; u.nt = 4; u.A = CQKV + (size_t)pm * 256 * 640 * 2 + 384 * 2; u.B = WKV + (size_t)pn * 256 * 640 * 2; return true;
    }
};
struct EpiQKV {
    static constexpr bool PERM = true;
    bf16_t *QM, *KVM; const float *SSP; const f32x2* t32; unsigned* kmx;
    __device__ __forceinline__ void operator()(const f32x4 (&acc)[2][2][4][2], const Unit& u, int wr, int wc, int fr, int fq) const {
        const int pn = u.pn, pmod = u.pm % 9; const bool lat = pmod != 0;
        const int rowb = u.pm * 256 + wr * 64 + fr, tb = (pmod - 1) * 256 + wr * 64 + fr;
        float kmax[2] = {0.f, 0.f};
        float rsv[2][4];
#pragma unroll
        for (int ai = 0; ai < 2; ++ai)
#pragma unroll
            for (int m = 0; m < 4; ++m) { const size_t row = rowb + ai * 128 + m * 16;
                if (u.kind == 1) { const f32x4 s0 = *(const f32x4*)(SSP + row * 20 + 12), s1 = *(const f32x4*)(SSP + row * 20 + 16);
                    rsv[ai][m] = rsqrtf((((s0[0] + s0[1]) + (s0[2] + s0[3])) + ((s1[0] + s1[1]) + (s1[2] + s1[3]))) * (1.f / 256.f) + EPS); }
                else { const f32x4 s0 = *(const f32x4*)(SSP + row * 20), s1 = *(const f32x4*)(SSP + row * 20 + 4), s2 = *(const f32x4*)(SSP + row * 20 + 8);
                    rsv[ai][m] = rsqrtf((((s0[0] + s0[1]) + (s0[2] + s0[3])) + ((s1[0] + s1[1]) + (s1[2] + s1[3])) + ((s2[0] + s2[1]) + (s2[2] + s2[3]))) * (1.f / 384.f) + EPS); } }
#pragma unroll
        for (int ai = 0; ai < 2; ++ai)
#pragma unroll
            for (int m = 0; m < 4; ++m) {
                const size_t row = rowb + ai * 128 + m * 16;
                if (u.kind == 1) {
                    const float rs = rsv[ai][m];
#pragma unroll
                    for (int bj = 0; bj < 2; ++bj) { const f32x4 a = acc[ai][bj][m][0] * rs, c = acc[ai][bj][m][1] * rs;
                        *(u32x4*)(KVM + row * 1024 + pn * 256 + 128 * bj + 32 * wc + 8 * fq) = pack8(a, c);
                        if (pn < 2) { float n2 = (a[0] * a[0] + a[1] * a[1]) + (a[2] * a[2] + a[3] * a[3]) + (c[0] * c[0] + c[1] * c[1]) + (c[2] * c[2] + c[3] * c[3]);
                            n2 += __shfl_xor(n2, 16); n2 += __shfl_xor(n2, 32); kmax[bj] = fmaxf(kmax[bj], n2); } }
                } else {
                    const float rs = rsv[ai][m];
                    if (pn < 2) {
#pragma unroll
                        for (int bj = 0; bj < 2; ++bj) *(u32x4*)(QM + row * 768 + pn * 256 + 128 * bj + 32 * wc + 8 * fq) = pack8(acc[ai][bj][m][0] * (rs * C2M), acc[ai][bj][m][1] * (rs * C2M));
                    } else {
                        const int t = tb + ai * 128 + m * 16, pr = t >> 6, pc = t & 63;
#pragma unroll
                        for (int bj = 0; bj < 2; ++bj) {
                            f32x4 v[2] = {acc[ai][bj][m][0] * rs, acc[ai][bj][m][1] * rs};
                            if (lat) {
#pragma unroll
                                for (int j = 0; j < 2; ++j) { const f32x2 cr = t32[pr * 8 + 2 * fq + j], cc = t32[pc * 8 + 2 * fq + j];
                                    const float a1 = v[0][j], a2 = v[0][j + 2]; v[0][j] = a1 * cr.x - a2 * cr.y; v[0][j + 2] = a2 * cr.x + a1 * cr.y;
                                    const float b1 = v[1][j], b2 = v[1][j + 2]; v[1][j] = b1 * cc.x - b2 * cc.y; v[1][j + 2] = b2 * cc.x + b1 * cc.y; } }
                            *(u32x4*)(QM + row * 768 + 512 + (4 * bj + wc) * 32 + 8 * fq) = pack8(v[0] * C2M, v[1] * C2M);
                        }
                    }
                }
            }
        if (u.kind == 1 && pn < 2) {
#pragma unroll
            for (int bj = 0; bj < 2; ++bj) { float km = kmax[bj];
#pragma unroll
                for (int o = 1; o < 16; o <<= 1) km = fmaxf(km, __shfl_xor(km, o));
                if (fr == 0 && fq == 0) atomicMax(kmx + (u.pm / 9) * 32 + 8 + 2 * (4 * pn + 2 * bj + (wc >> 1)) + (wc & 1), __float_as_uint(km)); }
        }
    }
};

struct SchedMerge {
    const char *H, *QG, *XM, *WG, *WB; int G, c; bool need_ctx;
    __device__ __forceinline__ bool next(int i, Unit& u) const {
        const int nlat = c < 256 ? (256 - c + G - 1) / G : 0;
        int pm, pn, sub, ctxf = 0;
        if (i < 6 * nlat) { const int ti = i / 6; sub = i - ti * 6; int im; rect_order(ti * G + c, 64, 4, im, pn); pm = lat_tile(im); }
        else {
            if (!need_ctx) return false;
            const int q = (i - 6 * nlat) >> 1, ci = c + q * G; if (ci >= 96) return false;
            const int ct = ci / 3, b = ci - ct * 3; pm = (ct >> 2) * 9; pn = ct & 3; sub = 2 * b + ((i - 6 * nlat) & 1); ctxf = 8;
        }
        const int b = sub >> 1;
        u.pm = pm; u.pn = pn; u.kind = sub | ctxf;
        if ((sub & 1) == 0) { u.nt = 16; u.A = H + (size_t)pm * 256 * 1024 * 2; u.B = WG + (size_t)(b * 1024 + pn * 256) * 1024 * 2; }
        else { u.nt = 8; u.A = (b == 0 ? QG : (b == 1 ? QG + 512 * 2 : XM + 512 * 2)) + (size_t)pm * 256 * 1024 * 2; u.B = WB + (size_t)(b * 1024 + pn * 256) * 1024 * 2; }
        return true;
    }
};
struct EpiMerge {
    static constexpr bool PERM = true;
    bf16_t* MERGED; u32x4* stash; bf16_t* PB;
    __device__ __forceinline__ void operator()(const f32x4 (&acc)[2][2][4][2], const Unit& u, int wr, int wc, int fr, int fq) const {
        const int rowb = u.pm * 256 + wr * 64 + fr, tid = opaque(threadIdx.x), b = (u.kind & 7) >> 1; const bool ctxs = (u.kind & 8) != 0;
        if ((u.kind & 1) == 0) {
#pragma unroll
            for (int ai = 0; ai < 2; ++ai)
#pragma unroll
                for (int m = 0; m < 4; ++m)
#pragma unroll
                    for (int bj = 0; bj < 2; ++bj) { f32x4 a = acc[ai][bj][m][0], c = acc[ai][bj][m][1];
#pragma unroll
                        for (int j = 0; j < 4; ++j) { a[j] = sigmoid_f(a[j]); c[j] = sigmoid_f(c[j]); }
                        stash[(size_t)(((ai * 4 + m) * 2 + bj) * 512 + tid)] = pack8(a, c); }
            return;
        }
        const bool rmw = b > 0 && !ctxs;
        u32x4 g[2][2], p[2][2], gq[2][2], pq[2][2];
#define EM_LOAD(G, P, am) do { const int ai_ = (am) >> 1, mh_ = (am) & 1; _Pragma("unroll") for (int mm = 0; mm < 2; ++mm) _Pragma("unroll") for (int bj = 0; bj < 2; ++bj) { const int m = mh_ * 2 + mm; \
        G[mm][bj] = ld16_sc1(stash + (size_t)(((ai_ * 4 + m) * 2 + bj) * 512 + tid)); \
        const u32x4* mp_ = (const u32x4*)(MERGED + (size_t)(rowb + ai_ * 128 + m * 16) * 1024 + u.pn * 256 + 128 * bj + 32 * wc + 8 * fq); \
        P[mm][bj] = rmw ? ld16_sc1(mp_) : (u32x4){0u, 0u, 0u, 0u}; } } while (0)
        EM_LOAD(g, p, 0);
#pragma unroll
        for (int am = 0; am < 4; ++am) { const int ai = am >> 1, mh = am & 1;
            if (am < 3) EM_LOAD(gq, pq, am + 1);
#pragma unroll
            for (int mm = 0; mm < 2; ++mm)
#pragma unroll
                for (int bj = 0; bj < 2; ++bj) { const int m = mh * 2 + mm; const u32x4 gg = g[mm][bj], pp = p[mm][bj];
                    f32x4 a = acc[ai][bj][m][0], c = acc[ai][bj][m][1];
                    a[0] = a[0] * bflo(gg.x) + bflo(pp.x); a[1] = a[1] * bfhi(gg.x) + bfhi(pp.x); a[2] = a[2] * bflo(gg.y) + bflo(pp.y); a[3] = a[3] * bfhi(gg.y) + bfhi(pp.y);
                    c[0] = c[0] * bflo(gg.z) + bflo(pp.z); c[1] = c[1] * bfhi(gg.z) + bfhi(pp.z); c[2] = c[2] * bflo(gg.w) + bflo(pp.w); c[3] = c[3] * bfhi(gg.w) + bfhi(pp.w);
                    u32x4* mp = (u32x4*)(MERGED + (size_t)(rowb + ai * 128 + m * 16) * 1024 + u.pn * 256 + 128 * bj + 32 * wc + 8 * fq);
                    if (ctxs && b > 0) mp = (u32x4*)(PB + ((size_t)(b - 1) * 2048 + (u.pm / 9) * 256 + wr * 64 + fr + ai * 128 + m * 16) * 1024 + u.pn * 256 + 128 * bj + 32 * wc + 8 * fq);
                    *mp = pack8(a, c); g[mm][bj] = gq[mm][bj]; p[mm][bj] = pq[mm][bj]; }
        }
#undef EM_LOAD
    }
};

struct SchedOut {
    const char *A, *W; int G, c; bool need_ctx;
    __device__ __forceinline__ bool next(int i, Unit& u) const {
        const int nlat = c < 256 ? (256 - c + G - 1) / G : 0;
        if (i < nlat) { int im, pn; rect_order(i * G + c, 64, 4, im, pn); const int pm = lat_tile(im);
            u.pm = pm; u.pn = pn; u.kind = 0; u.nt = 16; u.A = A + (size_t)pm * 256 * 1024 * 2; u.B = W + (size_t)pn * 256 * 1024 * 2; return true; }
        if (!need_ctx) return false;
        const int ci = c + (i - nlat) * G; if (ci >= 64) return false;
        const int ct = ci >> 1, kh = ci & 1, pm = (ct >> 2) * 9, pn = ct & 3;
        u.pm = pm; u.pn = pn; u.kind = 1 + kh; u.nt = 8; u.A = A + (size_t)pm * 256 * 1024 * 2 + kh * 512 * 2; u.B = W + (size_t)pn * 256 * 1024 * 2 + kh * 512 * 2; return true;
    }
};
struct EpiOut {
    static constexpr bool PERM = true;
    static constexpr int XP = 2048;
    float* xc; float* xl; const float* mod; float* PX;
    __device__ __forceinline__ void operator()(const f32x4 (&acc)[2][2][4][2], const Unit& u, int wr, int wc, int fr, int fq) const {
        const int b = u.pm / 9, pmod = u.pm - b * 9;
        const float* gate = mod + ((size_t)(pmod == 0 ? 8 : b) * 6 + 2) * D;
        const size_t row0 = pmod == 0 ? (size_t)b * CTXL : (size_t)b * SEQ + (pmod - 1) * 256;
        float* pxb = PX + (size_t)b * CTXL * D;
        bf16_t* xw = (bf16_t*)(pmod == 0 ? xc : xl) + row0 * XP;
        const int r0 = opaque(wr * 64 + fr), c0 = u.pn * 256 + 32 * wc + 8 * fq;
        f32x4 gv[2][2];
#pragma unroll
        for (int bj = 0; bj < 2; ++bj)
#pragma unroll
            for (int n = 0; n < 2; ++n) gv[bj][n] = *(const f32x4*)(gate + c0 + 128 * bj + 4 * n);
        u32x4 xv[2][2], xn[2][2];
#define EO_LOAD(dst, am) do { const int ai_ = (am) >> 1, m0_ = ((am) & 1) * 2; _Pragma("unroll") for (int mm = 0; mm < 2; ++mm) _Pragma("unroll") for (int bj = 0; bj < 2; ++bj) \
        dst[mm][bj] = (u.kind != 2) ? *(const u32x4*)(xw + (size_t)(r0 + ai_ * 128 + (m0_ + mm) * 16) * XP + c0 + 128 * bj) : (u32x4){0u, 0u, 0u, 0u}; } while (0)
        EO_LOAD(xv, 0);
#pragma unroll
        for (int am = 0; am < 4; ++am) { const int ai = am >> 1, m0 = (am & 1) * 2;
            if (am < 3) EO_LOAD(xn, am + 1);
#pragma unroll
            for (int mm = 0; mm < 2; ++mm)
#pragma unroll
                for (int bj = 0; bj < 2; ++bj) { const size_t row = r0 + ai * 128 + (m0 + mm) * 16; const u32x4 w = xv[mm][bj];
                    const f32x4 o0 = (f32x4){bflo(w.x), bfhi(w.x), bflo(w.y), bfhi(w.y)} + gv[bj][0] * acc[ai][bj][m0 + mm][0], o1 = (f32x4){bflo(w.z), bfhi(w.z), bflo(w.w), bfhi(w.w)} + gv[bj][1] * acc[ai][bj][m0 + mm][1];
                    if (u.kind == 2) { *(f32x4*)(pxb + row * D + c0 + 128 * bj) = o0; *(f32x4*)(pxb + row * D + c0 + 128 * bj + 4) = o1; }
                    else *(u32x4*)(xw + row * XP + c0 + 128 * bj) = pack8(o0, o1);
                    xv[mm][bj] = xn[mm][bj]; }
        }
#undef EO_LOAD
    }
};

struct SchedMoe {
    const char *A, *W; const int* rowl; const volatile LAS int* off; int G, c, second;
    __device__ __forceinline__ bool next(int i, Unit& u) const {
        const int L = i * G + c; const int ntile = off[16] >> 8;
        if (L >= ntile * 4) return false;
        int im, pn; rect_order(L, ntile, 4, im, pn);
        int e = 0;
#pragma unroll
        for (int q = 1; q < 16; ++q) e += (im * 256 >= off[q]) ? 1 : 0;
        e = __builtin_amdgcn_readfirstlane(e);
        u.pm = im; u.pn = pn; u.kind = e;
        if (!second) { const int j0 = im * 256 - off[e]; u.nt = 16; u.A = A; u.rows = rowl + (size_t)e * MALL + j0; u.nvalid = off[17 + e] - j0; u.B = W + (size_t)(e * 1024 + pn * 256) * 1024 * 2; }
        else { u.nt = 8; u.A = A + (size_t)im * 256 * 512 * 2; u.rows = nullptr; u.nvalid = 0; u.B = W + (size_t)(e * 1024 + pn * 256) * 512 * 2; }
        return true;
    }
};
struct EpiMoe1 {
    static constexpr bool PERM = true;
    bf16_t* ACT;
    __device__ __forceinline__ void operator()(const f32x4 (&acc)[2][2][4][2], const Unit& u, int wr, int wc, int fr, int fq) const {
        const int rowb = u.pm * 256 + wr * 64 + fr;
#pragma unroll
        for (int ai = 0; ai < 2; ++ai)
#pragma unroll
            for (int m = 0; m < 4; ++m) { const size_t row = rowb + ai * 128 + m * 16;
                f32x4 o[2];
#pragma unroll
                for (int n = 0; n < 2; ++n)
#pragma unroll
                    for (int j = 0; j < 4; ++j) o[n][j] = silu_f(acc[ai][0][m][n][j]) * acc[ai][1][m][n][j];
                *(u32x4*)(ACT + row * 512 + u.pn * 128 + 32 * wc + 8 * fq) = pack8(o[0], o[1]); }
    }
};
struct EpiMoe2 {
    static constexpr bool PERM = true;
    bf16_t* Y;
    __device__ __forceinline__ void operator()(const f32x4 (&acc)[2][2][4][2], const Unit& u, int wr, int wc, int fr, int fq) const {
        const int rowb = u.pm * 256 + wr * 64 + fr;
#pragma unroll
        for (int ai = 0; ai < 2; ++ai)
#pragma unroll
            for (int m = 0; m < 4; ++m)
#pragma unroll
                for (int bj = 0; bj < 2; ++bj) *(u32x4*)(Y + (size_t)(rowb + ai * 128 + m * 16) * 1024 + u.pn * 256 + 128 * bj + 32 * wc + 8 * fq) = pack8(acc[ai][bj][m][0], acc[ai][bj][m][1]);
    }
};

constexpr int AT_VB = 8192, AT_KB = 16384;
constexpr int AT_V = 0, AT_K = 3 * AT_VB, AT_WS = AT_K + 3 * AT_KB, AT_OST = AT_WS + NWAVES * 256, AT_BYTES = AT_OST + NWAVES * 4096;
static_assert(AT_BYTES <= LDS_STAGE, "attention LDS");
__device__ __forceinline__ int crow(int r, int hi) { return (r & 3) + 8 * (r >> 2) + 4 * hi; }
template <int DK> __device__ __forceinline__ int kswz(int row, int colB) { return DK == 64 ? row * 128 + (colB ^ (((row >> 1) & 7) << 4)) : row * 256 + (colB ^ ((row & 15) << 4)); }
__device__ __forceinline__ int v_st(int k, int c) { const int kk = (k & ~0xC) | ((k & 4) << 1) | ((k & 8) >> 1); return ((kk >> 3) * 2 + (c >> 5)) * 512 + ((kk & 7) * 32 + (c & 31)) * 2; }
__device__ __forceinline__ int v_rd_base(int lane) { return ((lane & 3) << 3) | (((lane >> 2) & 3) << 6) | (((lane >> 4) & 1) << 5) | (((lane >> 5) & 1) << 8); }
constexpr int v_rd_off(int d0, int ks, int half) { return d0 * 512 + ks * 2048 + half * 1024; }
template <int OFF> __device__ __forceinline__ s16x4 tr_read(int vb) { s16x4 r; asm volatile("ds_read_b64_tr_b16 %0, %1 offset:%2" : "=&v"(r) : "v"(vb), "i"(OFF) : "memory"); return r; }

__device__ __forceinline__ void expA(f32x16& p0) {
#pragma unroll
    for (int r = 0; r < 16; ++r) p0[r] = fast_exp2(p0[r]);
}
__device__ __forceinline__ void finishSM(f32x16& p0, f32x16& p1, float& l_reg, bf16x8& pa0, bf16x8& pa1, bf16x8& pa2, bf16x8& pa3) {
#pragma unroll
    for (int r = 0; r < 16; ++r) p1[r] = fast_exp2(p1[r]);
    float ps = 0;
#pragma unroll
    for (int r = 0; r < 16; ++r) ps += p0[r];
#pragma unroll
    for (int r = 0; r < 16; ++r) ps += p1[r];
    l_reg += ps;
#define PK4(P, BASE, OUT) do { unsigned a0 = cvt_pk_bf16(P[BASE + 0], P[BASE + 1]), a1 = cvt_pk_bf16(P[BASE + 2], P[BASE + 3]);   \
    unsigned b0 = cvt_pk_bf16(P[BASE + 4], P[BASE + 5]), b1 = cvt_pk_bf16(P[BASE + 6], P[BASE + 7]);                              \
    auto r0 = __builtin_amdgcn_permlane32_swap(a0, b0, false, false); auto r1 = __builtin_amdgcn_permlane32_swap(a1, b1, false, false); \
    u32x4 w = {r0[0], r1[0], r0[1], r1[1]}; OUT = *reinterpret_cast<bf16x8*>(&w); } while (0)
    PK4(p0, 0, pa0); PK4(p0, 8, pa1); PK4(p1, 0, pa2); PK4(p1, 8, pa3);
#undef PK4
}
template <int DK>
__device__ __forceinline__ void qkt(f32x16& p0, f32x16& p1, int Ks, const bf16x8* qr, const f32x16& cinit, int r32, int hi) {
#pragma unroll
    for (int d0 = 0; d0 < DK / 16; ++d0) { const int cb = (d0 * 16 + hi * 8) * 2;
        const bf16x8 b0 = *(const LAS bf16x8*)(uintptr_t)(Ks + kswz<DK>(r32, cb));
        const bf16x8 b1 = *(const LAS bf16x8*)(uintptr_t)(Ks + kswz<DK>(32 + r32, cb));
        if (d0 == 0) { p0 = __builtin_amdgcn_mfma_f32_32x32x16_bf16(b0, qr[0], cinit, 0, 0, 0); p1 = __builtin_amdgcn_mfma_f32_32x32x16_bf16(b1, qr[0], cinit, 0, 0, 0); }
        else { p0 = __builtin_amdgcn_mfma_f32_32x32x16_bf16(b0, qr[d0], p0, 0, 0, 0); p1 = __builtin_amdgcn_mfma_f32_32x32x16_bf16(b1, qr[d0], p1, 0, 0, 0); } }
}
__device__ __forceinline__ void pv_d0(f32x16* o, int vb, bf16x8 pa0, bf16x8 pa1, bf16x8 pa2, bf16x8 pa3) {
#define TR8(D0, l0, h0, l1, h1, l2, h2, l3, h3) const s16x4 l0 = tr_read<v_rd_off(D0, 0, 0)>(vb), h0 = tr_read<v_rd_off(D0, 0, 1)>(vb), l1 = tr_read<v_rd_off(D0, 1, 0)>(vb), h1 = tr_read<v_rd_off(D0, 1, 1)>(vb), \
    l2 = tr_read<v_rd_off(D0, 2, 0)>(vb), h2 = tr_read<v_rd_off(D0, 2, 1)>(vb), l3 = tr_read<v_rd_off(D0, 3, 0)>(vb), h3 = tr_read<v_rd_off(D0, 3, 1)>(vb)
    TR8(0, a0, b0, a1, b1, a2, b2, a3, b3); TR8(1, c0, d0, c1, d1, c2, d2, c3, d3);
#undef TR8
    asm volatile("s_waitcnt lgkmcnt(0)" ::: "memory"); SBAR();
#define PK(L, H) (bf16x8){L[0], L[1], L[2], L[3], H[0], H[1], H[2], H[3]}
    o[0] = __builtin_amdgcn_mfma_f32_32x32x16_bf16(pa0, PK(a0, b0), o[0], 0, 0, 0); o[1] = __builtin_amdgcn_mfma_f32_32x32x16_bf16(pa0, PK(c0, d0), o[1], 0, 0, 0);
    o[0] = __builtin_amdgcn_mfma_f32_32x32x16_bf16(pa1, PK(a1, b1), o[0], 0, 0, 0); o[1] = __builtin_amdgcn_mfma_f32_32x32x16_bf16(pa1, PK(c1, d1), o[1], 0, 0, 0);
    o[0] = __builtin_amdgcn_mfma_f32_32x32x16_bf16(pa2, PK(a2, b2), o[0], 0, 0, 0); o[1] = __builtin_amdgcn_mfma_f32_32x32x16_bf16(pa2, PK(c2, d2), o[1], 0, 0, 0);
    o[0] = __builtin_amdgcn_mfma_f32_32x32x16_bf16(pa3, PK(a3, b3), o[0], 0, 0, 0); o[1] = __builtin_amdgcn_mfma_f32_32x32x16_bf16(pa3, PK(c3, d3), o[1], 0, 0, 0);
#undef PK
}
template <int DK>
__device__ __forceinline__ void attn_unit(const bf16_t* Qb, int ldq, const bf16_t* Qr, const bf16_t* __restrict__ Kh, int ldk, const bf16_t* __restrict__ K2,
                                          const bf16_t* __restrict__ Vh, int ldv, bf16_t* Ob, int ldo, int nkeys, float k2max, int ldsb) {
    const int tid = opaque(threadIdx.x), wid = tid >> 6, lane = tid & 63, r32 = lane & 31, hi = lane >> 5;
    const int V_lds = ldsb + AT_V, K_lds = ldsb + AT_K;
    LAS float* li_l = (LAS float*)(uintptr_t)(ldsb + AT_WS + wid * 256);
    float l_reg = 0; f32x16 o[2] = {}; bf16x8 qr[DK / 16];
    { const bf16_t* Qw = Qb + (size_t)(wid * 32 + r32) * ldq + hi * 8;
#pragma unroll
      for (int d0 = 0; d0 < 4; ++d0) qr[d0] = *(const bf16x8*)(Qw + d0 * 16);
      if constexpr (DK == 96) { const bf16_t* Qw2 = Qr + (size_t)(wid * 32 + r32) * ldq + hi * 8;
#pragma unroll
        for (int d0 = 0; d0 < 2; ++d0) qr[4 + d0] = *(const bf16x8*)(Qw2 + d0 * 16); } }
    f32x16 cinit;
    {
        float qn = 0.f;
#pragma unroll
        for (int d0 = 0; d0 < DK / 16; ++d0) { const u32x4 w = *reinterpret_cast<const u32x4*>(&qr[d0]);
            qn += (bflo(w.x) * bflo(w.x) + bfhi(w.x) * bfhi(w.x)) + (bflo(w.y) * bflo(w.y) + bfhi(w.y) * bfhi(w.y)) + (bflo(w.z) * bflo(w.z) + bfhi(w.z) * bfhi(w.z)) + (bflo(w.w) * bflo(w.w) + bfhi(w.w) * bfhi(w.w)); }
        qn += __shfl_xor(qn, 32);
        const float nm = 32.f - sqrtf(qn * k2max * 1.03f);
#pragma unroll
        for (int r = 0; r < 16; ++r) cinit[r] = nm;
    }
    const int sr = tid >> 3, sc = (tid & 7) * 8;
    const int sr2 = (tid >> 2) & 63, sc2 = (tid & 3) * 8;
    const int kst = kswz<DK>(sr, sc * 2), kst2 = kswz<DK>(sr2, (64 + sc2) * 2), vst = v_st(sr, sc);
    const int vb0 = V_lds + v_rd_base(lane);
    constexpr int SD = 2, S1 = SD - 1;
    struct { bf16x8 k, k2, v; } sr_[SD];
#define SLOAD(i, k0) do { sr_[i].v = *(const bf16x8*)(Vh + (size_t)((k0) + sr) * ldv + sc); sr_[i].k = *(const bf16x8*)(Kh + (size_t)((k0) + sr) * ldk + sc); \
    if constexpr (DK == 96) sr_[i].k2 = *(const bf16x8*)(K2 + (size_t)((k0) + sr2) * 32 + sc2); } while (0)
#define SWRITE(b, i) do { *(LAS bf16x8*)(uintptr_t)(V_lds + (b) * AT_VB + vst) = sr_[i].v; *(LAS bf16x8*)(uintptr_t)(K_lds + (b) * AT_KB + kst) = sr_[i].k; \
    if constexpr (DK == 96) *(LAS bf16x8*)(uintptr_t)(K_lds + (b) * AT_KB + kst2) = sr_[i].k2; } while (0)
    f32x16 pA0, pA1, pB0, pB1; bf16x8 pa0, pa1, pa2, pa3; const int NT = nkeys / 64;
    SLOAD(0, 0); SWRITE(0, 0); SLOAD(S1, 64); SWRITE(1, S1); if constexpr (SD == 2) { if (2 < NT) SLOAD(0, 128); }
    __syncthreads();
    qkt<DK>(pA0, pA1, K_lds, qr, cinit, r32, hi); expA(pA0);
    int bp = 0, bq = 1, bn = 2;
#define STEP(C0, C1, P0, P1, SL_LD, SL_WR, J) do { \
        SBAR(); qkt<DK>(C0, C1, K_lds + bq * AT_KB, qr, cinit, r32, hi); \
        finishSM(P0, P1, l_reg, pa0, pa1, pa2, pa3); SBAR(); \
        if ((J) + SD < NT) SLOAD(SL_LD, ((J) + SD) * 64); SBAR(); \
        pv_d0(o, vb0 + bp * AT_VB, pa0, pa1, pa2, pa3); expA(C0); \
        if ((J) + 1 < NT) SWRITE(bn, SL_WR); \
        __syncthreads(); \
        bp = bq; bq = bn; bn = (bn == 2) ? 0 : bn + 1; } while (0)
    for (int j = 1; j + 1 < NT; j += 2) {
        STEP(pB0, pB1, pA0, pA1, S1, 0, j);
        STEP(pA0, pA1, pB0, pB1, 0, S1, j + 1);
    }
    SBAR(); qkt<DK>(pB0, pB1, K_lds + bq * AT_KB, qr, cinit, r32, hi);
    finishSM(pA0, pA1, l_reg, pa0, pa1, pa2, pa3); SBAR();
    pv_d0(o, vb0 + bp * AT_VB, pa0, pa1, pa2, pa3); expA(pB0);
    finishSM(pB0, pB1, l_reg, pa0, pa1, pa2, pa3); SBAR();
    pv_d0(o, vb0 + bq * AT_VB, pa0, pa1, pa2, pa3);
#undef STEP
    l_reg += __shfl_xor(l_reg, 32);
    if (hi == 0) li_l[r32] = l_reg; asm volatile("s_waitcnt lgkmcnt(0)" ::: "memory");
    {
        const int ost = ldsb + AT_OST + wid * 4096;
#pragma unroll
        for (int r = 0; r < 16; ++r) { const int orow = crow(r, hi); const float rl = fast_rcp(li_l[orow]);
#pragma unroll
            for (int d0 = 0; d0 < 2; ++d0) *(LAS unsigned short*)(uintptr_t)(ost + orow * 128 + (d0 * 32 + r32) * 2) = (unsigned short)(cvt_pk_bf16(o[d0][r] * rl, 0.f) & 0xffffu); }
        asm volatile("s_waitcnt lgkmcnt(0)" ::: "memory");
        bf16_t* Ow = Ob + (size_t)(wid * 32) * ldo;
#pragma unroll
        for (int i = 0; i < 4; ++i) { const int id = lane + 64 * i, row = id >> 3, ch = id & 7;
            *(u32x4*)(Ow + (size_t)row * ldo + ch * 8) = *(const LAS u32x4*)(uintptr_t)(ost + row * 128 + ch * 16); }
    }
    __syncthreads();
#undef SLOAD
#undef SWRITE
}

constexpr int LRU_UROW = 1040;
constexpr int LRU_GY = 64 * LRU_UROW;
static_assert(LRU_GY + 64 * LRU_UROW <= LDS_MISC, "lru lds");
template <bool FINAL, int DIR>
__device__ __forceinline__ void lru_dir(const Frame& F, int l, int b, int ch, int nt2, f32x16 (&hf)[2], float cin_in) {
    const int lane = opaque(F.lane), w = F.wave, r32 = lane & 31, hi = lane >> 5, d = DIR;
    LAS unsigned char* U = F.lds;
    LAS unsigned char* GYT = F.lds + LRU_GY;
    const int c = w * 64 + nt2 * 32 + r32;
    const bf16_t* WL = WSP(const bf16_t, WS_WLRU) + (size_t)l * (2 * 2 * 8 * 64 * 64);
    float* TOT = WSP(float, WS_TOT);
    const float nba = -LOG2E * F.in[I_LBA][(l * 2 + d) * 512 + c], nbi = -LOG2E * F.in[I_LBI][(l * 2 + d) * 512 + c];
    const float c8 = -8.f * LOG2E * log1pf(__expf(-F.in[I_LLAM][(l * 2 + d) * 512 + c]));
    f32x16 av[2], bq[2];
    bf16x8 wa[4], wi[4];
#pragma unroll
    for (int ks = 0; ks < 4; ++ks) {
        wa[ks] = *(const bf16x8*)(WL + ((size_t)((d * 2 + 0) * 8 + w) * 64 + nt2 * 32 + r32) * 64 + ks * 16 + hi * 8);
        wi[ks] = *(const bf16x8*)(WL + ((size_t)((d * 2 + 1) * 8 + w) * 64 + nt2 * 32 + r32) * 64 + ks * 16 + hi * 8); }
#pragma unroll
    for (int mt = 0; mt < 2; ++mt) {
        f32x16 xa = {}, xi = {};
#pragma unroll
        for (int ks = 0; ks < 4; ++ks) {
            const bf16x8 af = *(const LAS bf16x8*)(U + (mt * 32 + r32) * LRU_UROW + (w * 64 + ks * 16 + hi * 8) * 2);
            xa = __builtin_amdgcn_mfma_f32_32x32x16_bf16(af, wa[ks], xa, 0, 0, 0); xi = __builtin_amdgcn_mfma_f32_32x32x16_bf16(af, wi[ks], xi, 0, 0, 0); }
#pragma unroll
        for (int r = 0; r < 16; ++r) {
            const float uv = bf2f(*(const LAS unsigned short*)(U + (mt * 32 + crow(r, hi)) * LRU_UROW + c * 2));
            const float rg = fast_rcp(1.f + fast_exp2(fmaf(xa[r], -LOG2E, nba))), ig = fast_rcp(1.f + fast_exp2(fmaf(xi[r], -LOG2E, nbi)));
            const float a = fast_exp2(c8 * rg);
            av[mt][r] = a; bq[mt][r] = __builtin_amdgcn_sqrtf(fmaxf(fmaf(-a, a, 1.f), 0.f)) * ig * uv;
        }
    }
    float cin = FINAL ? cin_in : 0.f, Atot = 1.f;
    float mycin[2][4];
#pragma unroll
    for (int q = 0; q < 2; ++q) {
        const int mt = d == 0 ? q : 1 - q;
#pragma unroll
        for (int qs = 0; qs < 4; ++qs) {
            const int sl = d == 0 ? qs : 3 - qs;
            float As = 1.f, Bs = 0.f;
#pragma unroll
            for (int k = 0; k < 4; ++k) { const int r = 4 * sl + (d == 0 ? k : 3 - k); As *= av[mt][r]; Bs = av[mt][r] * Bs + bq[mt][r]; }
            const auto ra = __builtin_amdgcn_permlane32_swap(__float_as_uint(As), __float_as_uint(As), false, false), rb = __builtin_amdgcn_permlane32_swap(__float_as_uint(Bs), __float_as_uint(Bs), false, false);
            const float A0 = __uint_as_float(ra[0]), A1 = __uint_as_float(ra[1]), B0 = __uint_as_float(rb[0]), B1 = __uint_as_float(rb[1]);
            float c0v, c1v;
            if (d == 0) { c0v = cin; cin = A0 * cin + B0; c1v = cin; cin = A1 * cin + B1; }
            else { c1v = cin; cin = A1 * cin + B1; c0v = cin; cin = A0 * cin + B0; }
            mycin[mt][sl] = hi ? c1v : c0v; Atot *= A0 * A1;
        }
    }
    if (!FINAL) { if (hi == 0) { float* tp = TOT + ((size_t)(b * 2 + d) * NCH + ch) * 1024 + c; tp[0] = Atot; tp[512] = cin; } }
    else {
#pragma unroll
        for (int mt = 0; mt < 2; ++mt)
#pragma unroll
            for (int sl = 0; sl < 4; ++sl) { float h = mycin[mt][sl];
#pragma unroll
                for (int k = 0; k < 4; ++k) { const int r = 4 * sl + (d == 0 ? k : 3 - k); h = av[mt][r] * h + bq[mt][r];
                    if (d == 0) hf[mt][r] = h;
                    else { LAS unsigned short* op = (LAS unsigned short*)(GYT + (mt * 32 + crow(r, hi)) * LRU_UROW + c * 2);
                           *op = (unsigned short)(cvt_pk_bf16((hf[mt][r] + h) * bf2f(*op), 0.f) & 0xffffu); } } }
    }
}
template <bool FINAL>
__device__ __forceinline__ void lru_unit(const Frame& F, int l, int b, int ch, int half = -1) {
    const int tid = opaque(F.tid);
    LAS unsigned char* U = F.lds;
    const bf16_t* XM = WSP(const bf16_t, WS_XM);
    const int t0 = ch * 64, seglo = ch < 4 ? 0 : CTXL, seghi = ch < 4 ? CTXL : TT;
    float cpre[2][2] = {{0.f, 0.f}, {0.f, 0.f}};
    if (FINAL) {
        const int r32 = opaque(F.lane) & 31;
#pragma unroll
        for (int d = 0; d < 2; ++d) {
            const float* tp = WSP(const float, WS_TOT) + ((size_t)(b * 2 + d) * NCH) * 1024 + F.wave * 64 + r32;
            const int n0 = d == 0 ? 0 : (ch >= 4 ? 4 : 3 - ch);
            const int nst = d == 0 ? ch : (ch >= 4 ? 4 + (NCH - 1 - ch) : 3 - ch);
            float c0 = 0.f, c1 = 0.f;
#pragma unroll 1
            for (int s0 = 0; s0 < nst; s0 += 16) {
                float Aq[2][16], Bq[2][16];
#pragma unroll
                for (int q = 0; q < 16; ++q) { const int st = s0 + q; const bool ok = st < nst;
                    const int j = d == 0 ? st : (st < n0 ? 3 - st : NCH - 1 - (st - n0));
                    const int jj = ok ? j : 0;
#pragma unroll
                    for (int n = 0; n < 2; ++n) { const float Av = tp[jj * 1024 + n * 32], Bv = tp[jj * 1024 + 512 + n * 32]; Aq[n][q] = ok ? Av : 1.f; Bq[n][q] = ok ? Bv : 0.f; } }
#pragma unroll
                for (int q = 0; q < 16; ++q) { c0 = Aq[0][q] * c0 + Bq[0][q]; c1 = Aq[1][q] * c1 + Bq[1][q]; }
            }
            cpre[0][d] = c0; cpre[1][d] = c1;
        }
    }
    {
        const int c0 = (tid & 63) * 8, tg = tid >> 6;
        u32x4 xr[11];
#pragma unroll
        for (int i = 0; i < 11; ++i) { const int t = t0 + tg * 8 - 1 + i;
            xr[i] = (t >= seglo && t < seghi) ? *(const u32x4*)(XM + (size_t)(b * TT + t) * 1024 + c0) : (u32x4){0u, 0u, 0u, 0u}; }
        const float* cw = F.in[I_CONVW] + (size_t)l * 4 * 512 + c0; const float* cb = F.in[I_CONVB] + l * 512 + c0;
        f32x4 wv[4][2], bv[2];
#pragma unroll
        for (int j = 0; j < 4; ++j) { wv[j][0] = *(const f32x4*)(cw + j * 512); wv[j][1] = *(const f32x4*)(cw + j * 512 + 4); }
        bv[0] = *(const f32x4*)cb; bv[1] = *(const f32x4*)(cb + 4);
#pragma unroll
        for (int tt = 0; tt < 8; ++tt) { f32x4 a0 = bv[0], a1 = bv[1];
#pragma unroll
            for (int j = 0; j < 4; ++j) { const u32x4 x = xr[tt + j];
                a0 += wv[j][0] * (f32x4){bflo(x.x), bfhi(x.x), bflo(x.y), bfhi(x.y)}; a1 += wv[j][1] * (f32x4){bflo(x.z), bfhi(x.z), bflo(x.w), bfhi(x.w)}; }
            *(LAS u32x4*)(U + (tg * 8 + tt) * LRU_UROW + c0 * 2) = pack8(a0, a1); }
        if (FINAL) {
            bf16_t* QG = WSP(bf16_t, WS_QG);
            if (half < 0 || ((c0 >> 5) & 1) == half) {
#pragma unroll
            for (int tt = 0; tt < 8; ++tt) *(LAS u32x4*)(F.lds + LRU_GY + (tg * 8 + tt) * LRU_UROW + c0 * 2) = *(const u32x4*)(QG + (size_t)(b * TT + t0 + tg * 8 + tt) * 1024 + 512 + c0); }
        }
    }
    __syncthreads();
#pragma unroll 1
    for (int nt2 = (half < 0 ? 0 : half); nt2 < (half < 0 ? 2 : half + 1); ++nt2) {
        f32x16 hf[2];
        lru_dir<FINAL, 0>(F, l, b, ch, nt2, hf, nt2 ? cpre[1][0] : cpre[0][0]);
        lru_dir<FINAL, 1>(F, l, b, ch, nt2, hf, nt2 ? cpre[1][1] : cpre[0][1]);
    }
    __syncthreads();
    if (FINAL) {
        const int tid2 = opaque(F.tid), c0 = (tid2 & 63) * 8, tg = tid2 >> 6; bf16_t* QG = WSP(bf16_t, WS_QG);
        if (half < 0 || ((c0 >> 5) & 1) == half) {
#pragma unroll
        for (int tt = 0; tt < 8; ++tt) *(u32x4*)(QG + (size_t)(b * TT + t0 + tg * 8 + tt) * 1024 + 512 + c0) = *(const LAS u32x4*)(F.lds + LRU_GY + (tg * 8 + tt) * LRU_UROW + c0 * 2); }
        __syncthreads();
    }
}
#ifdef MK_DBG_DET
namespace mkdbg {
__global__ void k_chk(const unsigned* base, long rows, long pitch_w, long off_w, long width_w, const int* rowidx, unsigned long long* acc) {
    unsigned long long s = 0;
    const long total = rows * width_w;
    for (long i = blockIdx.x * (long)blockDim.x + threadIdx.x; i < total; i += (long)gridDim.x * blockDim.x) {
        const long r = i / width_w, c = i - r * width_w; const long rr = rowidx ? rowidx[r] : r;
        const unsigned v = base[rr * pitch_w + off_w + c];
        s += (unsigned long long)v * (unsigned long long)(2 * (i % 1021) + 1);
    }
    for (int o = 32; o > 0; o >>= 1) s += __shfl_xor(s, o);
    if ((threadIdx.x & 63) == 0) atomicAdd(acc, s);
}
__global__ void k_verdict(const unsigned long long* a, const unsigned long long* b, int n, float* out, long nout) {
    int code = n;
    for (int p = n - 1; p >= 0; --p) if (a[p] != b[p]) code = p;
    const float v = exp2f((float)(code + 1));
    for (long i = blockIdx.x * (long)blockDim.x + threadIdx.x; i < nout; i += (long)gridDim.x * blockDim.x) out[i] = v;
}
}
#endif

__device__ __forceinline__ void phase_attn(const Frame& F, int l) {
    const bool need_ctx = (l < DEPTH - 1);
    const int ldsb = (int)(uintptr_t)F.lds;
    bf16_t* QG = WSP(bf16_t, WS_QG); bf16_t* XM = WSP(bf16_t, WS_XM);
    const bf16_t* KB = WSP(const bf16_t, WS_KB); const bf16_t* VB = WSP(const bf16_t, WS_VB);
    const bf16_t* QM = WSP(const bf16_t, WS_QM); const bf16_t* KVM = WSP(const bf16_t, WS_KVM); const bf16_t* KR = WSP(const bf16_t, WS_KR);
    const float* kmx = (const float*)CTLW(CW_KMAX + l * 256);
    const int n_ctx = need_ctx ? 128 : 0, n_lru = need_ctx ? NB * NCH * 2 : NB * (NCH - 4);
    const int total = 1024 + n_ctx + n_lru;
    for (int id = F.bx; id < total; id += F.G) {
        int typ, b, h, qrow, nk, ch = 0, half = -1;
        if (id < 512) {
            const int r = id >> 8, wq = id & 255, x = wq & 7, j = wq >> 3, pp = x + 8 * r; b = pp >> 1; h = (pp & 1) * 4 + (j >> 3); qrow = CTXL + (j & 7) * 256; nk = TT; typ = 0;
        } else if (id < 1024) {
            const int i2 = id - 512, r = i2 >> 8, wq = i2 & 255, x = wq & 7, j = wq >> 3, idx = (x + 8 * r) * 4 + (j >> 3); b = idx >> 3; h = idx & 7; qrow = CTXL + (j & 7) * 256; nk = TT; typ = 1;
        } else if (id < 1024 + n_lru) { const int i2 = id - 1024; typ = 2; h = 0; qrow = 0; nk = 0;
            if (need_ctx) { const int u2 = i2 >> 1; half = i2 & 1; b = u2 / NCH; ch = u2 - b * NCH; } else { b = i2 / (NCH - 4); ch = 4 + i2 - b * (NCH - 4); } }
        else { const int i2 = id - 1024 - n_lru; b = (i2 & 63) >> 3; h = i2 & 7; qrow = 0; nk = CTXL; typ = i2 < 64 ? 0 : 1; }
        const size_t row0 = (size_t)b * TT + qrow, key0 = (size_t)b * TT;
        if (typ == 0) { const int kvh = h >> 2;
            if (nk == TT) attn_unit<64>(QG + row0 * 1024 + h * 64, 1024, nullptr, KB + key0 * 128 + kvh * 64, 128, nullptr, VB + key0 * 128 + kvh * 64, 128, QG + row0 * 1024 + h * 64, 1024, TT, kmx[b * 32 + kvh], ldsb);
            else attn_unit<64>(QG + row0 * 1024 + h * 64, 1024, nullptr, KB + key0 * 128 + kvh * 64, 128, nullptr, VB + key0 * 128 + kvh * 64, 128, QG + row0 * 1024 + h * 64, 1024, CTXL, kmx[b * 32 + kvh], ldsb);
        } else if (typ == 1) { const float k2 = kmx[b * 32 + 8 + 2 * h] + kmx[b * 32 + 9 + 2 * h] + kmx[b * 32 + 2];
            if (nk == TT) attn_unit<96>(QM + row0 * 768 + h * 64, 768, QM + row0 * 768 + 512 + h * 32, KVM + key0 * 1024 + h * 64, 1024, KR + key0 * 32, KVM + key0 * 1024 + 512 + h * 64, 1024, XM + row0 * 1024 + 512 + h * 64, 1024, TT, k2, ldsb);
            else attn_unit<96>(QM + row0 * 768 + h * 64, 768, QM + row0 * 768 + 512 + h * 32, KVM + key0 * 1024 + h * 64, 1024, KR + key0 * 32, KVM + key0 * 1024 + 512 + h * 64, 1024, XM + row0 * 1024 + 512 + h * 64, 1024, CTXL, k2, ldsb);
        } else lru_unit<true>(F, l, b, ch, half);
    }
}

constexpr int NPHASE = 2 + DEPTH * 10;
#ifndef MK_MASK
#define MK_MASK 0xFFF
#endif
#define PM(k) ((MK_MASK >> (k)) & 1)
#ifndef MK_REPGRP
#define MK_REPGRP 0
#endif
#define REPN(k) (1 + ((MK_REP >> (k)) & 1))
__global__ void __launch_bounds__(NTHR, 2) mk_fwd(Args args) {
    extern __shared__ __attribute__((aligned(16))) unsigned char lds_raw[];
    Frame F0;
    F0.lds = (LAS unsigned char*)lds_raw; F0.ws = args.ws; F0.in = args.in; F0.out = args.out;
    F0.tid = threadIdx.x; F0.lane = F0.tid & 63; F0.wave = __builtin_amdgcn_readfirstlane(F0.tid >> 6); F0.G = gridDim.x; F0.bx = blockIdx.x;
    const Frame& F = F0;
    volatile LAS unsigned* misc = (volatile LAS unsigned*)(F.lds + LDS_MISC);
    if (F.tid < 64) misc[F.tid] = 0u;
    __syncthreads();
    XcdBarrier bar; bar.bar = CTLW(CW_BAR); bar.x = 0; bar.st = nullptr;
#if !MK_PER_PHASE
    bar = xcd_barrier_post(CTLW(CW_BAR), misc + 8);
#endif
    const int lo = args.ph_lo, hi = args.ph_hi;
#ifndef MK_TIME_BLK
#define MK_TIME_BLK 0
#endif
#ifdef MK_TIME_A
#define STAMP(k) do { if (F.bx == MK_TIME_BLK && F.tid == 0) { if ((k) == MK_TIME_A) misc[16] = (unsigned)__builtin_amdgcn_s_memrealtime(); if ((k) == MK_TIME_B) misc[17] = (unsigned)__builtin_amdgcn_s_memrealtime(); } } while (0)
#else
#define STAMP(k) do { } while (0)
#endif
#define IN(k) (lo <= (k) && (k) < hi)
#if MK_PER_PHASE
#define SEAM(k) do { } while (0)
#else
#define SEAM(k) do { if (IN(k) && IN((k) + 1)) xcd_barrier(bar); } while (0)
#endif
    STAMP(0);
    if (PM(0) && IN(0)) for (int rep_ = 0; rep_ < REPN(0); ++rep_) { if (rep_) xcd_barrier(bar); const Frame F = phase_frame(F0); p0_mod(F); __syncthreads();
        p0_weights(F); p0_misc(F); }
    SEAM(0);
    STAMP(1);
    if (PM(1) && IN(1)) for (int rep_ = 0; rep_ < REPN(1); ++rep_) { if (rep_) xcd_barrier(bar); const Frame F = phase_frame(F0); phase_rows<0>(F, 0); }
    SEAM(1);
#pragma unroll 1
    for (int l = 0; l < DEPTH; ++l) {
        const int pb = 2 + l * 10; const bool need_ctx = (l < DEPTH - 1);
        STAMP(pb + 0);
#if MK_REPGRP
        for (int grp_ = 0; grp_ < 2; ++grp_) { if (grp_) xcd_barrier(bar);
#endif
        if (PM(2) && IN(pb + 0)) for (int rep_ = 0; rep_ < REPN(2); ++rep_) { if (rep_) xcd_barrier(bar); const Frame F = phase_frame(F0); unsigned char* wl = F.ws + WS_W + (size_t)l * W_LAYER;
            SchedIn S{(const char*)(F.ws + WS_H), (const char*)(wl + W_IN), F.G, F.bx, need_ctx};
            EpiIn E{WSP(bf16_t, WS_QG), WSP(bf16_t, WS_KB), WSP(bf16_t, WS_VB), WSP(bf16_t, WS_XM), WSP(bf16_t, WS_CQKV), WSP(bf16_t, WS_KR),
                    WSP(float, WS_SSP), F.in[I_GQN] + l * 64, F.in[I_GKN] + l * 64, WSP(const f32x2, WS_TAB64), WSP(const f32x2, WS_TAB32), CTLW(CW_KMAX + l * 256)};
            gemm_stream<1024, 1024, EpiIn, SchedIn>(F.lds, S, E);
        }
        SEAM(pb + 0);
        STAMP(pb + 1);
        if (PM(3) && IN(pb + 1)) for (int rep_ = 0; rep_ < REPN(3); ++rep_) { if (rep_) xcd_barrier(bar); const Frame F = phase_frame(F0); unsigned char* wl = F.ws + WS_W + (size_t)l * W_LAYER;
            const int nx = NB * NCH - F.G > 0 && NB * NCH - F.G < F.G ? NB * NCH - F.G : 0;
            SchedQKV S{(const char*)(F.ws + WS_CQKV), (const char*)(wl + W_QB), (const char*)(wl + W_KVB), F.G - nx, F.bx >= nx ? F.bx - nx : (1 << 28), need_ctx};
            EpiQKV E{WSP(bf16_t, WS_QM), WSP(bf16_t, WS_KVM), WSP(const float, WS_SSP), WSP(const f32x2, WS_TAB32), CTLW(CW_KMAX + l * 256)};
            gemm_stream<640, 640, EpiQKV, SchedQKV>(F.lds, S, E);
            __syncthreads();
            for (int id = F.bx; id < NB * NCH; id += F.G) lru_unit<false>(F, l, id / NCH, id % NCH);
        }
        SEAM(pb + 1);
        STAMP(pb + 2);
        if (PM(4) && IN(pb + 2)) for (int rep_ = 0; rep_ < REPN(4); ++rep_) { if (rep_) xcd_barrier(bar); const Frame F = phase_frame(F0); phase_attn(F, l); }
#if MK_REPGRP
        if (grp_ == 0) continue; }
#endif
        SEAM(pb + 2);
        STAMP(pb + 3);
        if (PM(5) && IN(pb + 3)) for (int rep_ = 0; rep_ < REPN(5); ++rep_) { if (rep_) xcd_barrier(bar); const Frame F = phase_frame(F0); unsigned char* wl = F.ws + WS_W + (size_t)l * W_LAYER;
            SchedMerge S{(const char*)(F.ws + WS_H), (const char*)(F.ws + WS_QG), (const char*)(F.ws + WS_XM), (const char*)(wl + W_GATE), (const char*)(wl + W_BR), F.G, F.bx, need_ctx};
            EpiMerge E{WSP(bf16_t, WS_MERGED), (u32x4*)(F.ws + WS_STASH + (size_t)(F.bx & 255) * 131072), WSP(bf16_t, WS_PB)};
            gemm_stream<1024, 1024, EpiMerge, SchedMerge>(F.lds, S, E);
        }
        SEAM(pb + 3);
        STAMP(pb + 4);
        if (IN(pb + 4) && need_ctx) { const Frame F = phase_frame(F0); phase_ctxsum(F); }
        if (need_ctx) SEAM(pb + 4);
        STAMP(pb + 5);
        if (PM(6) && IN(pb + 5)) for (int rep_ = 0; rep_ < REPN(6); ++rep_) { if (rep_) xcd_barrier(bar); const Frame F = phase_frame(F0); unsigned char* wl = F.ws + WS_W + (size_t)l * W_LAYER;
            SchedOut S{(const char*)(F.ws + WS_MERGED), (const char*)(wl + W_OUT), F.G, F.bx, need_ctx};
            EpiOut E{WSP(float, WS_XC), F.out, WSP(const float, WS_MOD) + (size_t)l * 9 * 6 * D, WSP(float, WS_PB)};
            gemm_stream<1024, 1024, EpiOut, SchedOut>(F.lds, S, E);
        }
        SEAM(pb + 5);
        STAMP(pb + 6);
        if (PM(7) && IN(pb + 6)) for (int rep_ = 0; rep_ < REPN(7); ++rep_) { if (rep_) xcd_barrier(bar); const Frame F = phase_frame(F0); phase_router(F, l, l * 2 + rep_); }
        SEAM(pb + 6);
        STAMP(pb + 7);
        if (PM(9) && IN(pb + 7)) for (int rep_ = 0; rep_ < REPN(9); ++rep_) { if (rep_) xcd_barrier(bar); const Frame F = phase_frame(F0); unsigned char* wl = F.ws + WS_W + (size_t)l * W_LAYER;
            moe_offsets(F, CREG(l));
            SchedMoe S{(const char*)(F.ws + WS_H), (const char*)(wl + W_GU), WSP(const int, WS_ROWL), (const volatile LAS int*)(F.lds + LDS_MISC + 128), F.G, F.bx, 0};
            EpiMoe1 E{WSP(bf16_t, WS_ACT)};
            gemm_stream<1024, 1024, EpiMoe1, SchedMoe, true>(F.lds, S, E);
        }
        SEAM(pb + 7);
        STAMP(pb + 8);
        if (PM(10) && IN(pb + 8)) for (int rep_ = 0; rep_ < REPN(10); ++rep_) { if (rep_) xcd_barrier(bar); const Frame F = phase_frame(F0); unsigned char* wl = F.ws + WS_W + (size_t)l * W_LAYER;
            moe_offsets(F, CREG(l));
            SchedMoe S{(const char*)(F.ws + WS_ACT), (const char*)(wl + W_DN), nullptr, (const volatile LAS int*)(F.lds + LDS_MISC + 128), F.G, F.bx, 1};
            EpiMoe2 E{WSP(bf16_t, WS_Y)};
            gemm_stream<512, 512, EpiMoe2, SchedMoe>(F.lds, S, E);
        }
        SEAM(pb + 8);
        STAMP(pb + 9);
        if (PM(11) && IN(pb + 9)) for (int rep_ = 0; rep_ < REPN(11); ++rep_) { if (rep_) xcd_barrier(bar); const Frame F = phase_frame(F0); phase_rows<1>(F, l, rep_ + 1 < REPN(11)); }
        SEAM(pb + 9);
    }
    STAMP(NPHASE);
#ifdef MK_TIME_A
    if (F.bx == MK_TIME_BLK && F.tid == 0) { const unsigned long long dly = (unsigned long long)(misc[17] - misc[16]) * 8ull, t0 = __builtin_amdgcn_s_memrealtime(); while (__builtin_amdgcn_s_memrealtime() - t0 < dly) __builtin_amdgcn_s_sleep(16); }
#endif
#undef IN
#undef SEAM
}
}

extern "C" void kernel_launch(void* const* d_in, const int* in_sizes, int n_in, void* d_out, int out_size, void* d_ws, size_t ws_size, hipStream_t stream) {
    using namespace mk;
    static int grid = 0;
    if (grid == 0) {
        if (n_in != 32 || out_size != NB * SEQ * D || ws_size < WS_END) { fprintf(stderr, "kernel_launch: unexpected shapes (n_in %d out %d ws %zu, need %zu)\n", n_in, out_size, ws_size, (size_t)WS_END); grid = -1; return; }
        int dev = 0, cus = 0, per_cu = 0;
        if (hipGetDevice(&dev) != hipSuccess || hipDeviceGetAttribute(&cus, hipDeviceAttributeMultiprocessorCount, dev) != hipSuccess) { grid = -1; return; }
        if (hipFuncSetAttribute((const void*)mk_fwd, hipFuncAttributeMaxDynamicSharedMemorySize, LDS_BYTES) != hipSuccess) { fprintf(stderr, "kernel_launch: hipFuncSetAttribute failed\n"); grid = -1; return; }
        if (hipOccupancyMaxActiveBlocksPerMultiprocessor(&per_cu, (const void*)mk_fwd, NTHR, LDS_BYTES) != hipSuccess || per_cu < 1) { fprintf(stderr, "kernel_launch: occupancy query says %d\n", per_cu); per_cu = 1; }
        (void)hipGetLastError();
        grid = cus;
    }
    if (grid < 0) return;
    if (hipMemsetAsync((char*)d_ws + WS_CTL, 0, CTL_BYTES, stream) != hipSuccess) return;
#ifdef MK_DBG_ZERO
    (void)hipMemsetAsync((char*)d_ws + CTL_BYTES, 0, WS_END - CTL_BYTES, stream);
    (void)hipMemsetAsync(d_out, 0, (size_t)NB * SEQ * D * 4, stream);
#endif
    Args a{};
    for (int i = 0; i < 32; ++i) a.in[i] = (const float*)d_in[i];
    a.out = (float*)d_out; a.ws = (unsigned char*)d_ws;
#if defined(MK_DBG_DET)
    {
        unsigned char* ws = (unsigned char*)d_ws;
        unsigned long long* chk = (unsigned long long*)(ws + WS_CTL + 512 * 1024);
        unsigned long long* chkA = (unsigned long long*)(ws + WS_ROUTE + RT_END + 1024);
        auto CHK = [&](int p, const void* base, long rows, long pitch_b, long off_b, long width_b, const int* rowidx) {
            hipLaunchKernelGGL(mk::mkdbg::k_chk, dim3(1024), dim3(256), 0, stream, (const unsigned*)base, rows, pitch_b / 4, off_b / 4, width_b / 4, rowidx, chk + p); };
        const int* tslot = (const int*)(ws + WS_ROUTE + RT_SLOT);
        for (int run = 0; run < 2; ++run) {
            if (run == 1) { hipMemcpyAsync(chkA, chk, 32 * 8, hipMemcpyDeviceToDevice, stream); hipMemsetAsync((char*)d_ws + WS_CTL, 0, CTL_BYTES, stream); }
            for (int p = 0; p < 12; ++p) {
                a.ph_lo = p; a.ph_hi = p + 1; hipLaunchKernelGGL(mk_fwd, dim3(grid), dim3(NTHR), LDS_BYTES, stream, a);
                switch (p) {
                    case 0: CHK(p, ws + WS_MOD, 1, 0, 0, 2 * 9 * 6 * D * 4 + 64 * 16 * 8 + 64 * 8 * 8, nullptr); CHK(p, ws + WS_WLRU, 1, 0, 0, 512 * 1024, nullptr); CHK(p, ws + WS_W, 1, 0, 0, 2 * W_LAYER, nullptr); break;
                    case 1: case 6: case 11: CHK(p, ws + WS_XC, 1, 0, 0, (long)NB * CTXL * D * 4, nullptr); CHK(p, d_out, 1, 0, 0, (long)NB * SEQ * D * 4, nullptr); if (p != 6) CHK(p, ws + WS_H, 1, 0, 0, SZ_R1K, nullptr); break;
                    case 2: CHK(p, ws + WS_QG, 1, 0, 0, SZ_R1K, nullptr); CHK(p, ws + WS_XM, MALL, 2048, 0, 1024, nullptr); CHK(p, ws + WS_KB, 1, 0, 0, (long)MALL * 128 * 2 * 2, nullptr);
                            CHK(p, ws + WS_CQKV, 1, 0, 0, (long)MALL * 640 * 2, nullptr); CHK(p, ws + WS_KR, 1, 0, 0, (long)MALL * 32 * 2, nullptr); CHK(p, ws + WS_SSP, 1, 0, 0, (long)MALL * 20 * 4, nullptr); break;
                    case 3: CHK(p, ws + WS_QM, 1, 0, 0, (long)MALL * 768 * 2, nullptr); CHK(p, ws + WS_KVM, 1, 0, 0, SZ_R1K, nullptr); CHK(p, ws + WS_TOT, 1, 0, 0, (long)NB * 2 * NCH * 1024 * 4, nullptr); break;
                    case 4: CHK(p, ws + WS_QG, 1, 0, 0, SZ_R1K, nullptr); CHK(p, ws + WS_XM, MALL, 2048, 1024, 1024, nullptr); break;
                    case 5: CHK(p, ws + WS_MERGED, 1, 0, 0, SZ_R1K, nullptr); break;
                    case 7: CHK(p, ws + WS_H, 1, 0, 0, SZ_R1K, nullptr); CHK(p, ws + WS_ROUTE + RT_TE, 1, 0, 0, (long)MALL * 2 * 4 * 2, nullptr); break;
                    case 8: CHK(p, ws + WS_H2S, (long)MALL * 2, 2048, 0, 2048, tslot); CHK(p, ws + WS_ROUTE + RT_SLOTW, (long)MALL * 2, 4, 0, 4, tslot); break;
                    case 9: CHK(p, ws + WS_ACT, (long)MALL * 2, 1024, 0, 1024, tslot); break;
                    case 10: CHK(p, ws + WS_Y, (long)MALL * 2, 2048, 0, 2048, tslot); break;
                }
            }
        }
        hipLaunchKernelGGL(mk::mkdbg::k_verdict, dim3(1024), dim3(256), 0, stream, (const unsigned long long*)chkA, (const unsigned long long*)chk, 12, (float*)d_out, (long)NB * SEQ * D);
    }
#elif MK_PER_PHASE
    for (int p = 0; p < NPHASE; ++p) { a.ph_lo = p; a.ph_hi = p + 1; hipLaunchKernelGGL(mk_fwd, dim3(grid), dim3(NTHR), LDS_BYTES, stream, a); }
#else
    a.ph_lo = 0; a.ph_hi = NPHASE;
    hipLaunchKernelGGL(mk_fwd, dim3(grid), dim3(NTHR), LDS_BYTES, stream, a);
#endif
    const hipError_t le = hipPeekAtLastError();
    if (le != hipSuccess) fprintf(stderr, "kernel_launch: launch failed: %s\n", hipGetErrorName(le));
}
```

```cpp
#include <hip/hip_runtime.h>
#include <cstdio>
#include <cstdint>

#ifndef MK_PER_PHASE
#define MK_PER_PHASE 0
#endif

#ifndef MK_REP
#define MK_REP 0
#endif
#define CREG(l) ((l) * 2 + ((MK_REP >> 7) & 1))
namespace mk {
#define LAS __attribute__((address_space(3)))
#define GAS __attribute__((address_space(1)))
typedef unsigned short bf16_t;
typedef short bf16x8 __attribute__((ext_vector_type(8)));
typedef short s16x4 __attribute__((ext_vector_type(4)));
typedef float f32x4 __attribute__((ext_vector_type(4)));
typedef float f32x2 __attribute__((ext_vector_type(2)));
typedef float f32x16 __attribute__((ext_vector_type(16)));
typedef unsigned u32x4 __attribute__((ext_vector_type(4)));
typedef unsigned u32x2 __attribute__((ext_vector_type(2)));

constexpr int D = 1024, NB = 8, SEQ = 2048, CTXL = 256, TT = CTXL + SEQ, MALL = NB * TT, NRT = MALL / 256;
constexpr int DEPTH = 2, INW = 5536;
constexpr int OFF_Q = 0, OFF_K = 512, OFF_V = 640, OFF_X = 768, OFF_Y = 1280, OFF_CQ = 1792, OFF_CKV = 2176, OFF_KR = 2432, OFF_G = 2464;
constexpr float EPS = 1e-6f, LOG2E = 1.4426950408889634f;
constexpr float C2Q = 0.125f * LOG2E;
constexpr float C2M = 0.10206207261596575f * LOG2E;
constexpr int NWAVES = 8, NTHR = 512;
constexpr int MAXSLOT = 40960, MAXTILE = 160;
constexpr int NCH = TT / 64;

constexpr size_t MiB = 1u << 20;
constexpr size_t WS_CTL = 0, CTL_BYTES = 1 * MiB;
constexpr int CW_BAR = 1024;
constexpr int CW_KMAX = 12288;
constexpr int CW_CNT = 8192;
constexpr size_t WS_MOD = 1 * MiB;
constexpr size_t WS_TAB64 = WS_MOD + 2 * 9 * 6 * D * 4;
constexpr size_t WS_TAB32 = WS_TAB64 + 64 * 16 * 8;
constexpr size_t WS_RWT = WS_TAB32 + 64 * 8 * 8;
constexpr size_t WS_ROUTE = WS_RWT + 16 * 1024 * 4;
constexpr size_t RT_TE = 0, RT_TW = RT_TE + MALL * 2 * 4, RT_RANK = RT_TW + MALL * 2 * 4, RT_SLOT = RT_RANK + MALL * 2 * 4, RT_SLOTW = RT_SLOT + MALL * 2 * 4,
                 RT_TILEE = RT_SLOTW + MAXSLOT * 4, RT_END = RT_TILEE + 256 * 4;
static_assert(WS_ROUTE + RT_END <= 3 * MiB, "route");
constexpr size_t WS_WLRU = 3 * MiB;
constexpr size_t WS_TOT = WS_WLRU + MiB / 2;
constexpr size_t WS_XC = 6 * MiB;
constexpr size_t WS_SSP = 14 * MiB;
constexpr size_t WS_W = 16 * MiB;
constexpr size_t W_IN = 0, W_GATE = W_IN + 2560 * 1024 * 2, W_QB = W_GATE + 3072 * 1024 * 2, W_KVB = W_QB + 768 * 640 * 2, W_BR = W_KVB + 1024 * 640 * 2,
                 W_OUT = W_BR + 3 * 1024 * 1024 * 2, W_GU = W_OUT + 1024 * 1024 * 2, W_DN = W_GU + (size_t)16 * 1024 * 1024 * 2, W_LAYER = W_DN + (size_t)16 * 1024 * 512 * 2;
static_assert(W_LAYER % 256 == 0, "w");
constexpr size_t WS_ACT0 = WS_W + 2 * W_LAYER;
constexpr size_t SZ_R1K = (size_t)MALL * 1024 * 2;
constexpr size_t WS_H = WS_ACT0;
constexpr size_t WS_QG = WS_H + SZ_R1K;
constexpr size_t WS_XM = WS_QG + SZ_R1K;
constexpr size_t WS_KB = WS_XM + SZ_R1K;
constexpr size_t WS_VB = WS_KB + (size_t)MALL * 128 * 2;
constexpr size_t WS_CQKV = WS_VB + (size_t)MALL * 128 * 2;
constexpr size_t WS_KR = WS_CQKV + (size_t)MALL * 640 * 2;
constexpr size_t WS_QM = WS_KR + (size_t)MALL * 32 * 2;
constexpr size_t WS_KVM = WS_QM + (size_t)MALL * 768 * 2;
constexpr size_t WS_END = WS_KVM + SZ_R1K;
constexpr size_t WS_MERGED = WS_KVM;
constexpr size_t WS_STASH = WS_CQKV;
static_assert(WS_STASH + (size_t)256 * 131072 <= WS_KVM, "stash");
constexpr size_t WS_PB = WS_QM + 16 * MiB;
static_assert(WS_PB >= WS_STASH + (size_t)256 * 131072 && WS_PB + (size_t)2 * 2048 * 1024 * 2 <= WS_KVM, "pb");
constexpr size_t WS_ROWL = WS_XM;
constexpr size_t WS_Y = WS_QG;
static_assert(WS_Y + (size_t)MAXSLOT * 1024 * 2 <= WS_CQKV, "y");
static_assert((size_t)16 * MALL * 4 <= SZ_R1K, "rowlist");
constexpr size_t WS_ACT = WS_CQKV;
static_assert(WS_ACT + (size_t)MAXSLOT * 512 * 2 <= WS_KVM, "act");
static_assert(WS_END <= (size_t)380 * MiB, "workspace must fit in sum(inputs) = 380.7 MiB");

constexpr int LDS_STAGE = 131072;
constexpr int LDS_MISC = 133120;
constexpr int LDS_BYTES = LDS_MISC + 512;

typedef __bf16 bf16x2v __attribute__((ext_vector_type(2)));
__device__ __forceinline__ unsigned cvt_pk_bf16(float lo, float hi) { const f32x2 v = {lo, hi}; const bf16x2v b = __builtin_convertvector(v, bf16x2v); return __builtin_bit_cast(unsigned, b); }
__device__ __forceinline__ float bf2f(unsigned short b) { return __uint_as_float(((unsigned)b) << 16); }
__device__ __forceinline__ float bflo(unsigned w) { return __uint_as_float(w << 16); }
__device__ __forceinline__ float bfhi(unsigned w) { return __uint_as_float(w & 0xffff0000u); }
__device__ __forceinline__ float fast_exp2(float x) { return __builtin_amdgcn_exp2f(x); }
__device__ __forceinline__ float fast_rcp(float x) { return __builtin_amdgcn_rcpf(x); }
__device__ __forceinline__ float sigmoid_f(float x) { return fast_rcp(1.f + fast_exp2(-LOG2E * x)); }
__device__ __forceinline__ float silu_f(float x) { return x * sigmoid_f(x); }
__device__ __forceinline__ float gelu_tanh_f(float x) {
    const float u = 0.7978845608028654f * (x + 0.044715f * x * x * x);
    return x * sigmoid_f(2.f * u);
}
template <int CTRL> __device__ __forceinline__ float dpp_mov(float v) { return __uint_as_float((unsigned)__builtin_amdgcn_update_dpp(0, (int)__float_as_uint(v), CTRL, 0xF, 0xF, true)); }
__device__ __forceinline__ float wave_sum(float v) {
    v += dpp_mov<0xB1>(v); v += dpp_mov<0x4E>(v); v += dpp_mov<0x141>(v); v += dpp_mov<0x140>(v);
    const unsigned u = __float_as_uint(v);
    return (__uint_as_float(__builtin_amdgcn_readlane(u, 0)) + __uint_as_float(__builtin_amdgcn_readlane(u, 16))) + (__uint_as_float(__builtin_amdgcn_readlane(u, 32)) + __uint_as_float(__builtin_amdgcn_readlane(u, 48)));
}
__device__ __forceinline__ u32x4 pack8(f32x4 a, f32x4 b) { u32x4 w; w.x = cvt_pk_bf16(a[0], a[1]); w.y = cvt_pk_bf16(a[2], a[3]); w.z = cvt_pk_bf16(b[0], b[1]); w.w = cvt_pk_bf16(b[2], b[3]); return w; }

#define SBAR() __builtin_amdgcn_sched_barrier(0)
template <class T> __device__ __forceinline__ T* opaque_p(T* p) { asm volatile("" : "+s"(p)); return p; }
__device__ __forceinline__ unsigned opaque_s(unsigned x) { asm volatile("" : "+s"(x)); return x; }
__device__ __forceinline__ int opaque(int x) { asm volatile("" : "+v"(x)); return x; }
__device__ __forceinline__ u32x4 ld16_sc1(const void* p) {
    const unsigned long long* q = (const unsigned long long*)p;
    const unsigned long long a = __hip_atomic_load(q, __ATOMIC_RELAXED, __HIP_MEMORY_SCOPE_AGENT), b = __hip_atomic_load(q + 1, __ATOMIC_RELAXED, __HIP_MEMORY_SCOPE_AGENT);
    return (u32x4){(unsigned)a, (unsigned)(a >> 32), (unsigned)b, (unsigned)(b >> 32)};
}
#define XB_TMO      128
#define XB_XCNT(j)  (256  + 64 * (j))
#define XB_XSUB(j)  (1280 + 64 * (j))
#define XB_XGEN(j)  (2304 + 64 * (j))
#define XB_TOP      3328
#define XB_TOPGEN   3392
#define XCD_BAR_WORDS 3456
#define XB_SPIN_CAP (1u << 18)
__device__ __forceinline__ unsigned xb_ld(unsigned* p)              { return __hip_atomic_load(p, __ATOMIC_RELAXED, __HIP_MEMORY_SCOPE_AGENT); }
__device__ __forceinline__ unsigned xb_add(unsigned* p, unsigned v) { return __hip_atomic_fetch_add(p, v, __ATOMIC_RELAXED, __HIP_MEMORY_SCOPE_AGENT); }
__device__ __forceinline__ unsigned xb_xcc_id() { return (unsigned)__builtin_amdgcn_s_getreg((3 << 11) | 20) & 0xFu; }
#define XB_SPIN(cond, bar) do { unsigned _sp = 0; while (cond) { __builtin_amdgcn_s_sleep(1); \
    if ((++_sp & 255u) == 0u) { if (xb_ld(&(bar)[XB_TMO])) break; if (_sp > XB_SPIN_CAP) { atomicAdd(&(bar)[XB_TMO], 1u); break; } } } } while (0)
struct XcdBarrier { unsigned* bar; unsigned x; volatile LAS unsigned* st; };
__device__ __forceinline__ XcdBarrier xcd_barrier_post(unsigned* bar, volatile LAS unsigned* st) {
    XcdBarrier b; b.bar = bar; b.x = xb_xcc_id(); b.st = st;
    if (threadIdx.x == 0) (void)xb_add(&bar[XB_XCNT(b.x)], 1u);
    return b;
}
__device__ __forceinline__ void xcd_barrier_complete(unsigned* bar, unsigned x, unsigned& nloc, unsigned& nx) {
    const unsigned G = gridDim.x * gridDim.y * gridDim.z;
    unsigned sum, cnt, mine, sp = 0u;
    for (;;) {
        sum = 0u; cnt = 0u; mine = 0u;
#pragma unroll
        for (unsigned j = 0; j < 16; ++j) { const unsigned c = xb_ld(&bar[XB_XCNT(j)]); sum += c; cnt += (c > 0u) ? 1u : 0u; mine = (j == x) ? c : mine; }
        if (sum == G) break;
        __builtin_amdgcn_s_sleep(1);
        if ((++sp & 255u) == 0u) { if (xb_ld(&bar[XB_TMO])) break; if (sp > XB_SPIN_CAP) { atomicAdd(&bar[XB_TMO], 1u); break; } }
    }
    nloc = mine > 0u ? mine : 1u; nx = cnt > 0u ? cnt : 1u;
}
__device__ __forceinline__ void xcd_barrier(const XcdBarrier& b) {
    asm volatile("s_waitcnt vmcnt(0)" ::: "memory");
    __syncthreads();
    if (threadIdx.x == 0) {
        unsigned* bar = opaque_p(b.bar);
        __builtin_amdgcn_s_waitcnt(0);
        const unsigned bx_ = opaque_s(b.x);
        unsigned nloc = b.st[0], nx = b.st[1];
        if (nloc == 0u) { xcd_barrier_complete(bar, bx_, nloc, nx); b.st[0] = nloc; b.st[1] = nx; }
        const unsigned old = xb_add(&bar[XB_XSUB(bx_)], 1u);
        const unsigned gen = old / nloc;
        if (old + 1u == (gen + 1u) * nloc) {
            __builtin_amdgcn_fence(__ATOMIC_RELEASE, "agent");
            asm volatile("s_waitcnt vmcnt(0)" ::: "memory");
            const unsigned og = xb_add(&bar[XB_TOP], 1u);
            const unsigned tg = og / nx;
            if (og + 1u == (tg + 1u) * nx) xb_add(&bar[XB_TOPGEN], 1u);
            else XB_SPIN(xb_ld(&bar[XB_TOPGEN]) == tg, bar);
            __builtin_amdgcn_fence(__ATOMIC_ACQUIRE, "agent");
            xb_add(&bar[XB_XGEN(bx_)], 1u);
            asm volatile("s_waitcnt vmcnt(0)" ::: "memory");
        } else {
            XB_SPIN(xb_ld(&bar[XB_XGEN(bx_)]) == gen, bar);
            __builtin_amdgcn_fence(__ATOMIC_ACQUIRE, "agent");
            asm volatile("s_waitcnt vmcnt(0)" ::: "memory");
        }
    }
    __syncthreads();
}

constexpr int BM = 256, BK = 64, HALF = 128, HTB = HALF * BK * 2, STAGE_BYTES = 8 * HTB, NXCD = 8, WGM = 8;
__host__ __device__ __forceinline__ int lds_byte(int r, int c) { const int st = (r >> 4) * 2 + (c >> 5), rr = r & 15, cc = c & 31, ob = rr * 64 + cc * 2; return st * 1024 + (ob ^ (((ob >> 9) & 1) << 5)); }
__host__ __device__ __forceinline__ void stage_rc(int b, int& R, int& C) { const int st = b / 1024, sb = b % 1024, swz = sb ^ (((sb >> 9) & 1) << 5); R = (st >> 1) * 16 + swz / 64; C = (st & 1) * 32 + (swz % 64) / 2; }
__host__ __device__ __forceinline__ int perm32(int rho) { const int n = rho >> 4, i = rho & 15; return 8 * (i >> 2) + 4 * n + (i & 3); }

struct Unit { const char* A; const char* B; int nt; int pm, pn, kind; const int* rows; int nvalid; };

__device__ __forceinline__ void rect_order(int L, int nM, int nN, int& im, int& in_) {
    const int nwg = nM * nN;
    int wgid = L; { const int q = nwg / NXCD, r = nwg % NXCD, xcd = wgid % NXCD, off = wgid / NXCD; wgid = (xcd < r ? xcd * (q + 1) : r * (q + 1) + (xcd - r) * q) + off; }
    const int nig = WGM * nN, gid = wgid / nig, fm = gid * WGM, gsz = (nM - fm) < WGM ? (nM - fm) : WGM;
    im = fm + ((wgid % nig) % gsz); in_ = (wgid % nig) / gsz;
}

template <int PA, int PB, class Epi, class Sched, bool GATHER = false>
__device__ __forceinline__ void gemm_stream(LAS unsigned char* lds, const Sched& S, const Epi& E) {
    const int tid = opaque(threadIdx.x), wid = __builtin_amdgcn_readfirstlane(tid >> 6), lane = tid & 63, wr = wid >> 2, wc = wid & 3, fr = lane & 15, fq = lane >> 4;
    unsigned voffA[2], voffB[2];
#pragma unroll
    for (int i = 0; i < 2; ++i) { int R, C; stage_rc(tid * 16 + i * 8192, R, C); const int Rb = Epi::PERM ? ((R & ~31) + perm32(R & 31)) : R;
        voffA[i] = (unsigned)(R * PA + C) * 2u; voffB[i] = (unsigned)(Rb * PB + C) * 2u; }
    constexpr size_t kstep = (size_t)(BK * 2);
    constexpr size_t hstepA = (size_t)HALF * PA * 2, hstepB = (size_t)HALF * PB * 2;
    const unsigned ldsw = (unsigned)wid * 1024u;
    const int aoff = lds_byte(wr * 64 + fr, fq * 8), boff = lds_byte(wc * 32 + fr, fq * 8);
#define G_SA(b, h) (((b) * 2 + (h)) * HTB)
#define G_SB(b, h) ((4 + (b) * 2 + (h)) * HTB)
#define G_STAGE(bufoff, gbase, voff) do { _Pragma("unroll") for (int _i = 0; _i < 2; ++_i) \
        __builtin_amdgcn_global_load_lds((const unsigned*)((const char*)(gbase) + (voff)[_i]), (LAS unsigned*)(lds + (bufoff) + ldsw + _i * 8192), 16, 0, 0); } while (0)
    unsigned gc[2][2], gn[2][2];
#define G_GOFF(U, G) do { int R_, C_; stage_rc(tid * 16, R_, C_); _Pragma("unroll") for (int h_ = 0; h_ < 2; ++h_) _Pragma("unroll") for (int i_ = 0; i_ < 2; ++i_) { \
        const int ix_ = h_ * 128 + R_ + 64 * i_; const int tk_ = ix_ < (U).nvalid ? ((U).rows[ix_] >> 1) : 0; (G)[h_][i_] = (unsigned)tk_ * (unsigned)(PA * 2) + (unsigned)(C_ * 2); } } while (0)
#define G_STAGEG(bufoff, gbase, g0, g1) do { \
        __builtin_amdgcn_global_load_lds((const unsigned*)((const char*)(gbase) + (g0)), (LAS unsigned*)(lds + (bufoff) + ldsw), 16, 0, 0); \
        __builtin_amdgcn_global_load_lds((const unsigned*)((const char*)(gbase) + (g1)), (LAS unsigned*)(lds + (bufoff) + ldsw + 8192), 16, 0, 0); } while (0)
#define G_STAGEA(bufoff, gbase, h, nx) do { if constexpr (GATHER) { const unsigned o0_ = (nx) ? gn[h][0] : gc[h][0], o1_ = (nx) ? gn[h][1] : gc[h][1]; G_STAGEG(bufoff, gbase, o0_, o1_); } \
        else G_STAGE(bufoff, (gbase) + (h) * hstepA, voffA); } while (0)
#define G_LDA(dst, b, h) do { _Pragma("unroll") for (int m = 0; m < 4; ++m) _Pragma("unroll") for (int k = 0; k < 2; ++k) dst[m][k] = *(const LAS bf16x8*)(lds + G_SA(b, h) + aoff + m * 2048 + k * 1024); } while (0)
#define G_LDB(dst, b, h) do { _Pragma("unroll") for (int n = 0; n < 2; ++n) _Pragma("unroll") for (int k = 0; k < 2; ++k) dst[n][k] = *(const LAS bf16x8*)(lds + G_SB(b, h) + boff + n * 2048 + k * 1024); } while (0)
#define G_MMA(ai, bj, At, Bt) do { __builtin_amdgcn_s_setprio(1); _Pragma("unroll") for (int m = 0; m < 4; ++m) _Pragma("unroll") for (int n = 0; n < 2; ++n) _Pragma("unroll") for (int k = 0; k < 2; ++k) \
        acc[ai][bj][m][n] = __builtin_amdgcn_mfma_f32_16x16x32_bf16(Bt[n][k], At[m][k], acc[ai][bj][m][n], 0, 0, 0); __builtin_amdgcn_s_setprio(0); } while (0)
#define G_WAIT_V(n) asm volatile("s_waitcnt vmcnt(" #n ")" ::: "memory")
#define G_WAIT_L(n) asm volatile("s_waitcnt lgkmcnt(" #n ")" ::: "memory")
#define G_BAR __builtin_amdgcn_s_barrier()
#define G_SCHED __builtin_amdgcn_sched_barrier(0)
    Unit cur, nxt; int ui = 0;
    if (!S.next(0, cur)) return;
    f32x4 acc[2][2][4][2];
#pragma unroll
    for (int a = 0; a < 2; ++a)
#pragma unroll
        for (int b = 0; b < 2; ++b)
#pragma unroll
            for (int m = 0; m < 4; ++m)
#pragma unroll
                for (int n = 0; n < 2; ++n) acc[a][b][m][n] = (f32x4){0.f, 0.f, 0.f, 0.f};
    bf16x8 At[4][2], B0[2][2], B1[2][2];
    const char* cA = cur.A; const char* cB = cur.B;
    if constexpr (GATHER) { G_GOFF(cur, gc); _Pragma("unroll") for (int h_ = 0; h_ < 2; ++h_) _Pragma("unroll") for (int i_ = 0; i_ < 2; ++i_) gn[h_][i_] = gc[h_][i_]; }
    G_STAGE(G_SB(0, 0), cB, voffB); G_STAGE(G_SB(0, 1), cB + hstepB, voffB); G_STAGEA(G_SA(0, 0), cA, 0, false); G_STAGEA(G_SA(0, 1), cA, 1, false);
    if (wr == 1) G_BAR;
    G_WAIT_V(2); G_BAR;
    G_STAGE(G_SB(1, 0), cB + kstep, voffB); G_STAGEA(G_SA(1, 0), cA + kstep, 0, false); G_STAGE(G_SB(1, 1), cB + hstepB + kstep, voffB);
    G_WAIT_V(6); G_BAR;
    for (;;) {
        const bool has_next = S.next(ui + 1, nxt);
        const char* nA = has_next ? nxt.A : cA; const char* nB = has_next ? nxt.B : cB;
        if constexpr (GATHER) { if (has_next) G_GOFF(nxt, gn); }
        const int nt = cur.nt;
        for (int t = 0; t < nt; t += 2) {
            const bool last = (t == nt - 2);
            const char* a1 = cA + (size_t)(t + 1) * kstep;
            const char* a2 = last ? nA : cA + (size_t)(t + 2) * kstep; const char* b2 = last ? nB : cB + (size_t)(t + 2) * kstep;
            const char* a3 = a2 + kstep; const char* b3 = b2 + kstep;
            G_LDB(B0, 0, 0); G_LDB(B1, 0, 1); G_SCHED; G_LDA(At, 0, 0); G_STAGEA(G_SA(1, 1), a1, 1, false);
            G_WAIT_V(8); G_WAIT_L(0); G_BAR; G_MMA(0, 0, At, B0); G_MMA(0, 1, At, B1); G_BAR; G_SCHED;
            G_LDA(At, 0, 1); G_STAGE(G_SB(0, 0), b2, voffB); G_STAGE(G_SB(0, 1), b2 + hstepB, voffB); G_STAGEA(G_SA(0, 0), a2, 0, last);
            G_WAIT_V(8); G_WAIT_L(0); G_BAR; G_MMA(1, 0, At, B0); G_MMA(1, 1, At, B1); G_BAR; G_SCHED;
            G_LDB(B0, 1, 0); G_LDB(B1, 1, 1); G_SCHED; G_LDA(At, 1, 0); G_STAGEA(G_SA(0, 1), a2, 1, last);
            G_WAIT_V(8); G_WAIT_L(0); G_BAR; G_MMA(0, 0, At, B0); G_MMA(0, 1, At, B1); G_BAR; G_SCHED;
            G_LDA(At, 1, 1); G_STAGE(G_SB(1, 0), b3, voffB); G_STAGE(G_SB(1, 1), b3 + hstepB, voffB); G_STAGEA(G_SA(1, 0), a3, 0, last);
            G_WAIT_V(8); G_WAIT_L(0); G_BAR; G_MMA(1, 0, At, B0); G_MMA(1, 1, At, B1); G_BAR; G_SCHED;
        }
        if (wr == 0) G_BAR;
        E(acc, cur, wr, wc, fr, fq);
        if (!has_next) break;
#pragma unroll
        for (int a = 0; a < 2; ++a)
#pragma unroll
            for (int b = 0; b < 2; ++b)
#pragma unroll
                for (int m = 0; m < 4; ++m)
#pragma unroll
                    for (int n = 0; n < 2; ++n) acc[a][b][m][n] = (f32x4){0.f, 0.f, 0.f, 0.f};
        cur = nxt; cA = nA; cB = nB; ++ui;
        if constexpr (GATHER) { _Pragma("unroll") for (int h_ = 0; h_ < 2; ++h_) _Pragma("unroll") for (int i_ = 0; i_ < 2; ++i_) gc[h_][i_] = gn[h_][i_]; }
        if (wr == 1) G_BAR;
    }
    G_WAIT_V(0);
    G_BAR;
#undef G_SA
#undef G_SB
#undef G_STAGE
#undef G_LDA
#undef G_GOFF
#undef G_STAGEG
#undef G_STAGEA
#undef G_LDB
#undef G_MMA
#undef G_WAIT_V
#undef G_WAIT_L
#undef G_BAR
#undef G_SCHED
}

struct Args { const float* in[32]; float* out; unsigned char* ws; int ph_lo, ph_hi; };
enum { I_X = 0, I_C, I_CTX, I_CCTX, I_WMOD, I_BMOD, I_NMIX, I_NFFN, I_WIN, I_GQN, I_GKN, I_CONVW, I_CONVB, I_LWA, I_LBA, I_LWI, I_LBI, I_LLAM,
       I_MQN, I_WQB, I_MKVN, I_WKVB, I_WBA, I_WBL, I_WBM, I_WOUT, I_RW, I_RB, I_MG, I_MU, I_MD, I_FN };
struct Frame {
    LAS unsigned char* lds; unsigned char* ws; const float* const* in; float* out;
    int tid, lane, wave, G, bx;
};
__device__ __forceinline__ Frame phase_frame(const Frame& F) { Frame P = F; P.bx = (int)opaque_s((unsigned)F.bx); return P; }
#define WSP(T, off) ((T*)(F.ws + (off)))
#define CTLW(idx) (((unsigned*)(F.ws + WS_CTL)) + (idx))
__device__ __forceinline__ float* xrow_ptr(const Frame& F, int r) {
    const int b = r / TT, t = r - b * TT;
    return t < CTXL ? WSP(float, WS_XC) + ((size_t)b * CTXL + t) * D : F.out + ((size_t)b * SEQ + (t - CTXL)) * D;
}
__device__ __forceinline__ const float* mod_ptr(const Frame& F, int l, int r, int which) {
    const int b = r / TT, t = r - b * TT; const int mr = t < CTXL ? 8 : b;
    return WSP(const float, WS_MOD) + ((size_t)(l * 9 + mr) * 6 + which) * D;
}

__device__ __forceinline__ int src_col_in(int p) {
    const int tile = p >> 8, q = p & 255, bj = q >> 7, wc = (q >> 5) & 3, s = q & 31, fq = s >> 3, n = (s >> 2) & 1, j = s & 3;
    const int hd = 32 * bj + 16 * n + 4 * fq + j;
    switch (tile) {
        case 0: case 1: return OFF_Q + (4 * tile + wc) * 64 + hd;
        case 2: return wc < 2 ? OFF_K + wc * 64 + hd : OFF_V + (wc - 2) * 64 + 32 * bj + s;
        case 3: case 4: return OFF_X + (tile - 3) * 256 + q;
        case 5: case 6: return OFF_Y + (tile - 5) * 256 + q;
        case 7: return OFF_CQ + q;
        case 8: return q < 128 ? OFF_CQ + 256 + q : OFF_CKV + (q - 128);
        default: if (q < 128) return OFF_CKV + 128 + q;
                 if (q < 160) return OFF_KR + 16 * n + 8 * (j >> 1) + 2 * fq + (j & 1);
                 return -1;
    }
}
__device__ __forceinline__ int rope32_dim(int s) { const int fq = s >> 3, n = (s >> 2) & 1, j = s & 3; return 16 * n + 8 * (j >> 1) + 2 * fq + (j & 1); }

struct WMat { int rows, K, pitch, nkb, items; };
struct WItem { const float* src; const float* ksc; bf16_t* dst; int ld, pitch, p0, k0, col; };
__device__ __forceinline__ WItem p0_item(const Frame& F, int it, int pl) {
    constexpr int NI_IN = 40 * 8, NI_GATE = 48 * 8, NI_QB = 12 * 3, NI_KVB = 16 * 2, NI_BR = 3 * 16 * 4, NI_OUT = 16 * 8, NI_GU = 256 * 8, NI_DN = 256 * 4;
    constexpr int NI_L = NI_IN + NI_GATE + NI_QB + NI_KVB + NI_BR + NI_OUT + NI_GU + NI_DN;
    WItem I;
    const int l = it / NI_L; int r = it - l * NI_L;
    const float* src; int ld, pitch, nkb, nrb; bf16_t* dst; int kind; const float* ksc = nullptr;
    unsigned char* wl = F.ws + WS_W + (size_t)l * W_LAYER;
    if (r < NI_IN) { kind = 0; src = F.in[I_WIN] + (size_t)l * D * INW; ld = INW; pitch = 1024; nkb = 8; nrb = 40; dst = (bf16_t*)(wl + W_IN); }
    else if ((r -= NI_IN) < NI_GATE) { kind = 1; src = F.in[I_WIN] + (size_t)l * D * INW; ld = INW; pitch = 1024; nkb = 8; nrb = 48; dst = (bf16_t*)(wl + W_GATE); }
    else if ((r -= NI_GATE) < NI_QB) { kind = 2; src = F.in[I_WQB] + (size_t)l * 384 * 768; ld = 768; pitch = 640; nkb = 3; nrb = 12; dst = (bf16_t*)(wl + W_QB); ksc = F.in[I_MQN] + l * 384; }
    else if ((r -= NI_QB) < NI_KVB) { kind = 3; src = F.in[I_WKVB] + (size_t)l * 256 * 1024; ld = 1024; pitch = 640; nkb = 2; nrb = 16; dst = (bf16_t*)(wl + W_KVB); ksc = F.in[I_MKVN] + l * 256; }
    else if ((r -= NI_KVB) < NI_BR) { kind = 4; const int b = r / 64; r -= b * 64; src = F.in[I_WBA + b] + (size_t)l * 512 * D; ld = D; pitch = 1024; nkb = 4; nrb = 16; dst = (bf16_t*)(wl + W_BR) + (size_t)b * 1024 * 1024; }
    else if ((r -= NI_BR) < NI_OUT) { kind = 5; src = F.in[I_WOUT] + (size_t)l * D * D; ld = D; pitch = 1024; nkb = 8; nrb = 16; dst = (bf16_t*)(wl + W_OUT); }
    else if ((r -= NI_OUT) < NI_GU) { kind = 6; src = nullptr; ld = 512; pitch = 1024; nkb = 8; nrb = 256; dst = (bf16_t*)(wl + W_GU); }
    else { r -= NI_GU; kind = 7; src = nullptr; ld = D; pitch = 512; nkb = 4; nrb = 256; dst = (bf16_t*)(wl + W_DN); }
    (void)nkb;
    const int kb = r / nrb, rb = r - kb * nrb, p0 = rb * 64, k0 = kb * 128, p = p0 + pl;
    int col;
    switch (kind) {
        case 0: col = src_col_in(p); break;
        case 1: col = OFF_G + p; break;
        case 2: col = p < 512 ? (p >> 6) * 96 + (p & 63) : (4 * (((p - 512) >> 7)) + (((p - 512) >> 5) & 3)) * 96 + 64 + rope32_dim((p - 512) & 31); break;
        case 3: col = p < 512 ? (p >> 6) * 128 + (p & 63) : ((p - 512) >> 6) * 128 + 64 + ((p - 512) & 63); break;
        case 6: { const int e = p >> 10, pp = p & 1023, t4 = pp >> 8, q = pp & 255;
                  src = F.in[q < 128 ? I_MG : I_MU] + ((size_t)l * 16 + e) * D * 512; col = t4 * 128 + (q & 127); } break;
        case 7: { const int e = p >> 10; src = F.in[I_MD] + ((size_t)l * 16 + e) * 512 * D; col = p & 1023; } break;
        default: col = p; break;
    }
    I.src = src; I.ksc = ksc; I.dst = dst; I.ld = ld; I.pitch = pitch; I.p0 = p0; I.k0 = k0; I.col = col;
    return I;
}
__device__ __forceinline__ void p0_weights(const Frame& F) {
    constexpr int NI_IN = 40 * 8, NI_GATE = 48 * 8, NI_QB = 12 * 3, NI_KVB = 16 * 2, NI_BR = 3 * 16 * 4, NI_OUT = 16 * 8, NI_GU = 256 * 8, NI_DN = 256 * 4;
    constexpr int NI_L = NI_IN + NI_GATE + NI_QB + NI_KVB + NI_BR + NI_OUT + NI_GU + NI_DN, NI_S = NI_QB + NI_KVB, NI_M = NI_L - NI_S;
    const int tid_ = opaque(F.tid); const int pl = tid_ & 63, kg = tid_ >> 6;
    {
        int it = F.bx, buf = 0; bool have = false, first = true;
        WItem cur = p0_item(F, 0, pl);
        float v[16];
#pragma unroll
        for (int i = 0; i < 16; ++i) v[i] = 0.f;
#pragma unroll 1
        for (;;) {
            const bool more = it < 2 * NI_M;
            if (!have && !more) break;
            LAS unsigned char* tile = F.lds + buf * (64 * 272);
            if (have) {
                u32x4 w0, w1;
#define P0_CONSUME(N) asm volatile("s_waitcnt vmcnt(" #N ")\n\tv_cvt_pk_bf16_f32 %0, %8, %9\n\tv_cvt_pk_bf16_f32 %1, %10, %11\n\tv_cvt_pk_bf16_f32 %2, %12, %13\n\tv_cvt_pk_bf16_f32 %3, %14, %15\n\t" \
                    "v_cvt_pk_bf16_f32 %4, %16, %17\n\tv_cvt_pk_bf16_f32 %5, %18, %19\n\tv_cvt_pk_bf16_f32 %6, %20, %21\n\tv_cvt_pk_bf16_f32 %7, %22, %23" \
                    : "=&v"(w0.x), "=&v"(w0.y), "=&v"(w0.z), "=&v"(w0.w), "=&v"(w1.x), "=&v"(w1.y), "=&v"(w1.z), "=&v"(w1.w) \
                    : "v"(v[0]), "v"(v[1]), "v"(v[2]), "v"(v[3]), "v"(v[4]), "v"(v[5]), "v"(v[6]), "v"(v[7]), "v"(v[8]), "v"(v[9]), "v"(v[10]), "v"(v[11]), "v"(v[12]), "v"(v[13]), "v"(v[14]), "v"(v[15]) : "memory")
                if (first) P0_CONSUME(0); else P0_CONSUME(2);
#undef P0_CONSUME
                first = false;
                if (cur.col < 0) { w0 = (u32x4){0u, 0u, 0u, 0u}; w1 = (u32x4){0u, 0u, 0u, 0u}; }
                *(LAS u32x4*)(tile + pl * 272 + kg * 32) = w0; *(LAS u32x4*)(tile + pl * 272 + kg * 32 + 16) = w1;
            }
            WItem nxt = cur;
            if (more) {
                const int l_ = it / NI_M, rr_ = it - l_ * NI_M;
                nxt = p0_item(F, l_ * NI_L + (rr_ < NI_IN + NI_GATE ? rr_ : rr_ + NI_S), pl);
                const float* sp_ = nxt.src + (size_t)(nxt.k0 + kg * 16) * nxt.ld + (nxt.col >= 0 ? nxt.col : 0);
#pragma unroll
                for (int i = 0; i < 16; ++i) { const float* q_ = sp_ + (size_t)i * nxt.ld; asm volatile("global_load_dword %0, %1, off" : "=v"(v[i]) : "v"(q_) : "memory"); }
            }
            __syncthreads();
            if (have) {
#pragma unroll
                for (int i = 0; i < 2; ++i) { const int id = tid_ + i * 512, row = id >> 4, ch = id & 15;
                    *(u32x4*)(cur.dst + (size_t)(cur.p0 + row) * cur.pitch + cur.k0 + ch * 8) = *(LAS u32x4*)(tile + row * 272 + ch * 16); }
                buf ^= 1;
            }
            have = more; cur = nxt; it += F.G;
        }
        asm volatile("s_waitcnt vmcnt(0)" ::: "memory");
    }
    __syncthreads();
    for (int i2 = F.bx; i2 < 2 * NI_S; i2 += F.G) {
        const int l_ = i2 / NI_S; const WItem I = p0_item(F, l_ * NI_L + NI_IN + NI_GATE + (i2 - l_ * NI_S), pl);
        LAS unsigned char* tile = F.lds;
        float v[16];
#pragma unroll
        for (int i = 0; i < 16; ++i) { const int k = I.k0 + kg * 16 + i; v[i] = I.src[(size_t)k * I.ld + I.col] * I.ksc[k]; }
        u32x4 w0, w1;
        w0.x = cvt_pk_bf16(v[0], v[1]); w0.y = cvt_pk_bf16(v[2], v[3]); w0.z = cvt_pk_bf16(v[4], v[5]); w0.w = cvt_pk_bf16(v[6], v[7]);
        w1.x = cvt_pk_bf16(v[8], v[9]); w1.y = cvt_pk_bf16(v[10], v[11]); w1.z = cvt_pk_bf16(v[12], v[13]); w1.w = cvt_pk_bf16(v[14], v[15]);
        *(LAS u32x4*)(tile + pl * 272 + kg * 32) = w0; *(LAS u32x4*)(tile + pl * 272 + kg * 32 + 16) = w1;
        __syncthreads();
#pragma unroll
        for (int i = 0; i < 2; ++i) { const int id = tid_ + i * 512, row = id >> 4, ch = id & 15;
            *(u32x4*)(I.dst + (size_t)(I.p0 + row) * I.pitch + I.k0 + ch * 8) = *(LAS u32x4*)(tile + row * 272 + ch * 16); }
        __syncthreads();
    }
}
__device__ __forceinline__ void p0_misc(const Frame& F) {
    const int gt = F.bx * NTHR + opaque(F.tid), GT = F.G * NTHR;
    bf16_t* wl = WSP(bf16_t, WS_WLRU);
    for (int i = gt; i < 2 * 2 * 2 * 8 * 64 * 64; i += GT) {
        const int k = i & 63, j = (i >> 6) & 63, n = (i >> 12) & 7, g = (i >> 15) & 1, d = (i >> 16) & 1, l = i >> 17;
        const float x = F.in[g ? I_LWI : I_LWA][((((size_t)(l * 2 + d) * 8 + n) * 64 + k) * 64) + j];
        wl[i] = (bf16_t)(cvt_pk_bf16(x, 0.f) & 0xffffu);
    }
    { float* rwt = WSP(float, WS_RWT); for (int i = gt; i < 16 * 1024; i += GT) { const int e = i >> 10, k = i & 1023; rwt[i] = F.in[I_RW][k * 16 + e]; } }
    f32x2* t64 = WSP(f32x2, WS_TAB64); f32x2* t32 = WSP(f32x2, WS_TAB32);
    for (int i = gt; i < 64 * 16 + 64 * 8; i += GT) {
        if (i < 1024) { const int p = i >> 4, q = i & 15; const float a = (float)p * exp2f(-13.287712379549449f * (float)q / 16.f); t64[i] = (f32x2){cosf(a), sinf(a)}; }
        else { const int ii = i - 1024, p = ii >> 3, q = ii & 7; const float a = (float)p * exp2f(-13.287712379549449f * (float)q / 8.f); t32[ii] = (f32x2){cosf(a), sinf(a)}; }
    }
}
__device__ __forceinline__ void p0_mod(const Frame& F) {
    LAS float* sv = (LAS float*)F.lds;
    LAS float* red = (LAS float*)(F.lds + 9 * 1024 * 4);
    if (F.bx >= 192) return;
    const int tid = opaque(F.tid);
    for (int i = tid; i < 9 * 1024; i += NTHR) { const int r = i >> 10, k = i & 1023; const float x = r < 8 ? F.in[I_C][r * D + k] : F.in[I_CCTX][k]; sv[i] = silu_f(x); }
    __syncthreads();
    for (int it = F.bx; it < 192; it += F.G) {
        const int l = it / 96, n0 = (it % 96) * 64, col = tid & 63, kg = tid >> 6;
        const float* w = F.in[I_WMOD] + (size_t)l * D * 6 * D + n0 + col;
        float acc[9];
#pragma unroll
        for (int r = 0; r < 9; ++r) acc[r] = 0.f;
#pragma unroll 4
        for (int k = kg * 128; k < kg * 128 + 128; ++k) { const float wv = w[(size_t)k * 6 * D];
#pragma unroll
            for (int r = 0; r < 9; ++r) acc[r] += sv[r * 1024 + k] * wv; }
#pragma unroll
        for (int r = 0; r < 9; ++r) red[(kg * 9 + r) * 64 + col] = acc[r];
        __syncthreads();
        for (int o = tid; o < 9 * 64; o += NTHR) { const int r = o >> 6, c = o & 63; float s = F.in[I_BMOD][l * 6 * D + n0 + c];
#pragma unroll
            for (int g = 0; g < 8; ++g) s += red[(g * 9 + r) * 64 + c];
            WSP(float, WS_MOD)[((size_t)(l * 9 + r)) * 6 * D + n0 + c] = s; }
        __syncthreads();
    }
}

__device__ __forceinline__ void moe_offsets(const Frame& F, int creg) {
    volatile LAS int* off = (volatile LAS int*)(F.lds + LDS_MISC + 128);
    if (F.tid == 0) { int s = 0; for (int e = 0; e < 16; ++e) { off[e] = s; const int c = (int)*CTLW(CW_CNT + creg * 64 + e); off[17 + e] = c; s += (c + 255) & ~255; } off[16] = s; }
    __syncthreads();
}
struct RowV { f32x4 v[4]; };
__device__ __forceinline__ RowV row_load(const float* p, int lane) { RowV r; const f32x4* q = (const f32x4*)p + lane;
#pragma unroll
    for (int j = 0; j < 4; ++j) r.v[j] = q[64 * j]; return r; }
__device__ __forceinline__ void row_store(float* p, int lane, const RowV& r) { f32x4* q = (f32x4*)p + lane;
#pragma unroll
    for (int j = 0; j < 4; ++j) q[64 * j] = r.v[j]; }
__device__ __forceinline__ float row_rstd(const RowV& r) { float s = 0.f;
#pragma unroll
    for (int j = 0; j < 4; ++j) s += (r.v[j][0] * r.v[j][0] + r.v[j][1] * r.v[j][1]) + (r.v[j][2] * r.v[j][2] + r.v[j][3] * r.v[j][3]);
    return rsqrtf(wave_sum(s) * (1.f / D) + EPS); }
__device__ __forceinline__ RowV row_normmod(const RowV& x, float rstd, const float* g, const float* shift, const float* scale, int lane) {
    RowV y;
#pragma unroll
    for (int j = 0; j < 4; ++j) { const f32x4 gv = ((const f32x4*)g)[lane + 64 * j]; f32x4 t = x.v[j] * rstd * gv;
        if (scale) { const f32x4 sc = ((const f32x4*)scale)[lane + 64 * j], sh = ((const f32x4*)shift)[lane + 64 * j]; t = t * (sc + 1.f) + sh; }
        y.v[j] = t; }
    return y;
}
__device__ __forceinline__ void row_store_bf16(bf16_t* p, int lane, const RowV& r) { u32x2* q = (u32x2*)p + lane;
#pragma unroll
    for (int j = 0; j < 4; ++j) { u32x2 w; w.x = cvt_pk_bf16(r.v[j][0], r.v[j][1]); w.y = cvt_pk_bf16(r.v[j][2], r.v[j][3]); q[64 * j] = w; } }
__device__ __forceinline__ RowV row_load_bf16(const bf16_t* p, int lane) { RowV r; const u32x2* q = (const u32x2*)p + lane;
#pragma unroll
    for (int j = 0; j < 4; ++j) { const u32x2 w = q[64 * j]; r.v[j] = (f32x4){bflo(w.x), bfhi(w.x), bflo(w.y), bfhi(w.y)}; } return r; }

struct RowIn { RowV x; u32x2 y0[4], y1[4]; int valid; float w0, w1; };
template <int MODE>
__device__ __forceinline__ RowIn rows_load(const Frame& F, int r, int lane, int s0, int s1, bool last) {
    RowIn in; in.valid = 0; in.w0 = 0.f; in.w1 = 0.f;
#pragma unroll
    for (int j = 0; j < 4; ++j) { in.x.v[j] = (f32x4){0.f, 0.f, 0.f, 0.f}; in.y0[j] = (u32x2){0u, 0u}; in.y1[j] = (u32x2){0u, 0u}; }
    if (r >= MALL) return in;
    const int b = r / TT, t = r - b * TT; const bool isctx = t < CTXL;
    if (last && isctx) return in;
    in.valid = 1;
    if (MODE == 0) in.x = row_load(isctx ? F.in[I_CTX] + ((size_t)b * CTXL + t) * D : F.in[I_X] + ((size_t)b * SEQ + (t - CTXL)) * D, lane);
    else {
        in.x = row_load_bf16((const bf16_t*)xrow_ptr(F, r), lane);
        const float* tw = WSP(const float, WS_ROUTE + RT_TW) + (size_t)r * 2; in.w0 = tw[0]; in.w1 = tw[1];
        const u32x2* q0 = (const u32x2*)(WSP(const bf16_t, WS_Y) + (size_t)s0 * D) + lane; const u32x2* q1 = (const u32x2*)(WSP(const bf16_t, WS_Y) + (size_t)s1 * D) + lane;
#pragma unroll
        for (int j = 0; j < 4; ++j) { in.y0[j] = q0[64 * j]; in.y1[j] = q1[64 * j]; }
    }
    return in;
}
template <int MODE>
__device__ __forceinline__ void phase_rows(const Frame& F, int l, int dry = 0) {
    const int gw = F.bx * NWAVES + F.wave, NGW = F.G * NWAVES, lane = opaque(F.lane);
    const bool last = (MODE == 1 && l == DEPTH - 1);
    const int ln = (MODE == 0) ? 0 : l + 1;
    const int RPV = (MALL + NGW - 1) / NGW, rbeg = gw * RPV, rend = (rbeg + RPV < MALL) ? rbeg + RPV : MALL;
    int s0all = 0, s1all = 0;
    if (MODE == 1) { if (MK_PER_PHASE) moe_offsets(F, CREG(l)); const volatile LAS int* off = (const volatile LAS int*)(F.lds + LDS_MISC + 128);
        const int rr = rbeg + lane; if (lane < RPV && rr < MALL && !(last && (rr % TT) < CTXL)) { const int* te = WSP(const int, WS_ROUTE + RT_TE) + (size_t)rr * 2; const int* rk = WSP(const int, WS_ROUTE + RT_RANK) + (size_t)rr * 2;
            s0all = off[te[0]] + rk[0]; s1all = off[te[1]] + rk[1]; } }
    RowIn cur = rows_load<MODE>(F, rbeg < rend ? rbeg : MALL, lane, __builtin_amdgcn_readlane(s0all, 0), __builtin_amdgcn_readlane(s1all, 0), last);
    RowIn nx1 = rows_load<MODE>(F, rbeg + 1 < rend ? rbeg + 1 : MALL, lane, __builtin_amdgcn_readlane(s0all, 1), __builtin_amdgcn_readlane(s1all, 1), last);
    f32x4 gtv[4], gsv[4], shv[4]; int key = -1;
#pragma unroll
    for (int j = 0; j < 4; ++j) { gtv[j] = (f32x4){0.f, 0.f, 0.f, 0.f}; gsv[j] = (f32x4){0.f, 0.f, 0.f, 0.f}; shv[j] = (f32x4){0.f, 0.f, 0.f, 0.f}; }
#pragma unroll 1
    for (int k = 0; rbeg + k < rend; ++k) {
        const int r = rbeg + k;
        const RowIn nxt = rows_load<MODE>(F, r + 2 < rend ? r + 2 : MALL, lane, __builtin_amdgcn_readlane(s0all, k + 2), __builtin_amdgcn_readlane(s1all, k + 2), last);
        if (cur.valid) {
            float* xp = xrow_ptr(F, r);
            RowV x = cur.x;
            if (MODE == 0) { if (!dry) row_store_bf16((bf16_t*)xp, lane, x); }
            { const int kk = (r % TT) < CTXL ? NB : r / TT;
              if (kk != key) { key = kk;
#pragma unroll
                for (int j = 0; j < 4; ++j) {
                    if (MODE == 1) gtv[j] = ((const f32x4*)mod_ptr(F, l, r, 5))[lane + 64 * j];
                    if (last) { gsv[j] = ((const f32x4*)F.in[I_FN])[lane + 64 * j]; }
                    else { gsv[j] = ((const f32x4*)(F.in[I_NMIX] + ln * D))[lane + 64 * j] * (((const f32x4*)mod_ptr(F, ln, r, 1))[lane + 64 * j] + 1.f); shv[j] = ((const f32x4*)mod_ptr(F, ln, r, 0))[lane + 64 * j]; } } } }
            if (MODE == 1) {
#pragma unroll
                for (int j = 0; j < 4; ++j) { const u32x2 a = cur.y0[j], c = cur.y1[j];
                    const f32x4 ys = (f32x4){cur.w0 * bflo(a.x) + cur.w1 * bflo(c.x), cur.w0 * bfhi(a.x) + cur.w1 * bfhi(c.x), cur.w0 * bflo(a.y) + cur.w1 * bflo(c.y), cur.w0 * bfhi(a.y) + cur.w1 * bfhi(c.y)};
                    x.v[j] = x.v[j] + gtv[j] * ys; }
                if (!last && !dry) row_store_bf16((bf16_t*)xp, lane, x);
            }
            const float rstd = row_rstd(x);
            RowV y;
#pragma unroll
            for (int j = 0; j < 4; ++j) y.v[j] = x.v[j] * rstd * gsv[j] + shv[j];
            if (last) { if (!dry) row_store(xp, lane, y); else row_store_bf16(WSP(bf16_t, WS_H) + (size_t)r * D, lane, y); }
            else row_store_bf16(WSP(bf16_t, WS_H) + (size_t)r * D, lane, y);
        }
        cur = nx1; nx1 = nxt;
    }
}

__device__ __forceinline__ void phase_ctxsum(const Frame& F) {
    const int gw = F.bx * NWAVES + F.wave, NGW = F.G * NWAVES, lane = opaque(F.lane);
    for (int r = gw; r < NB * CTXL; r += NGW) {
        const int b = r >> 8, t = r & 255;
        bf16_t* mp = WSP(bf16_t, WS_MERGED) + ((size_t)b * TT + t) * D;
        RowV m = row_load_bf16(mp, lane); const RowV p1 = row_load_bf16(WSP(const bf16_t, WS_PB) + (size_t)r * D, lane), p2 = row_load_bf16(WSP(const bf16_t, WS_PB) + ((size_t)2048 + r) * D, lane);
#pragma unroll
        for (int j = 0; j < 4; ++j) m.v[j] = (m.v[j] + p1.v[j]) + p2.v[j];
        row_store_bf16(mp, lane, m);
    }
}
__device__ __forceinline__ void phase_router(const Frame& F, int l, int creg) {
    LAS float* rwT = (LAS float*)F.lds;
    LAS int* lcnt = (LAS int*)(F.lds + 65536);
    LAS float* LG = (LAS float*)(F.lds + 65536 + 256);
    const bool last = (l == DEPTH - 1); const int tid = opaque(F.tid);
    const int RPW = (MALL + F.G - 1) / F.G;
    const int r0 = F.bx * RPW, r1 = (r0 + RPW < MALL) ? r0 + RPW : MALL;
    const int lane = tid & 63;
    constexpr int RJ = 3;
    RowV xn[RJ];
#pragma unroll
    for (int j = 0; j < RJ; ++j) { const int r = r0 + F.wave + NWAVES * j; xn[j] = row_load_bf16((const bf16_t*)xrow_ptr(F, r < r1 ? r : r0), lane); }
    for (int i = tid; i < 4 * 1024; i += NTHR) ((LAS f32x4*)rwT)[i] = WSP(const f32x4, WS_RWT)[i];
    if (tid < 32) lcnt[tid] = 0;
    __syncthreads();
    f32x4 gs[4], sh[4]; int key = -1;
#pragma unroll
    for (int j = 0; j < 4; ++j) { gs[j] = (f32x4){0.f, 0.f, 0.f, 0.f}; sh[j] = (f32x4){0.f, 0.f, 0.f, 0.f}; }
#pragma unroll 1
    for (int rb = r0 + F.wave; rb < r1; rb += NWAVES * RJ) {
        RowV x[RJ]; bool ok[RJ];
#pragma unroll
        for (int j = 0; j < RJ; ++j) x[j] = xn[j];
#pragma unroll
        for (int j = 0; j < RJ; ++j) { const int rn = rb + NWAVES * (RJ + j); xn[j] = row_load_bf16((const bf16_t*)xrow_ptr(F, rn < r1 ? rn : r0), lane); }
#pragma unroll
        for (int j = 0; j < RJ; ++j) {
            const int r = rb + NWAVES * j; const int b = r / TT, t = r - b * TT;
            ok[j] = r < r1 && !(last && t < CTXL);
            if (ok[j]) {
                if (t < CTXL) {
                    const RowV px = row_load(WSP(const float, WS_PB) + ((size_t)b * CTXL + t) * D, lane);
#pragma unroll
                    for (int q = 0; q < 4; ++q) x[j].v[q] = x[j].v[q] + px.v[q];
                    row_store_bf16((bf16_t*)xrow_ptr(F, r), lane, x[j]); }
                const int k = t < CTXL ? NB : b;
                if (k != key) { key = k; const float* g = F.in[I_NFFN] + l * D; const float* shp = mod_ptr(F, l, r, 3); const float* scp = mod_ptr(F, l, r, 4);
#pragma unroll
                    for (int q = 0; q < 4; ++q) { gs[q] = ((const f32x4*)g)[lane + 64 * q] * (((const f32x4*)scp)[lane + 64 * q] + 1.f); sh[q] = ((const f32x4*)shp)[lane + 64 * q]; } }
                const float rstd = row_rstd(x[j]);
#pragma unroll
                for (int q = 0; q < 4; ++q) x[j].v[q] = x[j].v[q] * rstd * gs[q] + sh[q];
                row_store_bf16(WSP(bf16_t, WS_H) + (size_t)r * D, lane, x[j]);
            }
        }
        float lg[RJ][8];
#pragma unroll
        for (int i = 0; i < 8; ++i) {
            f32x4 w0[4], w1[4];
#pragma unroll
            for (int q = 0; q < 4; ++q) { w0[q] = *(const LAS f32x4*)(rwT + i * 1024 + 256 * q + 4 * lane); w1[q] = *(const LAS f32x4*)(rwT + (i + 8) * 1024 + 256 * q + 4 * lane); }
#pragma unroll
            for (int j = 0; j < RJ; ++j) { f32x2 a2 = (f32x2){0.f, 0.f}, b2 = (f32x2){0.f, 0.f};
#pragma unroll
                for (int q = 0; q < 4; ++q) { const f32x4 xv = x[j].v[q]; const f32x2 xl = (f32x2){xv[0], xv[1]}, xh = (f32x2){xv[2], xv[3]};
                    a2 += xl * (f32x2){w0[q][0], w0[q][1]}; a2 += xh * (f32x2){w0[q][2], w0[q][3]};
                    b2 += xl * (f32x2){w1[q][0], w1[q][1]}; b2 += xh * (f32x2){w1[q][2], w1[q][3]}; }
                const float sa = a2[0] + a2[1], sb = b2[0] + b2[1];
                const auto sw = __builtin_amdgcn_permlane32_swap(__float_as_uint(sa), __float_as_uint(sb), false, false);
                lg[j][i] = __uint_as_float(sw[0]) + __uint_as_float(sw[1]); }
            __builtin_amdgcn_sched_barrier(0);
        }
        const bool b3 = lane & 8, b2 = lane & 4;
#pragma unroll
        for (int j = 0; j < RJ; ++j) {
            const int r = rb + NWAVES * j;
#pragma unroll
            for (int i = 0; i < 4; ++i) { const auto sw = __builtin_amdgcn_permlane16_swap(__float_as_uint(lg[j][i]), __float_as_uint(lg[j][i + 4]), false, false); lg[j][i] = __uint_as_float(sw[0]) + __uint_as_float(sw[1]); }
#pragma unroll
            for (int i = 0; i < 2; ++i) { const float snd = b3 ? lg[j][i] : lg[j][i + 2], kp = b3 ? lg[j][i + 2] : lg[j][i]; lg[j][i] = kp + dpp_mov<0x128>(snd); }
            { const float snd = b2 ? lg[j][0] : lg[j][1], kp = b2 ? lg[j][1] : lg[j][0]; lg[j][0] = kp + __uint_as_float((unsigned)__builtin_amdgcn_ds_swizzle((int)__float_as_uint(snd), 0x101F)); }
            lg[j][0] += dpp_mov<0xB1>(lg[j][0]); lg[j][0] += dpp_mov<0x4E>(lg[j][0]);
            if (r < r1) { if (ok[j]) { if ((lane & 3) == 0) LG[(r - r0) * 16 + (lane >> 2)] = lg[j][0]; }
                          else if (lane == 0) LG[(r - r0) * 16] = __builtin_nanf(""); }
        }
    }
    __syncthreads();
    int e0 = -1, e1 = -1, lr0 = 0, lr1 = 0;
    const int myr = r0 + tid;
    if (tid < r1 - r0 && !(LG[tid * 16] != LG[tid * 16])) {
        float sc[16], sel[16];
#pragma unroll
        for (int e = 0; e < 16; ++e) { sc[e] = 1.f / (1.f + __expf(-LG[tid * 16 + e])); sel[e] = sc[e] + F.in[I_RB][e]; }
        int bg = 0; float bgs = -1e30f;
#pragma unroll
        for (int g = 0; g < 4; ++g) { float m1 = -1e30f, m2 = -1e30f;
#pragma unroll
            for (int i = 0; i < 4; ++i) { const float v = sel[g * 4 + i]; if (v > m1) { m2 = m1; m1 = v; } else if (v > m2) m2 = v; }
            const float gs = m1 + m2; if (gs > bgs) { bgs = gs; bg = g; } }
        float v0 = -1e30f, v1 = -1e30f, w0 = 0.f, w1 = 0.f;
#pragma unroll
        for (int e = 0; e < 16; ++e) { if ((e >> 2) == bg) { const float v = sel[e], sv = sc[e];
            if (v > v0) { v1 = v0; e1 = e0; w1 = w0; v0 = v; e0 = e; w0 = sv; } else if (v > v1) { v1 = v; e1 = e; w1 = sv; } } }
        const float ws = w0 + w1;
        float* tw = WSP(float, WS_ROUTE + RT_TW) + (size_t)myr * 2; tw[0] = w0 / ws; tw[1] = w1 / ws;
        int* te = WSP(int, WS_ROUTE + RT_TE) + (size_t)myr * 2; te[0] = e0; te[1] = e1;
        lr0 = __hip_atomic_fetch_add(&lcnt[e0], 1, __ATOMIC_RELAXED, __HIP_MEMORY_SCOPE_WORKGROUP); lr1 = __hip_atomic_fetch_add(&lcnt[e1], 1, __ATOMIC_RELAXED, __HIP_MEMORY_SCOPE_WORKGROUP);
    }
    __syncthreads();
    if (tid < 16) lcnt[16 + tid] = (int)atomicAdd(CTLW(CW_CNT + creg * 64 + tid), (unsigned)lcnt[tid]);
    __syncthreads();
    if (e0 >= 0) { int* rk = WSP(int, WS_ROUTE + RT_RANK) + (size_t)myr * 2; const int k0 = lcnt[16 + e0] + lr0, k1 = lcnt[16 + e1] + lr1; rk[0] = k0; rk[1] = k1;
        int* rl = WSP(int, WS_ROWL); rl[(size_t)e0 * MALL + k0] = myr * 2; rl[(size_t)e1 * MALL + k1] = myr * 2 + 1; }
    __syncthreads();
}

__device__ __forceinline__ int lat_tile(int j) { return (j >> 3) * 9 + 1 + (j & 7); }

struct SchedIn {
    const char* H; const char* W; int G, c; bool need_ctx;
    __device__ __forceinline__ bool next(int i, Unit& u) const {
        const int L = i * G + c; int pm, pn;
        if (need_ctx) { if (L >= NRT * 10) return false; rect_order(L, NRT, 10, pm, pn); }
        else if (L < 640) { int im; rect_order(L, 64, 10, im, pn); pm = lat_tile(im); }
        else { const int Lc = L - 640; if (Lc >= 40) return false; pm = (Lc / 5) * 9; const int q = Lc % 5; pn = q < 3 ? 2 + q : 5 + q; }
        u.pm = pm; u.pn = pn; u.kind = 0; u.nt = 16;
        u.A = H + (size_t)pm * 256 * 1024 * 2; u.B = W + (size_t)pn * 256 * 1024 * 2;
        return true;
    }
};
struct EpiIn {
    static constexpr bool PERM = true;
    bf16_t *QG, *KB, *VB, *XM, *CQKV, *KR; float *SSP; const float *qg, *kg; const f32x2 *t64, *t32; unsigned* kmx;
    __device__ __forceinline__ void operator()(const f32x4 (&acc)[2][2][4][2], const Unit& u, int wr, int wc, int fr, int fq) const {
        const int pn = u.pn, pmod = u.pm % 9; const bool lat = pmod != 0;
        const int rowb = u.pm * 256 + wr * 64 + fr, tb = (pmod - 1) * 256 + wr * 64 + fr;
        if (pn <= 2) {
            if (pn == 2 && wc >= 2) {
#pragma unroll
                for (int ai = 0; ai < 2; ++ai)
#pragma unroll
                    for (int m = 0; m < 4; ++m) { const size_t row = rowb + ai * 128 + m * 16;
#pragma unroll
                        for (int bj = 0; bj < 2; ++bj) *(u32x4*)(VB + row * 128 + (wc - 2) * 64 + 32 * bj + 8 * fq) = pack8(acc[ai][bj][m][0], acc[ai][bj][m][1]); }
            } else {
                const float* g = pn < 2 ? qg : kg; const float osc = pn < 2 ? C2Q : 1.f;
                float kmax = 0.f;
                f32x4 gv[2][2];
#pragma unroll
                for (int bj = 0; bj < 2; ++bj)
#pragma unroll
                    for (int n = 0; n < 2; ++n) gv[bj][n] = *(const f32x4*)(g + 32 * bj + 16 * n + 4 * fq);
#pragma unroll
                for (int ai = 0; ai < 2; ++ai)
#pragma unroll
                    for (int m = 0; m < 4; ++m) {
                        const size_t row = rowb + ai * 128 + m * 16;
                        f32x4 v[2][2]; float ss = 0.f;
#pragma unroll
                        for (int bj = 0; bj < 2; ++bj)
#pragma unroll
                            for (int n = 0; n < 2; ++n) { v[bj][n] = acc[ai][bj][m][n]; ss += (v[bj][n][0] * v[bj][n][0] + v[bj][n][1] * v[bj][n][1]) + (v[bj][n][2] * v[bj][n][2] + v[bj][n][3] * v[bj][n][3]); }
                        ss += __shfl_xor(ss, 16); ss += __shfl_xor(ss, 32);
                        const float rs = rsqrtf(ss * (1.f / 64.f) + EPS);
#pragma unroll
                        for (int bj = 0; bj < 2; ++bj)
#pragma unroll
                            for (int n = 0; n < 2; ++n) v[bj][n] = v[bj][n] * rs * gv[bj][n];
                        if (lat) {
                            const int t = tb + ai * 128 + m * 16, pr = t >> 6, pc = t & 63;
#pragma unroll
                            for (int j = 0; j < 4; ++j) {
                                const f32x2 cr = t64[pr * 16 + 4 * fq + j], cc = t64[pc * 16 + 4 * fq + j];
                                const float a1 = v[0][0][j], a2 = v[0][1][j]; v[0][0][j] = a1 * cr.x - a2 * cr.y; v[0][1][j] = a2 * cr.x + a1 * cr.y;
                                const float b1 = v[1][0][j], b2 = v[1][1][j]; v[1][0][j] = b1 * cc.x - b2 * cc.y; v[1][1][j] = b2 * cc.x + b1 * cc.y;
                            }
                        }
                        bf16_t* dst = pn < 2 ? QG + row * 1024 + (4 * pn + wc) * 64 : KB + row * 128 + wc * 64;
#pragma unroll
                        for (int bj = 0; bj < 2; ++bj) *(u32x4*)(dst + 32 * bj + 8 * fq) = pack8(v[bj][0] * osc, v[bj][1] * osc);
                        if (pn == 2) { float n2 = 0.f;
#pragma unroll
                            for (int bj = 0; bj < 2; ++bj)
#pragma unroll
                                for (int n = 0; n < 2; ++n) n2 += (v[bj][n][0] * v[bj][n][0] + v[bj][n][1] * v[bj][n][1]) + (v[bj][n][2] * v[bj][n][2] + v[bj][n][3] * v[bj][n][3]);
                            n2 += __shfl_xor(n2, 16); n2 += __shfl_xor(n2, 32); kmax = fmaxf(kmax, n2); }
                    }
                if (pn == 2) {
#pragma unroll
                    for (int o = 1; o < 16; o <<= 1) kmax = fmaxf(kmax, __shfl_xor(kmax, o));
                    if (fr == 0 && fq == 0) atomicMax(kmx + (u.pm / 9) * 32 + wc, __float_as_uint(kmax)); }
            }
        } else if (pn <= 4) {
#pragma unroll
            for (int ai = 0; ai < 2; ++ai)
#pragma unroll
                for (int m = 0; m < 4; ++m) { const size_t row = rowb + ai * 128 + m * 16;
#pragma unroll
                    for (int bj = 0; bj < 2; ++bj) *(u32x4*)(XM + row * 1024 + (pn - 3) * 256 + 128 * bj + 32 * wc + 8 * fq) = pack8(acc[ai][bj][m][0], acc[ai][bj][m][1]); }
        } else if (pn <= 6) {
#pragma unroll
            for (int ai = 0; ai < 2; ++ai)
#pragma unroll
                for (int m = 0; m < 4; ++m) { const size_t row = rowb + ai * 128 + m * 16;
#pragma unroll
                    for (int bj = 0; bj < 2; ++bj) { f32x4 a = acc[ai][bj][m][0], b = acc[ai][bj][m][1];
#pragma unroll
                        for (int j = 0; j < 4; ++j) { a[j] = gelu_tanh_f(a[j]); b[j] = gelu_tanh_f(b[j]); }
                        *(u32x4*)(QG + row * 1024 + 512 + (pn - 5) * 256 + 128 * bj + 32 * wc + 8 * fq) = pack8(a, b); } }
        } else {
#pragma unroll
            for (int bj = 0; bj < 2; ++bj) {
                const int sec = pn == 7 ? 0 : (pn == 8 ? bj : 1 + bj);
                if (sec == 2) {
                    if (wc != 0) continue;
                    float kmax = 0.f;
#pragma unroll
                    for (int ai = 0; ai < 2; ++ai)
#pragma unroll
                        for (int m = 0; m < 4; ++m) { const size_t row = rowb + ai * 128 + m * 16;
                            f32x4 v[2] = {acc[ai][1][m][0], acc[ai][1][m][1]};
                            if (lat) { const int t = tb + ai * 128 + m * 16, pr = t >> 6, pc = t & 63;
#pragma unroll
                                for (int j = 0; j < 2; ++j) { const f32x2 cr = t32[pr * 8 + 2 * fq + j], cc = t32[pc * 8 + 2 * fq + j];
                                    const float a1 = v[0][j], a2 = v[0][j + 2]; v[0][j] = a1 * cr.x - a2 * cr.y; v[0][j + 2] = a2 * cr.x + a1 * cr.y;
                                    const float b1 = v[1][j], b2 = v[1][j + 2]; v[1][j] = b1 * cc.x - b2 * cc.y; v[1][j + 2] = b2 * cc.x + b1 * cc.y; } }
                            *(u32x4*)(KR + row * 32 + 8 * fq) = pack8(v[0], v[1]);
                            float n2 = (v[0][0] * v[0][0] + v[0][1] * v[0][1]) + (v[0][2] * v[0][2] + v[0][3] * v[0][3]) + (v[1][0] * v[1][0] + v[1][1] * v[1][1]) + (v[1][2] * v[1][2] + v[1][3] * v[1][3]);
                            n2 += __shfl_xor(n2, 16); n2 += __shfl_xor(n2, 32); kmax = fmaxf(kmax, n2); }
#pragma unroll
                    for (int o = 1; o < 16; o <<= 1) kmax = fmaxf(kmax, __shfl_xor(kmax, o));
                    if (fr == 0 && fq == 0) atomicMax(kmx + (u.pm / 9) * 32 + 2, __float_as_uint(kmax));
                } else {
                    const int colb = (pn == 7 ? 128 * bj : (pn == 8 ? (bj == 0 ? 256 : 384) : 384 + 128)) + 32 * wc + 8 * fq;
                    const int grp = (pn == 7 ? 4 * bj : (pn == 8 ? (bj == 0 ? 8 : 12) : 16)) + wc;
#pragma unroll
                    for (int ai = 0; ai < 2; ++ai)
#pragma unroll
                        for (int m = 0; m < 4; ++m) { const size_t row = rowb + ai * 128 + m * 16;
                            const f32x4 a = acc[ai][bj][m][0], b = acc[ai][bj][m][1];
                            *(u32x4*)(CQKV + row * 640 + colb) = pack8(a, b);
                            float ss = (a[0] * a[0] + a[1] * a[1]) + (a[2] * a[2] + a[3] * a[3]) + (b[0] * b[0] + b[1] * b[1]) + (b[2] * b[2] + b[3] * b[3]);
                            ss += __shfl_xor(ss, 16); ss += __shfl_xor(ss, 32);
                            if (fq == 0) SSP[row * 20 + grp] = ss; }
                }
            }
        }
    }
};

struct SchedQKV {
    const char* CQKV; const char* WQ; const char* WKV; int G, c; bool need_ctx;
    __device__ __forceinline__ bool next(int i, Unit& u) const {
        const int L = i * G + c; const int nq = need_ctx ? NRT : 64;
        if (L < nq * 3) { int im, pn; rect_order(L, nq, 3, im, pn); const int pm = need_ctx ? im : lat_tile(im);
            u.pm = pm; u.pn = pn; u.kind = 0; u.nt = 6; u.A = CQKV + (size_t)pm * 256 * 640 * 2; u.B = WQ + (size_t)pn * 256 * 640 * 2; return true; }
        const int L2 = L - nq * 3; if (L2 >= NRT * 4) return false;
        int pm, pn; rect_order(L2, NRT, 4, pm, pn);
        u.pm = pm; u.pn = pn; u.kind = 1; u.nt = 4; u.A = CQKV + (size_t)pm * 256 * 640 * 2 + 384 * 2; u.B = WKV + (size_t)pn * 256 * 640 * 2; return true;
    }
};
struct EpiQKV {
    static constexpr bool PERM = true;
    bf16_t *QM, *KVM; const float *SSP; const f32x2* t32; unsigned* kmx;
    __device__ __forceinline__ void operator()(const f32x4 (&acc)[2][2][4][2], const Unit& u, int wr, int wc, int fr, int fq) const {
        const int pn = u.pn, pmod = u.pm % 9; const bool lat = pmod != 0;
        const int rowb = u.pm * 256 + wr * 64 + fr, tb = (pmod - 1) * 256 + wr * 64 + fr;
        float kmax[2] = {0.f, 0.f};
        float rsv[2][4];
#pragma unroll
        for (int ai = 0; ai < 2; ++ai)
#pragma unroll
            for (int m = 0; m < 4; ++m) { const size_t row = rowb + ai * 128 + m * 16;
                if (u.kind == 1) { const f32x4 s0 = *(const f32x4*)(SSP + row * 20 + 12), s1 = *(const f32x4*)(SSP + row * 20 + 16);
                    rsv[ai][m] = rsqrtf((((s0[0] + s0[1]) + (s0[2] + s0[3])) + ((s1[0] + s1[1]) + (s1[2] + s1[3]))) * (1.f / 256.f) + EPS); }
                else { const f32x4 s0 = *(const f32x4*)(SSP + row * 20), s1 = *(const f32x4*)(SSP + row * 20 + 4), s2 = *(const f32x4*)(SSP + row * 20 + 8);
                    rsv[ai][m] = rsqrtf((((s0[0] + s0[1]) + (s0[2] + s0[3])) + ((s1[0] + s1[1]) + (s1[2] + s1[3])) + ((s2[0] + s2[1]) + (s2[2] + s2[3]))) * (1.f / 384.f) + EPS); } }
#pragma unroll
        for (int ai = 0; ai < 2; ++ai)
#pragma unroll
            for (int m = 0; m < 4; ++m) {
                const size_t row = rowb + ai * 128 + m * 16;
                if (u.kind == 1) {
                    const float rs = rsv[ai][m];
#pragma unroll
                    for (int bj = 0; bj < 2; ++bj) { const f32x4 a = acc[ai][bj][m][0] * rs, c = acc[ai][bj][m][1] * rs;
                        *(u32x4*)(KVM + row * 1024 + pn * 256 + 128 * bj + 32 * wc + 8 * fq) = pack8(a, c);
                        if (pn < 2) { float n2 = (a[0] * a[0] + a[1] * a[1]) + (a[2] * a[2] + a[3] * a[3]) + (c[0] * c[0] + c[1] * c[1]) + (c[2] * c[2] + c[3] * c[3]);
                            n2 += __shfl_xor(n2, 16); n2 += __shfl_xor(n2, 32); kmax[bj] = fmaxf(kmax[bj], n2); } }
                } else {
                    const float rs = rsv[ai][m];
                    if (pn < 2) {
#pragma unroll
                        for (int bj = 0; bj < 2; ++bj) *(u32x4*)(QM + row * 768 + pn * 256 + 128 * bj + 32 * wc + 8 * fq) = pack8(acc[ai][bj][m][0] * (rs * C2M), acc[ai][bj][m][1] * (rs * C2M));
                    } else {
                        const int t = tb + ai * 128 + m * 16, pr = t >> 6, pc = t & 63;
#pragma unroll
                        for (int bj = 0; bj < 2; ++bj) {
                            f32x4 v[2] = {acc[ai][bj][m][0] * rs, acc[ai][bj][m][1] * rs};
                            if (lat) {
#pragma unroll
                                for (int j = 0; j < 2; ++j) { const f32x2 cr = t32[pr * 8 + 2 * fq + j], cc = t32[pc * 8 + 2 * fq + j];
                                    const float a1 = v[0][j], a2 = v[0][j + 2]; v[0][j] = a1 * cr.x - a2 * cr.y; v[0][j + 2] = a2 * cr.x + a1 * cr.y;
                                    const float b1 = v[1][j], b2 = v[1][j + 2]; v[1][j] = b1 * cc.x - b2 * cc.y; v[1][j + 2] = b2 * cc.x + b1 * cc.y; } }
                            *(u32x4*)(QM + row * 768 + 512 + (4 * bj + wc) * 32 + 8 * fq) = pack8(v[0] * C2M, v[1] * C2M);
                        }
                    }
                }
            }
        if (u.kind == 1 && pn < 2) {
#pragma unroll
            for (int bj = 0; bj < 2; ++bj) { float km = kmax[bj];
#pragma unroll
                for (int o = 1; o < 16; o <<= 1) km = fmaxf(km, __shfl_xor(km, o));
                if (fr == 0 && fq == 0) atomicMax(kmx + (u.pm / 9) * 32 + 8 + 2 * (4 * pn + 2 * bj + (wc >> 1)) + (wc & 1), __float_as_uint(km)); }
        }
    }
};

struct SchedMerge {
    const char *H, *QG, *XM, *WG, *WB; int G, c; bool need_ctx;
    __device__ __forceinline__ bool next(int i, Unit& u) const {
        const int nlat = c < 256 ? (256 - c + G - 1) / G : 0;
        int pm, pn, sub, ctxf = 0;
        if (i < 6 * nlat) { const int ti = i / 6; sub = i - ti * 6; int im; rect_order(ti * G + c, 64, 4, im, pn); pm = lat_tile(im); }
        else {
            if (!need_ctx) return false;
            const int q = (i - 6 * nlat) >> 1, ci = c + q * G; if (ci >= 96) return false;
            const int ct = ci / 3, b = ci - ct * 3; pm = (ct >> 2) * 9; pn = ct & 3; sub = 2 * b + ((i - 6 * nlat) & 1); ctxf = 8;
        }
        const int b = sub >> 1;
        u.pm = pm; u.pn = pn; u.kind = sub | ctxf;
        if ((sub & 1) == 0) { u.nt = 16; u.A = H + (size_t)pm * 256 * 1024 * 2; u.B = WG + (size_t)(b * 1024 + pn * 256) * 1024 * 2; }
        else { u.nt = 8; u.A = (b == 0 ? QG : (b == 1 ? QG + 512 * 2 : XM + 512 * 2)) + (size_t)pm * 256 * 1024 * 2; u.B = WB + (size_t)(b * 1024 + pn * 256) * 1024 * 2; }
        return true;
    }
};
struct EpiMerge {
    static constexpr bool PERM = true;
    bf16_t* MERGED; bf16_t* PB; u32x4* stash;
    mutable unsigned gk[24];
    __device__ __forceinline__ void operator()(const f32x4 (&acc)[2][2][4][2], const Unit& u, int wr, int wc, int fr_in, int fq_in) const {
        const int b = (u.kind & 7) >> 1; const bool ctxs = (u.kind & 8) != 0;
        if ((u.kind & 1) == 0) {
#pragma unroll
            for (int ai = 0; ai < 2; ++ai)
#pragma unroll
                for (int bj = 0; bj < 2; ++bj)
#pragma unroll
                    for (int m = 0; m < 4; m += 2) { unsigned w4[4];
#pragma unroll
                        for (int q = 0; q < 4; ++q) { const f32x4 a = acc[ai][bj][m + (q >> 1)][q & 1]; unsigned w = 0u;
#pragma unroll
                            for (int j = 0; j < 4; j += 2) {
                                const f32x2 t = (f32x2){a[j], a[j + 1]} * (-LOG2E);
                                const f32x2 d = (f32x2){fast_exp2(t[0]), fast_exp2(t[1])} * (1.f / 255.f) + (1.f / 255.f);
                                w = __builtin_amdgcn_cvt_pk_u8_f32(fast_rcp(d[0]), j, w); w = __builtin_amdgcn_cvt_pk_u8_f32(fast_rcp(d[1]), j + 1, w); }
                            w4[q] = w; }
                        if (ai * 2 + bj < 3) {
#pragma unroll
                            for (int q = 0; q < 4; ++q) gk[((ai * 2 + bj) * 4 + m) * 2 + q] = w4[q]; }
                        else stash[(size_t)((m >> 1) * 512 + opaque(threadIdx.x))] = (u32x4){w4[0], w4[1], w4[2], w4[3]}; }
            return;
        }
        const int fr = opaque(fr_in), fq = opaque(fq_in);
        const int rowb = u.pm * 256 + wr * 64 + fr;
        const bool rmw = b > 0 && !ctxs;
        u32x4 p[2][2], pq[2][2], gs[2];
        { const int tid = opaque(threadIdx.x); gs[0] = stash[tid]; gs[1] = stash[512 + tid]; }
#define EM_LOAD(P, am) do { const int ai_ = (am) >> 1, mh_ = (am) & 1; _Pragma("unroll") for (int mm = 0; mm < 2; ++mm) _Pragma("unroll") for (int bj = 0; bj < 2; ++bj) { const int m = mh_ * 2 + mm; \
        const u32x4* mp_ = (const u32x4*)(MERGED + (size_t)(rowb + ai_ * 128 + m * 16) * 1024 + u.pn * 256 + 128 * bj + 32 * wc + 8 * fq); \
        P[mm][bj] = rmw ? *mp_ : (u32x4){0u, 0u, 0u, 0u}; } } while (0)
        EM_LOAD(p, 0);
#pragma unroll
        for (int am = 0; am < 4; ++am) { const int ai = am >> 1, mh = am & 1;
            if (am < 3) EM_LOAD(pq, am + 1);
#pragma unroll
            for (int mm = 0; mm < 2; ++mm)
#pragma unroll
                for (int bj = 0; bj < 2; ++bj) { const int m = mh * 2 + mm; const u32x4 pp = p[mm][bj];
                    const unsigned g0 = (ai * 2 + bj < 3) ? gk[((ai * 2 + bj) * 4 + m) * 2 + 0] : gs[m >> 1][(m & 1) * 2 + 0], g1 = (ai * 2 + bj < 3) ? gk[((ai * 2 + bj) * 4 + m) * 2 + 1] : gs[m >> 1][(m & 1) * 2 + 1];
                    constexpr float S = 1.f / 255.f;
                    f32x4 a = acc[ai][bj][m][0] * S, c = acc[ai][bj][m][1] * S;
                    a[0] = a[0] * (float)(g0 & 255u) + bflo(pp.x); a[1] = a[1] * (float)((g0 >> 8) & 255u) + bfhi(pp.x); a[2] = a[2] * (float)((g0 >> 16) & 255u) + bflo(pp.y); a[3] = a[3] * (float)(g0 >> 24) + bfhi(pp.y);
                    c[0] = c[0] * (float)(g1 & 255u) + bflo(pp.z); c[1] = c[1] * (float)((g1 >> 8) & 255u) + bfhi(pp.z); c[2] = c[2] * (float)((g1 >> 16) & 255u) + bflo(pp.w); c[3] = c[3] * (float)(g1 >> 24) + bfhi(pp.w);
                    u32x4* mp = (u32x4*)(MERGED + (size_t)(rowb + ai * 128 + m * 16) * 1024 + u.pn * 256 + 128 * bj + 32 * wc + 8 * fq);
                    if (ctxs && b > 0) mp = (u32x4*)(PB + ((size_t)(b - 1) * 2048 + (u.pm / 9) * 256 + wr * 64 + fr + ai * 128 + m * 16) * 1024 + u.pn * 256 + 128 * bj + 32 * wc + 8 * fq);
                    *mp = pack8(a, c); p[mm][bj] = pq[mm][bj]; }
        }
#undef EM_LOAD
    }
};

struct SchedOut {
    const char *A, *W; int G, c; bool need_ctx;
    __device__ __forceinline__ bool next(int i, Unit& u) const {
        const int nlat = c < 256 ? (256 - c + G - 1) / G : 0;
        if (i < nlat) { int im, pn; rect_order(i * G + c, 64, 4, im, pn); const int pm = lat_tile(im);
            u.pm = pm; u.pn = pn; u.kind = 0; u.nt = 16; u.A = A + (size_t)pm * 256 * 1024 * 2; u.B = W + (size_t)pn * 256 * 1024 * 2; return true; }
        if (!need_ctx) return false;
        const int ci = c + (i - nlat) * G; if (ci >= 64) return false;
        const int ct = ci >> 1, kh = ci & 1, pm = (ct >> 2) * 9, pn = ct & 3;
        u.pm = pm; u.pn = pn; u.kind = 1 + kh; u.nt = 8; u.A = A + (size_t)pm * 256 * 1024 * 2 + kh * 512 * 2; u.B = W + (size_t)pn * 256 * 1024 * 2 + kh * 512 * 2; return true;
    }
};
struct EpiOut {
    static constexpr bool PERM = true;
    static constexpr int XP = 2048;
    float* xc; float* xl; const float* mod; float* PX;
    __device__ __forceinline__ void operator()(const f32x4 (&acc)[2][2][4][2], const Unit& u, int wr, int wc, int fr, int fq) const {
        const int b = u.pm / 9, pmod = u.pm - b * 9;
        const float* gate = mod + ((size_t)(pmod == 0 ? 8 : b) * 6 + 2) * D;
        const size_t row0 = pmod == 0 ? (size_t)b * CTXL : (size_t)b * SEQ + (pmod - 1) * 256;
        float* pxb = PX + (size_t)b * CTXL * D;
        bf16_t* xw = (bf16_t*)(pmod == 0 ? xc : xl) + row0 * XP;
        const int r0 = opaque(wr * 64 + fr), c0 = u.pn * 256 + 32 * wc + 8 * fq;
        f32x4 gv[2][2];
#pragma unroll
        for (int bj = 0; bj < 2; ++bj)
#pragma unroll
            for (int n = 0; n < 2; ++n) gv[bj][n] = *(const f32x4*)(gate + c0 + 128 * bj + 4 * n);
        u32x4 xv[2][2], xn[2][2];
#define EO_LOAD(dst, am) do { const int ai_ = (am) >> 1, m0_ = ((am) & 1) * 2; _Pragma("unroll") for (int mm = 0; mm < 2; ++mm) _Pragma("unroll") for (int bj = 0; bj < 2; ++bj) \
        dst[mm][bj] = (u.kind != 2) ? *(const u32x4*)(xw + (size_t)(r0 + ai_ * 128 + (m0_ + mm) * 16) * XP + c0 + 128 * bj) : (u32x4){0u, 0u, 0u, 0u}; } while (0)
        EO_LOAD(xv, 0);
#pragma unroll
        for (int am = 0; am < 4; ++am) { const int ai = am >> 1, m0 = (am & 1) * 2;
            if (am < 3) EO_LOAD(xn, am + 1);
#pragma unroll
            for (int mm = 0; mm < 2; ++mm)
#pragma unroll
                for (int bj = 0; bj < 2; ++bj) { const size_t row = r0 + ai * 128 + (m0 + mm) * 16; const u32x4 w = xv[mm][bj];
                    const f32x4 o0 = (f32x4){bflo(w.x), bfhi(w.x), bflo(w.y), bfhi(w.y)} + gv[bj][0] * acc[ai][bj][m0 + mm][0], o1 = (f32x4){bflo(w.z), bfhi(w.z), bflo(w.w), bfhi(w.w)} + gv[bj][1] * acc[ai][bj][m0 + mm][1];
                    if (u.kind == 2) { *(f32x4*)(pxb + row * D + c0 + 128 * bj) = o0; *(f32x4*)(pxb + row * D + c0 + 128 * bj + 4) = o1; }
                    else *(u32x4*)(xw + row * XP + c0 + 128 * bj) = pack8(o0, o1);
                    xv[mm][bj] = xn[mm][bj]; }
        }
#undef EO_LOAD
    }
};

struct SchedMoe {
    const char *A, *W; const int* rowl; const volatile LAS int* off; int G, c, second;
    __device__ __forceinline__ bool next(int i, Unit& u) const {
        const int L = i * G + c; const int ntile = off[16] >> 8;
        if (L >= ntile * 4) return false;
        int im, pn; rect_order(L, ntile, 4, im, pn);
        int e = 0;
#pragma unroll
        for (int q = 1; q < 16; ++q) e += (im * 256 >= off[q]) ? 1 : 0;
        e = __builtin_amdgcn_readfirstlane(e);
        u.pm = im; u.pn = pn; u.kind = e;
        if (!second) { const int j0 = im * 256 - off[e]; u.nt = 16; u.A = A; u.rows = rowl + (size_t)e * MALL + j0; u.nvalid = off[17 + e] - j0; u.B = W + (size_t)(e * 1024 + pn * 256) * 1024 * 2; }
        else { u.nt = 8; u.A = A + (size_t)im * 256 * 512 * 2; u.rows = nullptr; u.nvalid = 0; u.B = W + (size_t)(e * 1024 + pn * 256) * 512 * 2; }
        return true;
    }
};
struct EpiMoe1 {
    static constexpr bool PERM = true;
    bf16_t* ACT;
    __device__ __forceinline__ void operator()(const f32x4 (&acc)[2][2][4][2], const Unit& u, int wr, int wc, int fr, int fq) const {
        const int rowb = u.pm * 256 + wr * 64 + fr;
#pragma unroll
        for (int ai = 0; ai < 2; ++ai)
#pragma unroll
            for (int m = 0; m < 4; ++m) { const size_t row = rowb + ai * 128 + m * 16;
                f32x4 o[2];
#pragma unroll
                for (int n = 0; n < 2; ++n)
#pragma unroll
                    for (int j = 0; j < 4; ++j) o[n][j] = silu_f(acc[ai][0][m][n][j]) * acc[ai][1][m][n][j];
                *(u32x4*)(ACT + row * 512 + u.pn * 128 + 32 * wc + 8 * fq) = pack8(o[0], o[1]); }
    }
};
struct EpiMoe2 {
    static constexpr bool PERM = true;
    bf16_t* Y;
    __device__ __forceinline__ void operator()(const f32x4 (&acc)[2][2][4][2], const Unit& u, int wr, int wc, int fr, int fq) const {
        const int rowb = u.pm * 256 + wr * 64 + fr;
#pragma unroll
        for (int ai = 0; ai < 2; ++ai)
#pragma unroll
            for (int m = 0; m < 4; ++m)
#pragma unroll
                for (int bj = 0; bj < 2; ++bj) *(u32x4*)(Y + (size_t)(rowb + ai * 128 + m * 16) * 1024 + u.pn * 256 + 128 * bj + 32 * wc + 8 * fq) = pack8(acc[ai][bj][m][0], acc[ai][bj][m][1]);
    }
};

constexpr int AT_VB = 8192, AT_KB = 16384;
constexpr int AT_V = 0, AT_K = 3 * AT_VB, AT_WS = AT_K + 3 * AT_KB, AT_OST = AT_WS + NWAVES * 256, AT_BYTES = AT_OST + NWAVES * 4096;
static_assert(AT_BYTES <= LDS_STAGE, "attention LDS");
__device__ __forceinline__ int crow(int r, int hi) { return (r & 3) + 8 * (r >> 2) + 4 * hi; }
template <int DK> __device__ __forceinline__ int kswz(int row, int colB) { return DK == 64 ? row * 128 + (colB ^ (((row >> 1) & 7) << 4)) : row * 256 + (colB ^ ((row & 15) << 4)); }
__device__ __forceinline__ int v_st(int k, int c) { const int kk = k; return ((kk >> 3) * 2 + (c >> 5)) * 512 + ((kk & 7) * 32 + (c & 31)) * 2; }
__device__ __forceinline__ int v_rd_base(int lane) { return ((lane & 3) << 3) | (((lane >> 2) & 3) << 6) | (((lane >> 4) & 1) << 5) | (((lane >> 5) & 1) << 8); }
constexpr int v_rd_off(int d0, int ks, int half) { return d0 * 512 + ks * 2048 + half * 1024; }
template <int OFF> __device__ __forceinline__ s16x4 tr_read(int vb) { s16x4 r; asm volatile("ds_read_b64_tr_b16 %0, %1 offset:%2" : "=&v"(r) : "v"(vb), "i"(OFF) : "memory"); return r; }

__device__ __forceinline__ void expA(f32x16& p0) {
#pragma unroll
    for (int r = 0; r < 16; ++r) p0[r] = fast_exp2(p0[r]);
}
__device__ __forceinline__ void finishSM(f32x16& p0, f32x16& p1, float& l_reg, bf16x8& pa0, bf16x8& pa1, bf16x8& pa2, bf16x8& pa3) {
#pragma unroll
    for (int r = 0; r < 16; ++r) p1[r] = fast_exp2(p1[r]);
    f32x2 ps2 = (f32x2){p0[0], p0[1]} + (f32x2){p1[0], p1[1]};
#pragma unroll
    for (int r = 2; r < 16; r += 2) ps2 += (f32x2){p0[r], p0[r + 1]} + (f32x2){p1[r], p1[r + 1]};
    l_reg += ps2[0] + ps2[1];
#define PK4(P, BASE, OUT) do { unsigned a0 = cvt_pk_bf16(P[BASE + 0], P[BASE + 1]), a1 = cvt_pk_bf16(P[BASE + 2], P[BASE + 3]);   \
    unsigned b0 = cvt_pk_bf16(P[BASE + 4], P[BASE + 5]), b1 = cvt_pk_bf16(P[BASE + 6], P[BASE + 7]);                              \
    u32x4 w = {a0, a1, b0, b1}; OUT = *reinterpret_cast<bf16x8*>(&w); } while (0)
    PK4(p0, 0, pa0); PK4(p0, 8, pa1); PK4(p1, 0, pa2); PK4(p1, 8, pa3);
#undef PK4
}
template <int DK>
__device__ __forceinline__ void qkt(f32x16& p0, f32x16& p1, int Ks, const bf16x8* qr, const f32x16& cinit, int r32, int hi) {
#pragma unroll
    for (int d0 = 0; d0 < DK / 16; ++d0) { const int cb = (d0 * 16 + hi * 8) * 2;
        const bf16x8 b0 = *(const LAS bf16x8*)(uintptr_t)(Ks + kswz<DK>(r32, cb));
        const bf16x8 b1 = *(const LAS bf16x8*)(uintptr_t)(Ks + kswz<DK>(32 + r32, cb));
        if (d0 == 0) { p0 = __builtin_amdgcn_mfma_f32_32x32x16_bf16(b0, qr[0], cinit, 0, 0, 0); p1 = __builtin_amdgcn_mfma_f32_32x32x16_bf16(b1, qr[0], cinit, 0, 0, 0); }
        else { p0 = __builtin_amdgcn_mfma_f32_32x32x16_bf16(b0, qr[d0], p0, 0, 0, 0); p1 = __builtin_amdgcn_mfma_f32_32x32x16_bf16(b1, qr[d0], p1, 0, 0, 0); } }
}
__device__ __forceinline__ void pv_d0(f32x16* o, int vb, bf16x8 pa0, bf16x8 pa1, bf16x8 pa2, bf16x8 pa3) {
#define TR8(D0, l0, h0, l1, h1, l2, h2, l3, h3) const s16x4 l0 = tr_read<v_rd_off(D0, 0, 0)>(vb), h0 = tr_read<v_rd_off(D0, 0, 1)>(vb), l1 = tr_read<v_rd_off(D0, 1, 0)>(vb), h1 = tr_read<v_rd_off(D0, 1, 1)>(vb), \
    l2 = tr_read<v_rd_off(D0, 2, 0)>(vb), h2 = tr_read<v_rd_off(D0, 2, 1)>(vb), l3 = tr_read<v_rd_off(D0, 3, 0)>(vb), h3 = tr_read<v_rd_off(D0, 3, 1)>(vb)
    TR8(0, a0, b0, a1, b1, a2, b2, a3, b3); TR8(1, c0, d0, c1, d1, c2, d2, c3, d3);
#undef TR8
    asm volatile("s_waitcnt lgkmcnt(0)" ::: "memory"); SBAR();
#define PK(L, H) (bf16x8){L[0], L[1], L[2], L[3], H[0], H[1], H[2], H[3]}
    o[0] = __builtin_amdgcn_mfma_f32_32x32x16_bf16(pa0, PK(a0, b0), o[0], 0, 0, 0); o[1] = __builtin_amdgcn_mfma_f32_32x32x16_bf16(pa0, PK(c0, d0), o[1], 0, 0, 0);
    o[0] = __builtin_amdgcn_mfma_f32_32x32x16_bf16(pa1, PK(a1, b1), o[0], 0, 0, 0); o[1] = __builtin_amdgcn_mfma_f32_32x32x16_bf16(pa1, PK(c1, d1), o[1], 0, 0, 0);
    o[0] = __builtin_amdgcn_mfma_f32_32x32x16_bf16(pa2, PK(a2, b2), o[0], 0, 0, 0); o[1] = __builtin_amdgcn_mfma_f32_32x32x16_bf16(pa2, PK(c2, d2), o[1], 0, 0, 0);
    o[0] = __builtin_amdgcn_mfma_f32_32x32x16_bf16(pa3, PK(a3, b3), o[0], 0, 0, 0); o[1] = __builtin_amdgcn_mfma_f32_32x32x16_bf16(pa3, PK(c3, d3), o[1], 0, 0, 0);
#undef PK
}
template <int DK>
__device__ __forceinline__ void attn_unit(const bf16_t* Qb, int ldq, const bf16_t* Qr, const bf16_t* __restrict__ Kh, int ldk, const bf16_t* __restrict__ K2,
                                          const bf16_t* __restrict__ Vh, int ldv, bf16_t* Ob, int ldo, int nkeys, float k2max, int ldsb) {
    const int tid = opaque(threadIdx.x), wid = tid >> 6, lane = tid & 63, r32 = lane & 31, hi = lane >> 5;
    const int V_lds = ldsb + AT_V, K_lds = ldsb + AT_K;
    LAS float* li_l = (LAS float*)(uintptr_t)(ldsb + AT_WS + wid * 256);
    float l_reg = 0; f32x16 o[2] = {}; bf16x8 qr[DK / 16];
    { const bf16_t* Qw = Qb + (size_t)(wid * 32 + r32) * ldq + hi * 8;
#pragma unroll
      for (int d0 = 0; d0 < 4; ++d0) qr[d0] = *(const bf16x8*)(Qw + d0 * 16);
      if constexpr (DK == 96) { const bf16_t* Qw2 = Qr + (size_t)(wid * 32 + r32) * ldq + hi * 8;
#pragma unroll
        for (int d0 = 0; d0 < 2; ++d0) qr[4 + d0] = *(const bf16x8*)(Qw2 + d0 * 16); } }
    f32x16 cinit;
    {
        float qn = 0.f;
#pragma unroll
        for (int d0 = 0; d0 < DK / 16; ++d0) { const u32x4 w = *reinterpret_cast<const u32x4*>(&qr[d0]);
            qn += (bflo(w.x) * bflo(w.x) + bfhi(w.x) * bfhi(w.x)) + (bflo(w.y) * bflo(w.y) + bfhi(w.y) * bfhi(w.y)) + (bflo(w.z) * bflo(w.z) + bfhi(w.z) * bfhi(w.z)) + (bflo(w.w) * bflo(w.w) + bfhi(w.w) * bfhi(w.w)); }
        qn += __shfl_xor(qn, 32);
        const float nm = 32.f - sqrtf(qn * k2max * 1.03f);
#pragma unroll
        for (int r = 0; r < 16; ++r) cinit[r] = nm;
    }
    const int sr = tid >> 3, sc = (tid & 7) * 8;
    const int sr2 = (tid >> 2) & 63, sc2 = (tid & 3) * 8;
    const int kst = kswz<DK>(sr, sc * 2), kst2 = kswz<DK>(sr2, (64 + sc2) * 2), vst = v_st(sr, sc);
    const int vb0 = V_lds + v_rd_base(lane);
    constexpr int SD = 2, S1 = SD - 1;
    struct { bf16x8 k, k2, v; } sr_[SD];
#define SLOAD(i, k0) do { sr_[i].v = *(const bf16x8*)(Vh + (size_t)((k0) + sr) * ldv + sc); sr_[i].k = *(const bf16x8*)(Kh + (size_t)((k0) + sr) * ldk + sc); \
    if constexpr (DK == 96) sr_[i].k2 = *(const bf16x8*)(K2 + (size_t)((k0) + sr2) * 32 + sc2); } while (0)
#define SWRITE(b, i) do { *(LAS bf16x8*)(uintptr_t)(V_lds + (b) * AT_VB + vst) = sr_[i].v; *(LAS bf16x8*)(uintptr_t)(K_lds + (b) * AT_KB + kst) = sr_[i].k; \
    if constexpr (DK == 96) *(LAS bf16x8*)(uintptr_t)(K_lds + (b) * AT_KB + kst2) = sr_[i].k2; } while (0)
    f32x16 pA0, pA1, pB0, pB1; bf16x8 pa0, pa1, pa2, pa3; const int NT = nkeys / 64;
    SLOAD(0, 0); SWRITE(0, 0); SLOAD(S1, 64); SWRITE(1, S1); if constexpr (SD == 2) { if (2 < NT) SLOAD(0, 128); }
    __syncthreads();
    qkt<DK>(pA0, pA1, K_lds, qr, cinit, r32, hi); expA(pA0);
    int bp = 0, bq = 1, bn = 2;
#define STEP(C0, C1, P0, P1, SL_LD, SL_WR, J) do { \
        SBAR(); qkt<DK>(C0, C1, K_lds + bq * AT_KB, qr, cinit, r32, hi); \
        finishSM(P0, P1, l_reg, pa0, pa1, pa2, pa3); SBAR(); \
        if ((J) + SD < NT) SLOAD(SL_LD, ((J) + SD) * 64); SBAR(); \
        pv_d0(o, vb0 + bp * AT_VB, pa0, pa1, pa2, pa3); expA(C0); \
        if ((J) + 1 < NT) SWRITE(bn, SL_WR); \
        __syncthreads(); \
        bp = bq; bq = bn; bn = (bn == 2) ? 0 : bn + 1; } while (0)
    for (int j = 1; j + 1 < NT; j += 2) {
        STEP(pB0, pB1, pA0, pA1, S1, 0, j);
        STEP(pA0, pA1, pB0, pB1, 0, S1, j + 1);
    }
    SBAR(); qkt<DK>(pB0, pB1, K_lds + bq * AT_KB, qr, cinit, r32, hi);
    finishSM(pA0, pA1, l_reg, pa0, pa1, pa2, pa3); SBAR();
    pv_d0(o, vb0 + bp * AT_VB, pa0, pa1, pa2, pa3); expA(pB0);
    finishSM(pB0, pB1, l_reg, pa0, pa1, pa2, pa3); SBAR();
    pv_d0(o, vb0 + bq * AT_VB, pa0, pa1, pa2, pa3);
#undef STEP
    l_reg += __shfl_xor(l_reg, 32);
    if (hi == 0) li_l[r32] = l_reg; asm volatile("s_waitcnt lgkmcnt(0)" ::: "memory");
    {
        const int ost = ldsb + AT_OST + wid * 4096;
#pragma unroll
        for (int r = 0; r < 16; ++r) { const int orow = crow(r, hi); const float rl = fast_rcp(li_l[orow]);
#pragma unroll
            for (int d0 = 0; d0 < 2; ++d0) *(LAS unsigned short*)(uintptr_t)(ost + orow * 128 + (d0 * 32 + r32) * 2) = (unsigned short)(cvt_pk_bf16(o[d0][r] * rl, 0.f) & 0xffffu); }
        asm volatile("s_waitcnt lgkmcnt(0)" ::: "memory");
        bf16_t* Ow = Ob + (size_t)(wid * 32) * ldo;
#pragma unroll
        for (int i = 0; i < 4; ++i) { const int id = lane + 64 * i, row = id >> 3, ch = id & 7;
            *(u32x4*)(Ow + (size_t)row * ldo + ch * 8) = *(const LAS u32x4*)(uintptr_t)(ost + row * 128 + ch * 16); }
    }
    __syncthreads();
#undef SLOAD
#undef SWRITE
}

constexpr int LRU_UROW = 1040;
constexpr int LRU_GY = 64 * LRU_UROW;
static_assert(LRU_GY + 64 * LRU_UROW <= LDS_MISC, "lru lds");
template <bool FINAL, int DIR>
__device__ __forceinline__ void lru_dir(const Frame& F, int l, int b, int ch, int nt2, f32x16 (&hf)[2], float cin_in) {
    const int lane = opaque(F.lane), w = F.wave, r32 = lane & 31, hi = lane >> 5, d = DIR;
    LAS unsigned char* U = F.lds;
    LAS unsigned char* GYT = F.lds + LRU_GY;
    const int c = w * 64 + nt2 * 32 + r32;
    const bf16_t* WL = WSP(const bf16_t, WS_WLRU) + (size_t)l * (2 * 2 * 8 * 64 * 64);
    float* TOT = WSP(float, WS_TOT);
    const float nba = -LOG2E * F.in[I_LBA][(l * 2 + d) * 512 + c], nbi = -LOG2E * F.in[I_LBI][(l * 2 + d) * 512 + c];
    const float c8 = -8.f * LOG2E * log1pf(__expf(-F.in[I_LLAM][(l * 2 + d) * 512 + c]));
    f32x16 av[2], bq[2];
    bf16x8 wa[4], wi[4];
#pragma unroll
    for (int ks = 0; ks < 4; ++ks) {
        wa[ks] = *(const bf16x8*)(WL + ((size_t)((d * 2 + 0) * 8 + w) * 64 + nt2 * 32 + r32) * 64 + ks * 16 + hi * 8);
        wi[ks] = *(const bf16x8*)(WL + ((size_t)((d * 2 + 1) * 8 + w) * 64 + nt2 * 32 + r32) * 64 + ks * 16 + hi * 8); }
#pragma unroll
    for (int mt = 0; mt < 2; ++mt) {
        f32x16 xa = {}, xi = {};
#pragma unroll
        for (int ks = 0; ks < 4; ++ks) {
            const bf16x8 af = *(const LAS bf16x8*)(U + (mt * 32 + r32) * LRU_UROW + (w * 64 + ks * 16 + hi * 8) * 2);
            xa = __builtin_amdgcn_mfma_f32_32x32x16_bf16(af, wa[ks], xa, 0, 0, 0); xi = __builtin_amdgcn_mfma_f32_32x32x16_bf16(af, wi[ks], xi, 0, 0, 0); }
#pragma unroll
        for (int r = 0; r < 16; r += 2) {
            const f32x2 uv = (f32x2){bf2f(*(const LAS unsigned short*)(U + (mt * 32 + crow(r, hi)) * LRU_UROW + c * 2)), bf2f(*(const LAS unsigned short*)(U + (mt * 32 + crow(r + 1, hi)) * LRU_UROW + c * 2))};
            const f32x2 ea = (f32x2){xa[r], xa[r + 1]} * (-LOG2E) + nba, ei = (f32x2){xi[r], xi[r + 1]} * (-LOG2E) + nbi;
            const f32x2 da = (f32x2){fast_exp2(ea[0]), fast_exp2(ea[1])} + 1.f, di = (f32x2){fast_exp2(ei[0]), fast_exp2(ei[1])} + 1.f;
            const f32x2 rg = (f32x2){fast_rcp(da[0]), fast_rcp(da[1])}, ig = (f32x2){fast_rcp(di[0]), fast_rcp(di[1])};
            const f32x2 t = rg * c8;
            const f32x2 a = (f32x2){fast_exp2(t[0]), fast_exp2(t[1])};
            const f32x2 s2 = 1.f - a * a;
            const f32x2 q2 = (f32x2){__builtin_amdgcn_sqrtf(fmaxf(s2[0], 0.f)), __builtin_amdgcn_sqrtf(fmaxf(s2[1], 0.f))};
            const f32x2 bb = q2 * ig * uv;
            av[mt][r] = a[0]; av[mt][r + 1] = a[1]; bq[mt][r] = bb[0]; bq[mt][r + 1] = bb[1];
        }
    }
    float cin = FINAL ? cin_in : 0.f, Atot = 1.f;
    float mycin[2][4];
#pragma unroll
    for (int q = 0; q < 2; ++q) {
        const int mt = d == 0 ? q : 1 - q;
#pragma unroll
        for (int qs = 0; qs < 4; ++qs) {
            const int sl = d == 0 ? qs : 3 - qs;
            float As = 1.f, Bs = 0.f;
#pragma unroll
            for (int k = 0; k < 4; ++k) { const int r = 4 * sl + (d == 0 ? k : 3 - k); As *= av[mt][r]; Bs = av[mt][r] * Bs + bq[mt][r]; }
            const auto ra = __builtin_amdgcn_permlane32_swap(__float_as_uint(As), __float_as_uint(As), false, false), rb = __builtin_amdgcn_permlane32_swap(__float_as_uint(Bs), __float_as_uint(Bs), false, false);
            const float A0 = __uint_as_float(ra[0]), A1 = __uint_as_float(ra[1]), B0 = __uint_as_float(rb[0]), B1 = __uint_as_float(rb[1]);
            float c0v, c1v;
            if (d == 0) { c0v = cin; cin = A0 * cin + B0; c1v = cin; cin = A1 * cin + B1; }
            else { c1v = cin; cin = A1 * cin + B1; c0v = cin; cin = A0 * cin + B0; }
            mycin[mt][sl] = hi ? c1v : c0v; Atot *= A0 * A1;
        }
    }
    if (!FINAL) { if (hi == 0) { float* tp = TOT + ((size_t)(b * 2 + d) * NCH + ch) * 1024 + c; tp[0] = Atot; tp[512] = cin; } }
    else {
#pragma unroll
        for (int mt = 0; mt < 2; ++mt)
#pragma unroll
            for (int sl = 0; sl < 4; ++sl) { float h = mycin[mt][sl];
#pragma unroll
                for (int k = 0; k < 4; ++k) { const int r = 4 * sl + (d == 0 ? k : 3 - k); h = av[mt][r] * h + bq[mt][r];
                    if (d == 0) hf[mt][r] = h;
                    else { LAS unsigned short* op = (LAS unsigned short*)(GYT + (mt * 32 + crow(r, hi)) * LRU_UROW + c * 2);
                           *op = (unsigned short)(cvt_pk_bf16((hf[mt][r] + h) * bf2f(*op), 0.f) & 0xffffu); } } }
    }
}
template <bool FINAL>
__device__ __forceinline__ void lru_unit(const Frame& F, int l, int b, int ch, int half = -1) {
    const int tid = opaque(F.tid);
    LAS unsigned char* U = F.lds;
    const bf16_t* XM = WSP(const bf16_t, WS_XM);
    const int t0 = ch * 64, seglo = ch < 4 ? 0 : CTXL, seghi = ch < 4 ? CTXL : TT;
    float cpre[2][2] = {{0.f, 0.f}, {0.f, 0.f}};
    if (FINAL) {
        const int r32 = opaque(F.lane) & 31;
#pragma unroll
        for (int d = 0; d < 2; ++d) {
            const float* tp = WSP(const float, WS_TOT) + ((size_t)(b * 2 + d) * NCH) * 1024 + F.wave * 64 + r32;
            const int n0 = d == 0 ? 0 : (ch >= 4 ? 4 : 3 - ch);
            const int nst = d == 0 ? ch : (ch >= 4 ? 4 + (NCH - 1 - ch) : 3 - ch);
            float c0 = 0.f, c1 = 0.f;
#pragma unroll 1
            for (int s0 = 0; s0 < nst; s0 += 16) {
                float Aq[2][16], Bq[2][16];
#pragma unroll
                for (int q = 0; q < 16; ++q) { const int st = s0 + q; const bool ok = st < nst;
                    const int j = d == 0 ? st : (st < n0 ? 3 - st : NCH - 1 - (st - n0));
                    const int jj = ok ? j : 0;
#pragma unroll
                    for (int n = 0; n < 2; ++n) { const float Av = tp[jj * 1024 + n * 32], Bv = tp[jj * 1024 + 512 + n * 32]; Aq[n][q] = ok ? Av : 1.f; Bq[n][q] = ok ? Bv : 0.f; } }
#pragma unroll
                for (int q = 0; q < 16; ++q) { c0 = Aq[0][q] * c0 + Bq[0][q]; c1 = Aq[1][q] * c1 + Bq[1][q]; }
            }
            cpre[0][d] = c0; cpre[1][d] = c1;
        }
    }
    {
        const int c0 = (tid & 63) * 8, tg = tid >> 6;
        u32x4 xr[11];
#pragma unroll
        for (int i = 0; i < 11; ++i) { const int t = t0 + tg * 8 - 1 + i;
            xr[i] = (t >= seglo && t < seghi) ? *(const u32x4*)(XM + (size_t)(b * TT + t) * 1024 + c0) : (u32x4){0u, 0u, 0u, 0u}; }
        const float* cw = F.in[I_CONVW] + (size_t)l * 4 * 512 + c0; const float* cb = F.in[I_CONVB] + l * 512 + c0;
        f32x4 wv[4][2], bv[2];
#pragma unroll
        for (int j = 0; j < 4; ++j) { wv[j][0] = *(const f32x4*)(cw + j * 512); wv[j][1] = *(const f32x4*)(cw + j * 512 + 4); }
        bv[0] = *(const f32x4*)cb; bv[1] = *(const f32x4*)(cb + 4);
#pragma unroll
        for (int tt = 0; tt < 8; ++tt) { f32x4 a0 = bv[0], a1 = bv[1];
#pragma unroll
            for (int j = 0; j < 4; ++j) { const u32x4 x = xr[tt + j];
                a0 += wv[j][0] * (f32x4){bflo(x.x), bfhi(x.x), bflo(x.y), bfhi(x.y)}; a1 += wv[j][1] * (f32x4){bflo(x.z), bfhi(x.z), bflo(x.w), bfhi(x.w)}; }
            *(LAS u32x4*)(U + (tg * 8 + tt) * LRU_UROW + c0 * 2) = pack8(a0, a1); }
        if (FINAL) {
            bf16_t* QG = WSP(bf16_t, WS_QG);
            if (half < 0 || ((c0 >> 5) & 1) == half) {
#pragma unroll
            for (int tt = 0; tt < 8; ++tt) *(LAS u32x4*)(F.lds + LRU_GY + (tg * 8 + tt) * LRU_UROW + c0 * 2) = *(const u32x4*)(QG + (size_t)(b * TT + t0 + tg * 8 + tt) * 1024 + 512 + c0); }
        }
    }
    __syncthreads();
#pragma unroll 1
    for (int nt2 = (half < 0 ? 0 : half); nt2 < (half < 0 ? 2 : half + 1); ++nt2) {
        f32x16 hf[2];
        lru_dir<FINAL, 0>(F, l, b, ch, nt2, hf, nt2 ? cpre[1][0] : cpre[0][0]);
        lru_dir<FINAL, 1>(F, l, b, ch, nt2, hf, nt2 ? cpre[1][1] : cpre[0][1]);
    }
    __syncthreads();
    if (FINAL) {
        const int tid2 = opaque(F.tid), c0 = (tid2 & 63) * 8, tg = tid2 >> 6; bf16_t* QG = WSP(bf16_t, WS_QG);
        if (half < 0 || ((c0 >> 5) & 1) == half) {
#pragma unroll
        for (int tt = 0; tt < 8; ++tt) *(u32x4*)(QG + (size_t)(b * TT + t0 + tg * 8 + tt) * 1024 + 512 + c0) = *(const LAS u32x4*)(F.lds + LRU_GY + (tg * 8 + tt) * LRU_UROW + c0 * 2); }
        __syncthreads();
    }
}
#ifdef MK_DBG_DET
namespace mkdbg {
__global__ void k_chk(const unsigned* base, long rows, long pitch_w, long off_w, long width_w, const int* rowidx, unsigned long long* acc) {
    unsigned long long s = 0;
    const long total = rows * width_w;
    for (long i = blockIdx.x * (long)blockDim.x + threadIdx.x; i < total; i += (long)gridDim.x * blockDim.x) {
        const long r = i / width_w, c = i - r * width_w; const long rr = rowidx ? rowidx[r] : r;
        const unsigned v = base[rr * pitch_w + off_w + c];
        s += (unsigned long long)v * (unsigned long long)(2 * (i % 1021) + 1);
    }
    for (int o = 32; o > 0; o >>= 1) s += __shfl_xor(s, o);
    if ((threadIdx.x & 63) == 0) atomicAdd(acc, s);
}
__global__ void k_verdict(const unsigned long long* a, const unsigned long long* b, int n, float* out, long nout) {
    int code = n;
    for (int p = n - 1; p >= 0; --p) if (a[p] != b[p]) code = p;
    const float v = exp2f((float)(code + 1));
    for (long i = blockIdx.x * (long)blockDim.x + threadIdx.x; i < nout; i += (long)gridDim.x * blockDim.x) out[i] = v;
}
}
#endif

__device__ __forceinline__ void phase_attn(const Frame& F, int l) {
    const bool need_ctx = (l < DEPTH - 1);
    const int ldsb = (int)(uintptr_t)F.lds;
    bf16_t* QG = WSP(bf16_t, WS_QG); bf16_t* XM = WSP(bf16_t, WS_XM);
    const bf16_t* KB = WSP(const bf16_t, WS_KB); const bf16_t* VB = WSP(const bf16_t, WS_VB);
    const bf16_t* QM = WSP(const bf16_t, WS_QM); const bf16_t* KVM = WSP(const bf16_t, WS_KVM); const bf16_t* KR = WSP(const bf16_t, WS_KR);
    const float* kmx = (const float*)CTLW(CW_KMAX + l * 256);
    const int n_ctx = need_ctx ? 128 : 0, n_lru = need_ctx ? NB * NCH * 2 : NB * (NCH - 4);
    const int total = 1024 + n_ctx + n_lru;
    for (int id = F.bx; id < total; id += F.G) {
        int typ, b, h, qrow, nk, ch = 0, half = -1;
        if (id < 512) {
            const int r = id >> 8, wq = id & 255, x = wq & 7, j = wq >> 3, pp = x + 8 * r; b = pp >> 1; h = (pp & 1) * 4 + (j >> 3); qrow = CTXL + (j & 7) * 256; nk = TT; typ = 0;
        } else if (id < 1024) {
            const int i2 = id - 512, r = i2 >> 8, wq = i2 & 255, x = wq & 7, j = wq >> 3, idx = (x + 8 * r) * 4 + (j >> 3); b = idx >> 3; h = idx & 7; qrow = CTXL + (j & 7) * 256; nk = TT; typ = 1;
        } else if (id < 1024 + n_lru) { const int i2 = id - 1024; typ = 2; h = 0; qrow = 0; nk = 0;
            if (need_ctx) { const int u2 = i2 >> 1; half = i2 & 1; b = u2 / NCH; ch = u2 - b * NCH; } else { b = i2 / (NCH - 4); ch = 4 + i2 - b * (NCH - 4); } }
        else { const int i2 = id - 1024 - n_lru; b = (i2 & 63) >> 3; h = i2 & 7; qrow = 0; nk = CTXL; typ = i2 < 64 ? 0 : 1; }
        const size_t row0 = (size_t)b * TT + qrow, key0 = (size_t)b * TT;
        if (typ == 0) { const int kvh = h >> 2;
            if (nk == TT) attn_unit<64>(QG + row0 * 1024 + h * 64, 1024, nullptr, KB + key0 * 128 + kvh * 64, 128, nullptr, VB + key0 * 128 + kvh * 64, 128, QG + row0 * 1024 + h * 64, 1024, TT, kmx[b * 32 + kvh], ldsb);
            else attn_unit<64>(QG + row0 * 1024 + h * 64, 1024, nullptr, KB + key0 * 128 + kvh * 64, 128, nullptr, VB + key0 * 128 + kvh * 64, 128, QG + row0 * 1024 + h * 64, 1024, CTXL, kmx[b * 32 + kvh], ldsb);
        } else if (typ == 1) { const float k2 = kmx[b * 32 + 8 + 2 * h] + kmx[b * 32 + 9 + 2 * h] + kmx[b * 32 + 2];
            if (nk == TT) attn_unit<96>(QM + row0 * 768 + h * 64, 768, QM + row0 * 768 + 512 + h * 32, KVM + key0 * 1024 + h * 64, 1024, KR + key0 * 32, KVM + key0 * 1024 + 512 + h * 64, 1024, XM + row0 * 1024 + 512 + h * 64, 1024, TT, k2, ldsb);
            else attn_unit<96>(QM + row0 * 768 + h * 64, 768, QM + row0 * 768 + 512 + h * 32, KVM + key0 * 1024 + h * 64, 1024, KR + key0 * 32, KVM + key0 * 1024 + 512 + h * 64, 1024, XM + row0 * 1024 + 512 + h * 64, 1024, CTXL, k2, ldsb);
        } else lru_unit<true>(F, l, b, ch, half);
    }
}

constexpr int NPHASE = 2 + DEPTH * 10;
#ifndef MK_MASK
#define MK_MASK 0xFFF
#endif
#define PM(k) ((MK_MASK >> (k)) & 1)
#ifndef MK_REPGRP
#define MK_REPGRP 0
#endif
#define REPN(k) (1 + ((MK_REP >> (k)) & 1))
__global__ void __launch_bounds__(NTHR, 2) mk_fwd(Args args) {
    extern __shared__ __attribute__((aligned(16))) unsigned char lds_raw[];
    Frame F0;
    F0.lds = (LAS unsigned char*)lds_raw; F0.ws = args.ws; F0.in = args.in; F0.out = args.out;
    F0.tid = threadIdx.x; F0.lane = F0.tid & 63; F0.wave = __builtin_amdgcn_readfirstlane(F0.tid >> 6); F0.G = gridDim.x; F0.bx = blockIdx.x;
    const Frame& F = F0;
    volatile LAS unsigned* misc = (volatile LAS unsigned*)(F.lds + LDS_MISC);
    if (F.tid < 64) misc[F.tid] = 0u;
    __syncthreads();
    XcdBarrier bar; bar.bar = CTLW(CW_BAR); bar.x = 0; bar.st = nullptr;
#if !MK_PER_PHASE
    bar = xcd_barrier_post(CTLW(CW_BAR), misc + 8);
#endif
    const int lo = args.ph_lo, hi = args.ph_hi;
#ifndef MK_TIME_BLK
#define MK_TIME_BLK 0
#endif
#ifdef MK_TIME_A
#define STAMP(k) do { if (F.bx == MK_TIME_BLK && F.tid == 0) { if ((k) == MK_TIME_A) misc[16] = (unsigned)__builtin_amdgcn_s_memrealtime(); if ((k) == MK_TIME_B) misc[17] = (unsigned)__builtin_amdgcn_s_memrealtime(); } } while (0)
#else
#define STAMP(k) do { } while (0)
#endif
#define IN(k) (lo <= (k) && (k) < hi)
#if MK_PER_PHASE
#define SEAM(k) do { } while (0)
#else
#define SEAM(k) do { if (IN(k) && IN((k) + 1)) xcd_barrier(bar); } while (0)
#endif
    STAMP(0);
    if (PM(0) && IN(0)) for (int rep_ = 0; rep_ < REPN(0); ++rep_) { if (rep_) xcd_barrier(bar); const Frame F = phase_frame(F0); p0_mod(F); __syncthreads();
        p0_weights(F); p0_misc(F); }
    SEAM(0);
    STAMP(1);
    if (PM(1) && IN(1)) for (int rep_ = 0; rep_ < REPN(1); ++rep_) { if (rep_) xcd_barrier(bar); const Frame F = phase_frame(F0); phase_rows<0>(F, 0); }
    SEAM(1);
#pragma unroll 1
    for (int l = 0; l < DEPTH; ++l) {
        const int pb = 2 + l * 10; const bool need_ctx = (l < DEPTH - 1);
        STAMP(pb + 0);
#if MK_REPGRP
        for (int grp_ = 0; grp_ < 2; ++grp_) { if (grp_) xcd_barrier(bar);
#endif
        if (PM(2) && IN(pb + 0)) for (int rep_ = 0; rep_ < REPN(2); ++rep_) { if (rep_) xcd_barrier(bar); const Frame F = phase_frame(F0); unsigned char* wl = F.ws + WS_W + (size_t)l * W_LAYER;
            SchedIn S{(const char*)(F.ws + WS_H), (const char*)(wl + W_IN), F.G, F.bx, need_ctx};
            EpiIn E{WSP(bf16_t, WS_QG), WSP(bf16_t, WS_KB), WSP(bf16_t, WS_VB), WSP(bf16_t, WS_XM), WSP(bf16_t, WS_CQKV), WSP(bf16_t, WS_KR),
                    WSP(float, WS_SSP), F.in[I_GQN] + l * 64, F.in[I_GKN] + l * 64, WSP(const f32x2, WS_TAB64), WSP(const f32x2, WS_TAB32), CTLW(CW_KMAX + l * 256)};
            gemm_stream<1024, 1024, EpiIn, SchedIn>(F.lds, S, E);
        }
        SEAM(pb + 0);
        STAMP(pb + 1);
        if (PM(3) && IN(pb + 1)) for (int rep_ = 0; rep_ < REPN(3); ++rep_) { if (rep_) xcd_barrier(bar); const Frame F = phase_frame(F0); unsigned char* wl = F.ws + WS_W + (size_t)l * W_LAYER;
            const int nx = NB * NCH - F.G > 0 && NB * NCH - F.G < F.G ? NB * NCH - F.G : 0;
            SchedQKV S{(const char*)(F.ws + WS_CQKV), (const char*)(wl + W_QB), (const char*)(wl + W_KVB), F.G - nx, F.bx >= nx ? F.bx - nx : (1 << 28), need_ctx};
            EpiQKV E{WSP(bf16_t, WS_QM), WSP(bf16_t, WS_KVM), WSP(const float, WS_SSP), WSP(const f32x2, WS_TAB32), CTLW(CW_KMAX + l * 256)};
            gemm_stream<640, 640, EpiQKV, SchedQKV>(F.lds, S, E);
            __syncthreads();
            for (int id = F.bx; id < NB * NCH; id += F.G) lru_unit<false>(F, l, id / NCH, id % NCH);
        }
        SEAM(pb + 1);
        STAMP(pb + 2);
        if (PM(4) && IN(pb + 2)) for (int rep_ = 0; rep_ < REPN(4); ++rep_) { if (rep_) xcd_barrier(bar); const Frame F = phase_frame(F0); phase_attn(F, l); }
#if MK_REPGRP
        if (grp_ == 0) continue; }
#endif
        SEAM(pb + 2);
        STAMP(pb + 3);
        if (PM(5) && IN(pb + 3)) for (int rep_ = 0; rep_ < REPN(5); ++rep_) { if (rep_) xcd_barrier(bar); const Frame F = phase_frame(F0); unsigned char* wl = F.ws + WS_W + (size_t)l * W_LAYER;
            SchedMerge S{(const char*)(F.ws + WS_H), (const char*)(F.ws + WS_QG), (const char*)(F.ws + WS_XM), (const char*)(wl + W_GATE), (const char*)(wl + W_BR), F.G, F.bx, need_ctx};
            EpiMerge E{WSP(bf16_t, WS_MERGED), WSP(bf16_t, WS_PB), (u32x4*)(F.ws + WS_STASH + (size_t)(F.bx & 255) * 16384), {}};
            gemm_stream<1024, 1024, EpiMerge, SchedMerge>(F.lds, S, E);
        }
        SEAM(pb + 3);
        STAMP(pb + 4);
        if (IN(pb + 4) && need_ctx) { const Frame F = phase_frame(F0); phase_ctxsum(F); }
        if (need_ctx) SEAM(pb + 4);
        STAMP(pb + 5);
        if (PM(6) && IN(pb + 5)) for (int rep_ = 0; rep_ < REPN(6); ++rep_) { if (rep_) xcd_barrier(bar); const Frame F = phase_frame(F0); unsigned char* wl = F.ws + WS_W + (size_t)l * W_LAYER;
            SchedOut S{(const char*)(F.ws + WS_MERGED), (const char*)(wl + W_OUT), F.G, F.bx, need_ctx};
            EpiOut E{WSP(float, WS_XC), F.out, WSP(const float, WS_MOD) + (size_t)l * 9 * 6 * D, WSP(float, WS_PB)};
            gemm_stream<1024, 1024, EpiOut, SchedOut>(F.lds, S, E);
        }
        SEAM(pb + 5);
        STAMP(pb + 6);
        if (PM(7) && IN(pb + 6)) for (int rep_ = 0; rep_ < REPN(7); ++rep_) { if (rep_) xcd_barrier(bar); const Frame F = phase_frame(F0); phase_router(F, l, l * 2 + rep_); }
        SEAM(pb + 6);
        STAMP(pb + 7);
        if (PM(9) && IN(pb + 7)) for (int rep_ = 0; rep_ < REPN(9); ++rep_) { if (rep_) xcd_barrier(bar); const Frame F = phase_frame(F0); unsigned char* wl = F.ws + WS_W + (size_t)l * W_LAYER;
            moe_offsets(F, CREG(l));
            SchedMoe S{(const char*)(F.ws + WS_H), (const char*)(wl + W_GU), WSP(const int, WS_ROWL), (const volatile LAS int*)(F.lds + LDS_MISC + 128), F.G, F.bx, 0};
            EpiMoe1 E{WSP(bf16_t, WS_ACT)};
            gemm_stream<1024, 1024, EpiMoe1, SchedMoe, true>(F.lds, S, E);
        }
        SEAM(pb + 7);
        STAMP(pb + 8);
        if (PM(10) && IN(pb + 8)) for (int rep_ = 0; rep_ < REPN(10); ++rep_) { if (rep_) xcd_barrier(bar); const Frame F = phase_frame(F0); unsigned char* wl = F.ws + WS_W + (size_t)l * W_LAYER;
#if MK_PER_PHASE
            moe_offsets(F, CREG(l));
#endif
            SchedMoe S{(const char*)(F.ws + WS_ACT), (const char*)(wl + W_DN), nullptr, (const volatile LAS int*)(F.lds + LDS_MISC + 128), F.G, F.bx, 1};
            EpiMoe2 E{WSP(bf16_t, WS_Y)};
            gemm_stream<512, 512, EpiMoe2, SchedMoe>(F.lds, S, E);
        }
        SEAM(pb + 8);
        STAMP(pb + 9);
        if (PM(11) && IN(pb + 9)) for (int rep_ = 0; rep_ < REPN(11); ++rep_) { if (rep_) xcd_barrier(bar); const Frame F = phase_frame(F0); phase_rows<1>(F, l, rep_ + 1 < REPN(11)); }
        SEAM(pb + 9);
    }
    STAMP(NPHASE);
#ifdef MK_TIME_A
    if (F.bx == MK_TIME_BLK && F.tid == 0) { const unsigned long long dly = (unsigned long long)(misc[17] - misc[16]) * 8ull, t0 = __builtin_amdgcn_s_memrealtime(); while (__builtin_amdgcn_s_memrealtime() - t0 < dly) __builtin_amdgcn_s_sleep(16); }
#endif
#undef IN
#undef SEAM
}
}

extern "C" void kernel_launch(void* const* d_in, const int* in_sizes, int n_in, void* d_out, int out_size, void* d_ws, size_t ws_size, hipStream_t stream) {
    using namespace mk;
    static int grid = 0;
    if (grid == 0) {
        if (n_in != 32 || out_size != NB * SEQ * D || ws_size < WS_END) { fprintf(stderr, "kernel_launch: unexpected shapes (n_in %d out %d ws %zu, need %zu)\n", n_in, out_size, ws_size, (size_t)WS_END); grid = -1; return; }
        int dev = 0, cus = 0, per_cu = 0;
        if (hipGetDevice(&dev) != hipSuccess || hipDeviceGetAttribute(&cus, hipDeviceAttributeMultiprocessorCount, dev) != hipSuccess) { grid = -1; return; }
        if (hipFuncSetAttribute((const void*)mk_fwd, hipFuncAttributeMaxDynamicSharedMemorySize, LDS_BYTES) != hipSuccess) { fprintf(stderr, "kernel_launch: hipFuncSetAttribute failed\n"); grid = -1; return; }
        if (hipOccupancyMaxActiveBlocksPerMultiprocessor(&per_cu, (const void*)mk_fwd, NTHR, LDS_BYTES) != hipSuccess || per_cu < 1) { fprintf(stderr, "kernel_launch: occupancy query says %d\n", per_cu); per_cu = 1; }
        (void)hipGetLastError();
        grid = cus;
    }
    if (grid < 0) return;
    if (hipMemsetAsync((char*)d_ws + WS_CTL, 0, CTL_BYTES, stream) != hipSuccess) return;
#ifdef MK_DBG_ZERO
    (void)hipMemsetAsync((char*)d_ws + CTL_BYTES, 0, WS_END - CTL_BYTES, stream);
    (void)hipMemsetAsync(d_out, 0, (size_t)NB * SEQ * D * 4, stream);
#endif
    Args a{};
    for (int i = 0; i < 32; ++i) a.in[i] = (const float*)d_in[i];
    a.out = (float*)d_out; a.ws = (unsigned char*)d_ws;
#if defined(MK_DBG_DET)
    {
        unsigned char* ws = (unsigned char*)d_ws;
        unsigned long long* chk = (unsigned long long*)(ws + WS_CTL + 512 * 1024);
        unsigned long long* chkA = (unsigned long long*)(ws + WS_ROUTE + RT_END + 1024);
        auto CHK = [&](int p, const void* base, long rows, long pitch_b, long off_b, long width_b, const int* rowidx) {
            hipLaunchKernelGGL(mk::mkdbg::k_chk, dim3(1024), dim3(256), 0, stream, (const unsigned*)base, rows, pitch_b / 4, off_b / 4, width_b / 4, rowidx, chk + p); };
        const int* tslot = (const int*)(ws + WS_ROUTE + RT_SLOT);
        for (int run = 0; run < 2; ++run) {
            if (run == 1) { hipMemcpyAsync(chkA, chk, 32 * 8, hipMemcpyDeviceToDevice, stream); hipMemsetAsync((char*)d_ws + WS_CTL, 0, CTL_BYTES, stream); }
            for (int p = 0; p < 12; ++p) {
                a.ph_lo = p; a.ph_hi = p + 1; hipLaunchKernelGGL(mk_fwd, dim3(grid), dim3(NTHR), LDS_BYTES, stream, a);
                switch (p) {
                    case 0: CHK(p, ws + WS_MOD, 1, 0, 0, 2 * 9 * 6 * D * 4 + 64 * 16 * 8 + 64 * 8 * 8, nullptr); CHK(p, ws + WS_WLRU, 1, 0, 0, 512 * 1024, nullptr); CHK(p, ws + WS_W, 1, 0, 0, 2 * W_LAYER, nullptr); break;
                    case 1: case 6: case 11: CHK(p, ws + WS_XC, 1, 0, 0, (long)NB * CTXL * D * 4, nullptr); CHK(p, d_out, 1, 0, 0, (long)NB * SEQ * D * 4, nullptr); if (p != 6) CHK(p, ws + WS_H, 1, 0, 0, SZ_R1K, nullptr); break;
                    case 2: CHK(p, ws + WS_QG, 1, 0, 0, SZ_R1K, nullptr); CHK(p, ws + WS_XM, MALL, 2048, 0, 1024, nullptr); CHK(p, ws + WS_KB, 1, 0, 0, (long)MALL * 128 * 2 * 2, nullptr);
                            CHK(p, ws + WS_CQKV, 1, 0, 0, (long)MALL * 640 * 2, nullptr); CHK(p, ws + WS_KR, 1, 0, 0, (long)MALL * 32 * 2, nullptr); CHK(p, ws + WS_SSP, 1, 0, 0, (long)MALL * 20 * 4, nullptr); break;
                    case 3: CHK(p, ws + WS_QM, 1, 0, 0, (long)MALL * 768 * 2, nullptr); CHK(p, ws + WS_KVM, 1, 0, 0, SZ_R1K, nullptr); CHK(p, ws + WS_TOT, 1, 0, 0, (long)NB * 2 * NCH * 1024 * 4, nullptr); break;
                    case 4: CHK(p, ws + WS_QG, 1, 0, 0, SZ_R1K, nullptr); CHK(p, ws + WS_XM, MALL, 2048, 1024, 1024, nullptr); break;
                    case 5: CHK(p, ws + WS_MERGED, 1, 0, 0, SZ_R1K, nullptr); break;
                    case 7: CHK(p, ws + WS_H, 1, 0, 0, SZ_R1K, nullptr); CHK(p, ws + WS_ROUTE + RT_TE, 1, 0, 0, (long)MALL * 2 * 4 * 2, nullptr); break;
                    case 8: CHK(p, ws + WS_H2S, (long)MALL * 2, 2048, 0, 2048, tslot); CHK(p, ws + WS_ROUTE + RT_SLOTW, (long)MALL * 2, 4, 0, 4, tslot); break;
                    case 9: CHK(p, ws + WS_ACT, (long)MALL * 2, 1024, 0, 1024, tslot); break;
                    case 10: CHK(p, ws + WS_Y, (long)MALL * 2, 2048, 0, 2048, tslot); break;
                }
            }
        }
        hipLaunchKernelGGL(mk::mkdbg::k_verdict, dim3(1024), dim3(256), 0, stream, (const unsigned long long*)chkA, (const unsigned long long*)chk, 12, (float*)d_out, (long)NB * SEQ * D);
    }
#elif MK_PER_PHASE
    for (int p = 0; p < NPHASE; ++p) { a.ph_lo = p; a.ph_hi = p + 1; hipLaunchKernelGGL(mk_fwd, dim3(grid), dim3(NTHR), LDS_BYTES, stream, a); }
#else
    a.ph_lo = 0; a.ph_hi = NPHASE;
    hipLaunchKernelGGL(mk_fwd, dim3(grid), dim3(NTHR), LDS_BYTES, stream, a);
#endif
    const hipError_t le = hipPeekAtLastError();
    if (le != hipSuccess) fprintf(stderr, "kernel_launch: launch failed: %s\n", hipGetErrorName(le));
}
```
